# Optimizing an MI355X kernel written in HIP

```python
import math
import jax, jax.numpy as jnp
from jax import lax
import numpy as np

D_MODEL = 1024
BATCH = 2
SEQ = 8192
DEPTH = 1

D_MIX = D_MODEL
ATTN_HEADS = 8
ATTN_KV_HEADS = 2
ATTN_HEAD_DIM = 64
ATTN_GROUP = ATTN_HEADS // ATTN_KV_HEADS
WINDOW = 128
BLOCK = 128
N_BUCKETS = 32
MAX_DISTANCE = 128
GDN_HEADS = 4
GDN_HEAD_DIM = 128
CONV_K = 5
CHUNK = 64
N_DIR = 2
D_FF = 4 * D_MODEL
EPS = 1e-6

ATTN_Q = ATTN_HEADS * ATTN_HEAD_DIM
ATTN_KV = ATTN_KV_HEADS * ATTN_HEAD_DIM
GDN_W = GDN_HEADS * GDN_HEAD_DIM
D_IN = ATTN_Q + 2 * ATTN_KV + 4 * GDN_W + 2 * N_DIR * GDN_HEADS
SPLIT_POINTS = (ATTN_Q,
                ATTN_Q + ATTN_KV,
                ATTN_Q + 2 * ATTN_KV,
                ATTN_Q + 2 * ATTN_KV + 3 * GDN_W,
                ATTN_Q + 2 * ATTN_KV + 4 * GDN_W,
                ATTN_Q + 2 * ATTN_KV + 4 * GDN_W + N_DIR * GDN_HEADS)

kernel_name = "hymba_swa_gdn_relu2_encoder"


def _rmsnorm(x, w):
    x32 = x.astype(jnp.float32)
    y = x32 * lax.rsqrt(jnp.mean(x32 * x32, axis=-1, keepdims=True) + EPS)
    return (y * w.astype(jnp.float32)).astype(x.dtype)


def _l2norm(t):
    return t * lax.rsqrt(jnp.sum(t * t, axis=-1, keepdims=True) + EPS)


def _t5_buckets(rel):
    nb = N_BUCKETS // 2
    max_exact = nb // 2
    base = jnp.where(rel > 0, nb, 0)
    n = jnp.abs(rel)
    log_ratio = jnp.log(jnp.maximum(n, 1).astype(jnp.float32) / max_exact) / math.log(MAX_DISTANCE / max_exact)
    large = jnp.minimum(max_exact + (log_ratio * (nb - max_exact)).astype(jnp.int32), nb - 1)
    return base + jnp.where(n < max_exact, n, large)


def _band_bias(rel_bias):
    rel = (np.arange(3 * BLOCK)[None, :] - BLOCK) - np.arange(BLOCK)[:, None]
    bucket = _t5_buckets(jnp.asarray(rel, dtype=jnp.int32))
    bias = jnp.transpose(rel_bias[bucket], (2, 0, 1)).astype(jnp.float32)
    return bias, np.abs(rel) <= WINDOW


def _band(t):
    B, S = t.shape[:2]
    nb = S // BLOCK
    tp = jnp.pad(t, ((0, 0), (BLOCK, BLOCK), (0, 0), (0, 0))).reshape(B, nb + 2, BLOCK, t.shape[2], t.shape[3])
    return jnp.concatenate([tp[:, :-2], tp[:, 1:-1], tp[:, 2:]], axis=2)


def _windowed_gqa(q, k, v, bias, in_window, sink):
    B, S = q.shape[:2]
    nb = S // BLOCK
    qb = q.reshape(B, nb, BLOCK, ATTN_KV_HEADS, ATTN_GROUP, ATTN_HEAD_DIM)
    kb, vb = _band(k), _band(v)
    scores = jnp.einsum("bnqkgd,bnskd->bnkgqs", qb, kb).astype(jnp.float32) * (ATTN_HEAD_DIM ** -0.5)
    scores = scores + bias.reshape(ATTN_KV_HEADS, ATTN_GROUP, BLOCK, 3 * BLOCK)[None, None]
    key_pos = np.arange(nb)[:, None] * BLOCK - BLOCK + np.arange(3 * BLOCK)[None, :]
    valid = in_window[None] & ((key_pos >= 0) & (key_pos < S))[:, None, :]
    scores = jnp.where(valid[None, :, None, None], scores, -1e30)
    sink_col = jnp.broadcast_to(
        sink.astype(jnp.float32).reshape(ATTN_KV_HEADS, ATTN_GROUP)[None, None, :, :, None, None],
        scores.shape[:-1] + (1,))
    probs = jax.nn.softmax(jnp.concatenate([scores, sink_col], axis=-1), axis=-1)[..., :-1]
    out = jnp.einsum("bnkgqs,bnskd->bnqkgd", probs.astype(v.dtype), vb)
    return out.reshape(B, S, ATTN_Q)


def _centred_conv(x, w):
    C = x.shape[-1]
    return lax.conv_general_dilated(
        x, w[:, None, :].astype(x.dtype), window_strides=(1,),
        padding=((CONV_K // 2, CONV_K // 2),),
        dimension_numbers=("NWC", "WIO", "NWC"), feature_group_count=C)


def _chunk_gated_delta_rule(q, k, v, g, beta):
    B, S, H, DK = q.shape
    DV = v.shape[-1]
    NC = S // CHUNK

    def to_chunks(t):
        return jnp.moveaxis(t.reshape((B, NC, CHUNK) + t.shape[2:]), 2, 3)

    q = to_chunks(q * (DK ** -0.5))
    k, v, g, beta = to_chunks(k), to_chunks(v), to_chunks(g), to_chunks(beta)
    gc = jnp.cumsum(g, axis=-1)
    causal = np.tril(np.ones((CHUNK, CHUNK), dtype=bool))
    strict = np.tril(np.ones((CHUNK, CHUNK), dtype=bool), -1)
    decay = jnp.exp(jnp.where(causal, gc[..., :, None] - gc[..., None, :], -jnp.inf))
    kk = jnp.einsum("bnhcd,bnhsd->bnhcs", k, k)
    a_mat = jnp.where(strict, beta[..., :, None] * kk * decay, 0.0)
    eye = jnp.eye(CHUNK, dtype=jnp.float32)
    t_mat = lax.linalg.triangular_solve(eye + a_mat, jnp.broadcast_to(eye, a_mat.shape),
                                        left_side=True, lower=True)
    w_c = jnp.einsum("bnhcs,bnhsd->bnhcd", t_mat, beta[..., None] * k * jnp.exp(gc)[..., None])
    u_c = jnp.einsum("bnhcs,bnhse->bnhce", t_mat, beta[..., None] * v)
    qk = jnp.einsum("bnhcd,bnhsd->bnhcs", q, k) * decay
    q_dec = q * jnp.exp(gc)[..., None]
    g_last = gc[..., -1]
    k_dec = k * jnp.exp(g_last[..., None] - gc)[..., None]

    def step(state, xs):
        q_c, k_c, u, w, qk_c, gl = xs
        v_new = u - jnp.einsum("bhcd,bhde->bhce", w, state)
        o = jnp.einsum("bhcd,bhde->bhce", q_c, state) + jnp.einsum("bhcs,bhse->bhce", qk_c, v_new)
        state = state * jnp.exp(gl)[..., None, None] + jnp.einsum("bhcd,bhce->bhde", k_c, v_new)
        return state, o

    xs = tuple(jnp.moveaxis(t, 1, 0) for t in (q_dec, k_dec, u_c, w_c, qk, g_last))
    state0 = jnp.zeros((B, H, DK, DV), dtype=jnp.float32)
    _, o = lax.scan(step, state0, xs)
    return jnp.transpose(o, (1, 0, 3, 2, 4)).reshape(B, S, H, DV)


def _gdn_mixer(qkv, z, a, b, conv_w, a_log, dt_bias, norm_w):
    B, S, _ = qkv.shape
    f32 = jnp.float32
    qkv = jax.nn.silu(_centred_conv(qkv, conv_w)).astype(f32)
    q, k, v = jnp.split(qkv, 3, axis=-1)
    q = _l2norm(q.reshape(B, S, GDN_HEADS, GDN_HEAD_DIM))
    k = _l2norm(k.reshape(B, S, GDN_HEADS, GDN_HEAD_DIM))
    v = v.reshape(B, S, GDN_HEADS, GDN_HEAD_DIM)
    a = a.astype(f32).reshape(B, S, N_DIR, GDN_HEADS)
    b = b.astype(f32).reshape(B, S, N_DIR, GDN_HEADS)
    g = -jnp.exp(a_log.astype(f32)) * jax.nn.softplus(a + dt_bias.astype(f32))
    beta = jax.nn.sigmoid(b)
    o_fwd = _chunk_gated_delta_rule(q, k, v, g[:, :, 0], beta[:, :, 0])
    flip = lambda t: jnp.flip(t, axis=1)
    o_bwd = flip(_chunk_gated_delta_rule(flip(q), flip(k), flip(v), flip(g[:, :, 1]), flip(beta[:, :, 1])))
    o = _rmsnorm(o_fwd + o_bwd, norm_w) * jax.nn.silu(z.astype(f32).reshape(B, S, GDN_HEADS, GDN_HEAD_DIM))
    return o.reshape(B, S, GDN_W).astype(z.dtype)


def setup_inputs(seed: int = 0) -> dict:
    key = jax.random.key(seed)
    ks = jax.random.split(key, 16)
    nrm = lambda k, shape, scale: jax.random.normal(k, shape, dtype=jnp.float32) * scale
    gain = lambda k, shape: 1.0 + 0.02 * jax.random.normal(k, shape, dtype=jnp.float32)
    dt = jnp.exp(jax.random.uniform(ks[7], (DEPTH, N_DIR, GDN_HEADS), minval=math.log(1e-3), maxval=math.log(1e-1)))
    return {
        "x": nrm(ks[0], (BATCH, SEQ, D_MODEL), 1.0),
        "norm_mix_w": gain(ks[1], (DEPTH, D_MODEL)),
        "w_in": nrm(ks[2], (DEPTH, D_MODEL, D_IN), D_MODEL ** -0.5),
        "rel_bias": nrm(ks[3], (N_BUCKETS, ATTN_HEADS), 0.5),
        "attn_sink": nrm(ks[4], (DEPTH, ATTN_HEADS), 1.0),
        "conv_w": nrm(ks[5], (DEPTH, CONV_K, 3 * GDN_W), CONV_K ** -0.5),
        "gdn_a_log": jnp.log(jax.random.uniform(ks[6], (DEPTH, N_DIR, GDN_HEADS), minval=1.0, maxval=16.0)),
        "gdn_dt_bias": dt + jnp.log(-jnp.expm1(-dt)),
        "gdn_norm_w": gain(ks[8], (DEPTH, GDN_HEAD_DIM)),
        "w_out": nrm(ks[9], (DEPTH, D_MIX, D_MODEL), D_MIX ** -0.5),
        "norm_ffn_w": gain(ks[10], (DEPTH, D_MODEL)),
        "w_ffn_in": nrm(ks[11], (DEPTH, D_MODEL, D_FF), D_MODEL ** -0.5),
        "w_ffn_out": nrm(ks[12], (DEPTH, D_FF, D_MODEL), D_FF ** -0.5),
        "norm_final_w": gain(ks[13], (D_MODEL,)),
    }


def reference(x, norm_mix_w, w_in, rel_bias, attn_sink, conv_w, gdn_a_log, gdn_dt_bias,
              gdn_norm_w, w_out, norm_ffn_w, w_ffn_in, w_ffn_out, norm_final_w):
    B, S, _ = x.shape
    band_bias, in_window = _band_bias(rel_bias)
    h = x
    for l in range(DEPTH):
        xn = _rmsnorm(h, norm_mix_w[l])
        proj = xn @ w_in[l]
        q_a, k_a, v_a, qkv_g, z_g, a_g, b_g = jnp.split(proj, SPLIT_POINTS, axis=-1)
        attn = _windowed_gqa(q_a.reshape(B, S, ATTN_HEADS, ATTN_HEAD_DIM),
                             k_a.reshape(B, S, ATTN_KV_HEADS, ATTN_HEAD_DIM),
                             v_a.reshape(B, S, ATTN_KV_HEADS, ATTN_HEAD_DIM),
                             band_bias, in_window, attn_sink[l])
        gdn = _gdn_mixer(qkv_g, z_g, a_g, b_g, conv_w[l], gdn_a_log[l], gdn_dt_bias[l], gdn_norm_w[l])
        h = h + jnp.concatenate([attn, gdn], axis=-1) @ w_out[l]
        hn = _rmsnorm(h, norm_ffn_w[l])
        h = h + jnp.square(jax.nn.relu(hn @ w_ffn_in[l])) @ w_ffn_out[l]
    return _rmsnorm(h, norm_final_w)
```

```cpp
#include <hip/hip_runtime.h>
#include <cstdio>
#include <cstdint>

constexpr int BATCH = 2, SEQ = 8192, DM = 1024, M = BATCH * SEQ;
constexpr int AH = 8, AKVH = 2, AHD = 64, WIN = 128;
constexpr int GH = 4, GD = 128, CONVK = 5, CHUNK = 64, NCH = SEQ / CHUNK;
constexpr int DFF = 4096, DIN = 2832, NPROJ = 2816;
constexpr float EPS = 1e-6f;
constexpr int NUNIT = BATCH * GH * NCH;

constexpr size_t MiB = 1u << 20;
constexpr size_t WS_CTL = 0, CTL_ZERO_BYTES = 1 * MiB;
constexpr size_t WS_WIN = 1 * MiB;
constexpr size_t WS_WOUT = 7 * MiB;
constexpr size_t WS_W1 = 9 * MiB;
constexpr size_t WS_W2 = 17 * MiB;
constexpr size_t WS_GATES = 25 * MiB;
constexpr size_t WS_XN = 26 * MiB;
constexpr size_t WS_QHAT = 26 * MiB, WS_KHT = 42 * MiB, WS_HB = 26 * MiB;
constexpr size_t WS_QC = 58 * MiB;
constexpr size_t WS_KV = 90 * MiB;
constexpr size_t WS_Z = 98 * MiB;
constexpr size_t WS_QKVG = 114 * MiB;
constexpr size_t WS_W = 114 * MiB, WS_QK = 146 * MiB;
constexpr size_t WS_TMP = 162 * MiB;
constexpr size_t WS_KHAT = 162 * MiB, WS_VHT = 178 * MiB, WS_ODIR = 162 * MiB;
constexpr size_t WS_U = 194 * MiB;
constexpr size_t WS_TAB = 226 * MiB;
constexpr size_t WS_SSQ1 = 228 * MiB;
constexpr size_t WS_SSQ2 = 229 * MiB;
constexpr size_t WS_ACT = 58 * MiB;
constexpr size_t WS_END = 256 * MiB;
static_assert(WS_ACT + (size_t)M * DFF * 2 <= WS_U && WS_SSQ2 + (size_t)M * 16 * 4 <= WS_END, "d_ws map");

typedef unsigned short bf16_t;
__host__ __device__ __forceinline__ unsigned f2bf(float f) { unsigned u = __builtin_bit_cast(unsigned, f); return (u + 0x7fffu + ((u >> 16) & 1u)) >> 16; }
__host__ __device__ __forceinline__ float bf2f(unsigned h) { return __builtin_bit_cast(float, (h & 0xffffu) << 16); }
__host__ __device__ __forceinline__ unsigned pk2(float lo, float hi) { return f2bf(lo) | (f2bf(hi) << 16); }

__host__ __device__ __forceinline__ int kperm(int a) { return (a & ~31) | ((a & 12) << 1) | ((a & 16) >> 2) | (a & 3); }
__host__ __device__ __forceinline__ int offA(int row, int col) { const int p = kperm(col); return row * 128 + ((((p >> 3) ^ (row & 15)) << 3) | (p & 7)); }
__host__ __device__ __forceinline__ int offT(int row, int col) { const int p = kperm(col); return row * 64 + ((((p >> 3) ^ ((row >> 1) & 7)) << 3) | (p & 7)); }
__host__ __device__ __forceinline__ int offU(int c, int dv) { return (((dv >> 4) * 4 + (c >> 4)) * 64 + ((c >> 2) & 3) * 16 + (dv & 15)) * 4 + (c & 3); }
constexpr int BLOB = 64 * 128;
constexpr int QKBLOB = 64 * 64;
constexpr int TABW = 192;
namespace pg8 {
#define PG8_LAS __attribute__((address_space(3)))
typedef unsigned short bf16_t;
typedef short bf16x8 __attribute__((ext_vector_type(8)));
typedef float f32x4 __attribute__((ext_vector_type(4)));
typedef unsigned u32x4 __attribute__((ext_vector_type(4)));
constexpr int BM = 256, BK = 64, HALF = 128, HTB = HALF * BK * 2  , STAGE_BYTES = 8 * HTB, NXCD = 8, WGM = 8;

__host__ __device__ __forceinline__ int lds_byte(int r, int c) { const int st = (r >> 4) * 2 + (c >> 5), rr = r & 15, cc = c & 31, ob = rr * 64 + cc * 2; return st * 1024 + (ob ^ (((ob >> 9) & 1) << 5)); }
__host__ __device__ __forceinline__ void stage_rc(int b, int& R, int& C) { const int st = b / 1024, sb = b % 1024, swz = sb ^ (((sb >> 9) & 1) << 5); R = (st >> 1) * 16 + swz / 64; C = (st & 1) * 32 + (swz % 64) / 2; }
__host__ __device__ __forceinline__ int perm32(int rho) { const int n = rho >> 4, i = rho & 15; return 8 * (i >> 2) + 4 * n + (i & 3); }

struct Unit { int pm, pn; };
struct Gemm { const bf16_t* A; const bf16_t* Bt; int M, N, K, pad; };

struct StaticOrder {
    int nM, nN, nwg, G, c;
    __host__ __device__ void init(int M, int N, int G_, int c_) { nM = M / BM; nN = N / BM; nwg = nM * nN; G = G_; c = c_; }
    __host__ __device__ bool next(int i, Unit& u) const {
        const long L = (long)i * G + c; if (L >= nwg) return false;
        int wgid = (int)L; { const int q = nwg / NXCD, r = nwg % NXCD, xcd = wgid % NXCD, off = wgid / NXCD; wgid = (xcd < r ? xcd * (q + 1) : r * (q + 1) + (xcd - r) * q) + off; }
        const int nig = WGM * nN, gid = wgid / nig, fm = gid * WGM, gsz = (nM - fm) < WGM ? (nM - fm) : WGM;
        u.pm = fm + ((wgid % nig) % gsz); u.pn = (wgid % nig) / gsz; return true;
    }
    __device__ __forceinline__ void a_ready(const Unit&) const {}
    __device__ __forceinline__ void done(const Unit&) const {}
};

__device__ __forceinline__ unsigned cvt_pk_bf16(float lo, float hi) { unsigned r; asm volatile("v_cvt_pk_bf16_f32 %0, %1, %2" : "=v"(r) : "v"(lo), "v"(hi)); return r; }
typedef float f32x2 __attribute__((ext_vector_type(2)));
__device__ __forceinline__ f32x2 gelu_pk(f32x2 v) {
    const f32x2 av = __builtin_elementwise_abs(v), d = av * 0.2316418882f + 1.0f;
    f32x2 t; t.x = __builtin_amdgcn_rcpf(d.x); t.y = __builtin_amdgcn_rcpf(d.y);
    f32x2 q = t * 0.5307027145f + (-0.7265760135f); q = q * t + 0.7107068705f; q = q * t + (-0.142248368f); q = q * t + 0.127414796f; q = q * t;
    const f32x2 s = (v * v) * (-0.72134752044f);
    f32x2 e; e.x = __builtin_amdgcn_exp2f(s.x); e.y = __builtin_amdgcn_exp2f(s.y);
    const f32x2 m = v * (q * e), r = v - m;
    f32x2 o; o.x = v.x < 0.f ? m.x : r.x; o.y = v.y < 0.f ? m.y : r.y; return o;
}

template <int ACT  > struct EpiBf16 {
    static constexpr bool PERM = true, AFTER_DRAIN = false; static_assert(ACT == 0 || ACT == 1, "EpiBf16: ACT is 0 (none) or 1 (gelu_pk)");
    bf16_t* O; int ldc; const float* bias; int split_cols; size_t split_stride; float scale0;
    __device__ __forceinline__ void operator()(const f32x4 (&acc)[2][2][4][2], const Unit& u, int wr, int wc, int fr, int fq) const {
        const int row0 = u.pm * BM + wr * 64 + fr; int colt = u.pn * BM; bf16_t* base = O;
        float sc = 1.f; if (split_cols) { const int t = colt / split_cols; base += (size_t)t * split_stride; colt -= t * split_cols; if (t == 0) sc = scale0; }
        const int col0 = colt + wc * 32 + 8 * fq, bcol0 = u.pn * BM + wc * 32 + 8 * fq;
        f32x4 bv[2][2];
#pragma unroll
        for (int bj = 0; bj < 2; ++bj)
#pragma unroll
            for (int n = 0; n < 2; ++n) bv[bj][n] = bias ? *(const f32x4*)(bias + bcol0 + bj * HALF + 4 * n) : (f32x4){0.f, 0.f, 0.f, 0.f};
#pragma unroll
        for (int ai = 0; ai < 2; ++ai)
#pragma unroll
            for (int m = 0; m < 4; ++m) { bf16_t* rowp = base + (size_t)(row0 + ai * HALF + m * 16) * ldc + col0;
#pragma unroll
                for (int bj = 0; bj < 2; ++bj) { f32x4 v0 = acc[ai][bj][m][0] + bv[bj][0], v1 = acc[ai][bj][m][1] + bv[bj][1];
                    if (ACT == 1) { f32x2 a = gelu_pk((f32x2){v0[0], v0[1]}), b = gelu_pk((f32x2){v0[2], v0[3]}), c = gelu_pk((f32x2){v1[0], v1[1]}), d = gelu_pk((f32x2){v1[2], v1[3]});
                        v0 = (f32x4){a.x, a.y, b.x, b.y}; v1 = (f32x4){c.x, c.y, d.x, d.y}; }
                    v0 = v0 * sc; v1 = v1 * sc; u32x4 w; w.x = cvt_pk_bf16(v0[0], v0[1]); w.y = cvt_pk_bf16(v0[2], v0[3]); w.z = cvt_pk_bf16(v1[0], v1[1]); w.w = cvt_pk_bf16(v1[2], v1[3]);
                    *(u32x4*)(rowp + bj * HALF) = w; } }
    }
};

struct PanelStats {
    unsigned* xbuf;
    unsigned* cnt;
    unsigned* tmo;
    int ntn; float eps;
    unsigned code;
    __device__ __forceinline__ bool run(const f32x4 (&v)[2][2][4][2], const Unit& u, int wr, int wc, int fr, int fq, PG8_LAS unsigned char* lds, int wid, int lane) const {
        typedef float f32x2v __attribute__((ext_vector_type(2)));
        PG8_LAS f32x2v* P = (PG8_LAS f32x2v*)lds;
        PG8_LAS f32x2v* S = (PG8_LAS f32x2v*)(lds + 8192);
        PG8_LAS unsigned* flag = (PG8_LAS unsigned*)(lds + 8192 + 2048);
#pragma unroll
        for (int ai = 0; ai < 2; ++ai)
#pragma unroll
            for (int m = 0; m < 4; ++m) {
                float s = 0.f;
#pragma unroll
                for (int bj = 0; bj < 2; ++bj)
#pragma unroll
                    for (int n = 0; n < 2; ++n) { const f32x4 x = v[ai][bj][m][n]; s += (x[0] + x[1]) + (x[2] + x[3]); }
                s += __shfl_xor(s, 16); s += __shfl_xor(s, 32);
                const float mw = s * (1.0f / 64.0f); float q = 0.f;
#pragma unroll
                for (int bj = 0; bj < 2; ++bj)
#pragma unroll
                    for (int n = 0; n < 2; ++n) { const f32x4 d = v[ai][bj][m][n] - mw; q += (d[0] * d[0] + d[1] * d[1]) + (d[2] * d[2] + d[3] * d[3]); }
                q += __shfl_xor(q, 16); q += __shfl_xor(q, 32);
                if (fq == 0) P[(ai * HALF + wr * 64 + m * 16 + fr) * 4 + wc] = (f32x2v){mw, q};
            }
        asm volatile("s_waitcnt lgkmcnt(0)" ::: "memory"); __builtin_amdgcn_s_barrier(); asm volatile("" ::: "memory");
#if defined(BROKEN_EXCHANGE_NO_WAIT)
#warning BROKEN CONTROL BUILD: the row-statistics exchange does not wait; results are wrong by design
        if (blockIdx.x >= 64) { const long long t0_ = clock64(); while (clock64() - t0_ < 60000) __builtin_amdgcn_s_sleep(8); }
#endif
        const int row = wid * 32 + (lane & 31);
        if (lane < 32) {
            const f32x2v a = P[row * 4 + 0], b = P[row * 4 + 1], c = P[row * 4 + 2], d = P[row * 4 + 3];
            const float mt = (a.x + b.x + c.x + d.x) * 0.25f;
            const float da = a.x - mt, db = b.x - mt, dc = c.x - mt, dd = d.x - mt;
            const float m2 = (a.y + b.y) + (c.y + d.y) + 64.0f * ((da * da + db * db) + (dc * dc + dd * dd));
            unsigned long long* slot = (unsigned long long*)xbuf + ((size_t)(u.pm * BM + row) * 4 + u.pn);
            __hip_atomic_store(slot, ((unsigned long long)__float_as_uint(m2) << 32) | __float_as_uint(mt), __ATOMIC_RELAXED, __HIP_MEMORY_SCOPE_AGENT);
        }
        asm volatile("s_waitcnt vmcnt(0)" ::: "memory");
        if (lane == 0) __hip_atomic_fetch_add(cnt + 64 * u.pm, 1u, __ATOMIC_RELAXED, __HIP_MEMORY_SCOPE_AGENT);
        if (wid == 0) {
            bool dead = false; const unsigned long long t0 = __builtin_amdgcn_s_memrealtime(); const unsigned want = 8u * (unsigned)ntn;
            for (;;) {
#if defined(BROKEN_EXCHANGE_NO_WAIT)
                break;
#endif
                if ((unsigned)__builtin_amdgcn_readfirstlane(__hip_atomic_load(cnt + 64 * u.pm, __ATOMIC_RELAXED, __HIP_MEMORY_SCOPE_AGENT)) >= want) break;
                if (__builtin_amdgcn_s_memrealtime() - t0 > 2000000ull) {
                    if (lane == 0) { unsigned expect = 0u; __hip_atomic_compare_exchange_strong(tmo + 1, &expect, code | (unsigned)(u.pm & 0xff), __ATOMIC_RELAXED, __ATOMIC_RELAXED, __HIP_MEMORY_SCOPE_AGENT);
                                     __hip_atomic_store(tmo, 1u, __ATOMIC_RELAXED, __HIP_MEMORY_SCOPE_AGENT); }
                    dead = true; break; }
                __builtin_amdgcn_s_sleep(2);
            }
            __builtin_amdgcn_fence(__ATOMIC_ACQUIRE, "agent");
            if (lane == 0) flag[0] = dead ? 1u : 0u;
        }
        asm volatile("s_waitcnt vmcnt(0) lgkmcnt(0)" ::: "memory"); __builtin_amdgcn_s_barrier(); asm volatile("" ::: "memory");
        const bool bad = flag[0] != 0u;
        if (lane < 32) {
            const unsigned long long* slot = (const unsigned long long*)xbuf + (size_t)(u.pm * BM + row) * 4; float mt[4], m2[4]; float ms = 0.f;
#pragma unroll
            for (int t = 0; t < 4; ++t) { if (t < ntn) { const unsigned long long w = __hip_atomic_load(slot + t, __ATOMIC_RELAXED, __HIP_MEMORY_SCOPE_AGENT); mt[t] = __uint_as_float((unsigned)w); m2[t] = __uint_as_float((unsigned)(w >> 32)); } else { mt[t] = 0.f; m2[t] = 0.f; } ms += mt[t]; }
            const float mean = ms / (float)ntn; float q = 0.f;
#pragma unroll
            for (int t = 0; t < 4; ++t) if (t < ntn) { const float dm = mt[t] - mean; q += m2[t] + 256.0f * dm * dm; }
            S[row] = (f32x2v){mean, 1.0f / sqrtf(q / (256.0f * (float)ntn) + eps)};
        }
        asm volatile("s_waitcnt lgkmcnt(0)" ::: "memory"); __builtin_amdgcn_s_barrier(); asm volatile("" ::: "memory");
        return bad;
    }
};
struct EpiLnRes {
    static constexpr bool PERM = false, AFTER_DRAIN = true;
    const float* base; float* out; int ldc; const float* bias; PanelStats st; unsigned poison;
    __device__ __forceinline__ void fused(f32x4 (&acc)[2][2][4][2], const Unit& u, int wr, int wc, int fr, int fq, PG8_LAS unsigned char* lds, int wid, int lane) const {
        typedef float f32x2v __attribute__((ext_vector_type(2)));
        const PG8_LAS f32x2v* S = (const PG8_LAS f32x2v*)(lds + 8192);
        const int col0 = u.pn * BM + wc * 32 + 4 * fq;
#pragma unroll
        for (int bj = 0; bj < 2; ++bj)
#pragma unroll
            for (int n = 0; n < 2; ++n) { const f32x4 bv = bias ? *(const f32x4*)(bias + col0 + bj * HALF + n * 16) : (f32x4){0.f, 0.f, 0.f, 0.f};
#pragma unroll
                for (int ai = 0; ai < 2; ++ai)
#pragma unroll
                    for (int m = 0; m < 4; ++m) acc[ai][bj][m][n] += bv; }
        f32x4 pre[4][2][2];
#pragma unroll
        for (int m = 0; m < 4; ++m) { const size_t off = (size_t)(u.pm * BM + wr * 64 + m * 16 + fr) * ldc + col0;
#pragma unroll
            for (int bj = 0; bj < 2; ++bj)
#pragma unroll
                for (int n = 0; n < 2; ++n) pre[m][bj][n] = *(const f32x4*)(base + off + bj * HALF + n * 16); }
        const bool bad = st.run(acc, u, wr, wc, fr, fq, lds, wid, lane) || poison != 0u;
        const float qnan = __builtin_nanf("");
#pragma unroll
        for (int ai = 0; ai < 2; ++ai)
#pragma unroll
            for (int m = 0; m < 4; ++m) { const int r = ai * HALF + wr * 64 + m * 16 + fr; const f32x2v sr = S[r]; const size_t off = (size_t)(u.pm * BM + r) * ldc + col0;
#pragma unroll
                for (int bj = 0; bj < 2; ++bj)
#pragma unroll
                    for (int n = 0; n < 2; ++n) { const f32x4 bs = ai == 0 ? pre[m][bj][n] : *(const f32x4*)(base + off + bj * HALF + n * 16); f32x4 o = bs + (acc[ai][bj][m][n] - sr.x) * sr.y;
                        if (bad) o = (f32x4){qnan, qnan, qnan, qnan}; *(f32x4*)(out + off + bj * HALF + n * 16) = o; }
                if (m & 1) asm volatile("" ::: "memory"); }
    }
};
struct EpiLnResLn {
    static constexpr bool PERM = false, AFTER_DRAIN = true;
    const float* base; float* out; bf16_t* xn; int ldc; const float* bias; PanelStats st1, st2; unsigned poison;
    __device__ __forceinline__ void fused(f32x4 (&acc)[2][2][4][2], const Unit& u, int wr, int wc, int fr, int fq, PG8_LAS unsigned char* lds, int wid, int lane) const {
        typedef float f32x2v __attribute__((ext_vector_type(2))); typedef unsigned u32x2v __attribute__((ext_vector_type(2)));
        const PG8_LAS f32x2v* S = (const PG8_LAS f32x2v*)(lds + 8192);
        const int col0 = u.pn * BM + wc * 32 + 4 * fq;
#pragma unroll
        for (int bj = 0; bj < 2; ++bj)
#pragma unroll
            for (int n = 0; n < 2; ++n) { const f32x4 bv = bias ? *(const f32x4*)(bias + col0 + bj * HALF + n * 16) : (f32x4){0.f, 0.f, 0.f, 0.f};
#pragma unroll
                for (int ai = 0; ai < 2; ++ai)
#pragma unroll
                    for (int m = 0; m < 4; ++m) acc[ai][bj][m][n] += bv; }
        bool bad = st1.run(acc, u, wr, wc, fr, fq, lds, wid, lane) || poison != 0u;
        const float qnan = __builtin_nanf("");
#pragma unroll
        for (int ai = 0; ai < 2; ++ai)
#pragma unroll
            for (int m = 0; m < 4; ++m) { const int r = ai * HALF + wr * 64 + m * 16 + fr; const f32x2v sr = S[r]; const size_t off = (size_t)(u.pm * BM + r) * ldc + col0;
#pragma unroll
                for (int bj = 0; bj < 2; ++bj)
#pragma unroll
                    for (int n = 0; n < 2; ++n) { const f32x4 bs = *(const f32x4*)(base + off + bj * HALF + n * 16); acc[ai][bj][m][n] = bs + (acc[ai][bj][m][n] - sr.x) * sr.y; }
                asm volatile("" : "+v"(acc[ai][0][m][0]), "+v"(acc[ai][0][m][1]), "+v"(acc[ai][1][m][0]), "+v"(acc[ai][1][m][1]));
                if (m & 1) asm volatile("" ::: "memory"); }
        const bool bad1 = bad;
        bad = st2.run(acc, u, wr, wc, fr, fq, lds, wid, lane) || bad;
#pragma unroll
        for (int ai = 0; ai < 2; ++ai)
#pragma unroll
            for (int m = 0; m < 4; ++m) { const int r = ai * HALF + wr * 64 + m * 16 + fr; const f32x2v sr = S[r]; const size_t off = (size_t)(u.pm * BM + r) * ldc + col0;
#pragma unroll
                for (int bj = 0; bj < 2; ++bj)
#pragma unroll
                    for (int n = 0; n < 2; ++n) { const f32x4 x1 = acc[ai][bj][m][n]; *(f32x4*)(out + off + bj * HALF + n * 16) = bad1 ? (f32x4){qnan, qnan, qnan, qnan} : x1;
                        const f32x4 o = (x1 - sr.x) * sr.y; u32x2v w; w.x = cvt_pk_bf16(o[0], o[1]); w.y = cvt_pk_bf16(o[2], o[3]);
                        if (bad) { w.x = 0x7fc07fc0u; w.y = 0x7fc07fc0u; } *(u32x2v*)(xn + off + bj * HALF + n * 16) = w; }
                asm volatile("" ::: "memory"); }
    }
};

template <class Epi, class Sched, bool ALIGN_EPI = false, bool SP2 = false>
__device__ __forceinline__ void gemm_phase(PG8_LAS unsigned char* lds, const Gemm g, const Sched& S, const Epi& E) {
    const int tid = threadIdx.x, wid = __builtin_amdgcn_readfirstlane(tid >> 6), lane = tid & 63, wr = wid >> 2, wc = wid & 3, fr = lane & 15, fq = lane >> 4;
    const int K = g.K, nt = K / BK;
    unsigned voffA[2], voffB[2];
#pragma unroll
    for (int i = 0; i < 2; ++i) { int R, C; stage_rc(tid * 16 + i * 8192, R, C); const int Rb = Epi::PERM ? ((R & ~31) + perm32(R & 31)) : R;
        voffA[i] = (unsigned)(R * K + C) * 2u; voffB[i] = (unsigned)(Rb * K + C) * 2u; }
    const size_t kstep = (size_t)(BK * 2);
    const size_t hstep = (size_t)HALF * K * 2;
    const size_t tstep = 2 * hstep;
    const unsigned ldsw = (unsigned)wid * 1024u;
    const int aoff = lds_byte(wr * 64 + fr, fq * 8), boff = lds_byte(wc * 32 + fr, fq * 8);
#define PG8_SA(b, h) (((b) * 2 + (h)) * HTB)
#define PG8_SB(b, h) ((4 + (b) * 2 + (h)) * HTB)
#define PG8_STAGE(bufoff, gbase, voff) do { _Pragma("unroll") for (int _i = 0; _i < 2; ++_i) \
        __builtin_amdgcn_global_load_lds((const unsigned*)((const char*)(gbase) + (voff)[_i]), (PG8_LAS unsigned*)(lds + (bufoff) + ldsw + _i * 8192), 16, 0, 0); } while (0)
#define PG8_LDA(dst, b, h) do { _Pragma("unroll") for (int m = 0; m < 4; ++m) _Pragma("unroll") for (int k = 0; k < 2; ++k) dst[m][k] = *(const PG8_LAS bf16x8*)(lds + PG8_SA(b, h) + aoff + m * 2048 + k * 1024); } while (0)
#define PG8_LDB(dst, b, h) do { _Pragma("unroll") for (int n = 0; n < 2; ++n) _Pragma("unroll") for (int k = 0; k < 2; ++k) dst[n][k] = *(const PG8_LAS bf16x8*)(lds + PG8_SB(b, h) + boff + n * 2048 + k * 1024); } while (0)
#define PG8_MMA(ai, bj, At, Bt) do { __builtin_amdgcn_s_setprio(1); _Pragma("unroll") for (int m = 0; m < 4; ++m) _Pragma("unroll") for (int n = 0; n < 2; ++n) _Pragma("unroll") for (int k = 0; k < 2; ++k) \
        acc[ai][bj][m][n] = __builtin_amdgcn_mfma_f32_16x16x32_bf16(Bt[n][k], At[m][k], acc[ai][bj][m][n], 0, 0, 0); __builtin_amdgcn_s_setprio(0); } while (0)
#define PG8_WAIT_V(n) asm volatile("s_waitcnt vmcnt(" #n ")" ::: "memory")
#define PG8_WAIT_L(n) asm volatile("s_waitcnt lgkmcnt(" #n ")" ::: "memory")
#define PG8_BAR __builtin_amdgcn_s_barrier()
#define PG8_SCHED __builtin_amdgcn_sched_barrier(0)
    Unit cur, nxt; int ui = 0;
    if (!S.next(0, cur)) return;
    f32x4 acc[2][2][4][2];
#pragma unroll
    for (int a = 0; a < 2; ++a)
#pragma unroll
        for (int b = 0; b < 2; ++b)
#pragma unroll
            for (int m = 0; m < 4; ++m)
#pragma unroll
                for (int n = 0; n < 2; ++n) acc[a][b][m][n] = (f32x4){0.f, 0.f, 0.f, 0.f};
    bf16x8 At[4][2], B0[2][2], B1[2][2];
    const char* cA = (const char*)g.A + (size_t)cur.pm * tstep; const char* cB = (const char*)g.Bt + (size_t)cur.pn * tstep;
    S.a_ready(cur);
    if constexpr (SP2) {
        PG8_STAGE(PG8_SB(0, 0), cB, voffB); PG8_STAGE(PG8_SB(0, 1), cB + hstep, voffB); PG8_STAGE(PG8_SA(0, 0), cA, voffA); PG8_STAGE(PG8_SA(0, 1), cA + hstep, voffA);
        if (wr == 1) PG8_BAR;
        PG8_WAIT_V(2); PG8_BAR;
        PG8_STAGE(PG8_SB(1, 0), cB + kstep, voffB); PG8_STAGE(PG8_SA(1, 0), cA + kstep, voffA); PG8_STAGE(PG8_SB(1, 1), cB + hstep + kstep, voffB);
        PG8_WAIT_V(6); PG8_BAR;
    } else {
        PG8_STAGE(PG8_SB(0, 0), cB, voffB); PG8_STAGE(PG8_SA(0, 0), cA, voffA); PG8_STAGE(PG8_SB(0, 1), cB + hstep, voffB); PG8_STAGE(PG8_SA(0, 1), cA + hstep, voffA);
        if (wr == 1) PG8_BAR;
        PG8_WAIT_V(4); PG8_BAR;
        PG8_STAGE(PG8_SB(1, 0), cB + kstep, voffB); PG8_STAGE(PG8_SA(1, 0), cA + kstep, voffA); PG8_STAGE(PG8_SB(1, 1), cB + hstep + kstep, voffB);
        PG8_WAIT_V(6); PG8_BAR;
    }
    for (;;) {
        const bool has_next = S.next(ui + 1, nxt);
        const char* nA = has_next ? (const char*)g.A + (size_t)nxt.pm * tstep : cA; const char* nB = has_next ? (const char*)g.Bt + (size_t)nxt.pn * tstep : cB;
        for (int t = 0; t < nt; t += 2) {
            const bool last = (t == nt - 2);
            const char* a1 = cA + (size_t)(t + 1) * kstep;
            const char* a2 = last ? nA : cA + (size_t)(t + 2) * kstep; const char* b2 = last ? nB : cB + (size_t)(t + 2) * kstep;
            const char* a3 = a2 + kstep; const char* b3 = b2 + kstep;
            if (last && has_next) S.a_ready(nxt);
            if constexpr (SP2) {
            PG8_LDB(B0, 0, 0); PG8_LDB(B1, 0, 1); PG8_SCHED; PG8_LDA(At, 0, 0); PG8_STAGE(PG8_SA(1, 1), a1 + hstep, voffA);
            PG8_WAIT_V(8); PG8_WAIT_L(0); PG8_BAR; PG8_MMA(0, 0, At, B0); PG8_MMA(0, 1, At, B1); PG8_BAR; PG8_SCHED;
            PG8_LDA(At, 0, 1); PG8_STAGE(PG8_SB(0, 0), b2, voffB); PG8_STAGE(PG8_SB(0, 1), b2 + hstep, voffB); PG8_STAGE(PG8_SA(0, 0), a2, voffA);
            PG8_WAIT_V(8); PG8_WAIT_L(0); PG8_BAR; PG8_MMA(1, 0, At, B0); PG8_MMA(1, 1, At, B1); PG8_BAR; PG8_SCHED;
            PG8_LDB(B0, 1, 0); PG8_LDB(B1, 1, 1); PG8_SCHED; PG8_LDA(At, 1, 0); PG8_STAGE(PG8_SA(0, 1), a2 + hstep, voffA);
            PG8_WAIT_V(8); PG8_WAIT_L(0); PG8_BAR; PG8_MMA(0, 0, At, B0); PG8_MMA(0, 1, At, B1); PG8_BAR; PG8_SCHED;
            PG8_LDA(At, 1, 1); PG8_STAGE(PG8_SB(1, 0), b3, voffB); PG8_STAGE(PG8_SB(1, 1), b3 + hstep, voffB); PG8_STAGE(PG8_SA(1, 0), a3, voffA);
            PG8_WAIT_V(8); PG8_WAIT_L(0); PG8_BAR; PG8_MMA(1, 0, At, B0); PG8_MMA(1, 1, At, B1); PG8_BAR; PG8_SCHED;
            } else {
            PG8_LDB(B0, 0, 0); PG8_SCHED; PG8_LDA(At, 0, 0); PG8_STAGE(PG8_SA(1, 1), a1 + hstep, voffA);
            PG8_WAIT_L(8); PG8_BAR; PG8_WAIT_L(0); PG8_MMA(0, 0, At, B0); PG8_BAR; PG8_SCHED;
            PG8_LDB(B1, 0, 1); PG8_STAGE(PG8_SB(0, 0), b2, voffB);
            PG8_BAR; PG8_WAIT_L(0); PG8_MMA(0, 1, At, B1); PG8_BAR;
            PG8_LDA(At, 0, 1); PG8_STAGE(PG8_SA(0, 0), a2, voffA);
            PG8_BAR; PG8_WAIT_L(0); PG8_MMA(1, 0, At, B0); PG8_BAR; PG8_SCHED;
            PG8_STAGE(PG8_SB(0, 1), b2 + hstep, voffB);
            PG8_WAIT_V(6); PG8_BAR; PG8_MMA(1, 1, At, B1); PG8_BAR;
            PG8_LDB(B0, 1, 0); PG8_SCHED; PG8_LDA(At, 1, 0); PG8_STAGE(PG8_SA(0, 1), a2 + hstep, voffA);
            PG8_WAIT_L(8); PG8_BAR; PG8_WAIT_L(0); PG8_MMA(0, 0, At, B0); PG8_BAR; PG8_SCHED;
            PG8_LDB(B1, 1, 1); PG8_STAGE(PG8_SB(1, 0), b3, voffB);
            PG8_BAR; PG8_WAIT_L(0); PG8_MMA(0, 1, At, B1); PG8_BAR;
            PG8_LDA(At, 1, 1); PG8_STAGE(PG8_SA(1, 0), a3, voffA);
            PG8_BAR; PG8_WAIT_L(0); PG8_MMA(1, 0, At, B0); PG8_BAR; PG8_SCHED;
            PG8_STAGE(PG8_SB(1, 1), b3 + hstep, voffB);
            PG8_WAIT_V(6); PG8_BAR; PG8_MMA(1, 1, At, B1); PG8_BAR;
            }
        }
        if constexpr (ALIGN_EPI) { if (wr == 0) PG8_BAR; }
        if constexpr (!Epi::AFTER_DRAIN) { E(acc, cur, wr, wc, fr, fq); S.done(cur); }
        if (!has_next) break;
#pragma unroll
        for (int a = 0; a < 2; ++a)
#pragma unroll
            for (int b = 0; b < 2; ++b)
#pragma unroll
                for (int m = 0; m < 4; ++m)
#pragma unroll
                    for (int n = 0; n < 2; ++n) acc[a][b][m][n] = (f32x4){0.f, 0.f, 0.f, 0.f};
        cur = nxt; cA = nA; cB = nB; ++ui;
        if constexpr (ALIGN_EPI) { if (wr == 1) PG8_BAR; }
    }
    PG8_WAIT_V(0);
    if constexpr (!ALIGN_EPI) { if (wr == 0) PG8_BAR; }
    PG8_BAR;
    if constexpr (Epi::AFTER_DRAIN) { E.fused(acc, cur, wr, wc, fr, fq, lds, wid, lane); S.done(cur); }
#undef PG8_SA
#undef PG8_SB
#undef PG8_STAGE
#undef PG8_LDA
#undef PG8_LDB
#undef PG8_MMA
#undef PG8_WAIT_V
#undef PG8_WAIT_L
#undef PG8_BAR
#undef PG8_SCHED
}
}
namespace pg8 {
struct EpiProj {
    static constexpr bool PERM = true, AFTER_DRAIN = false;
    bf16_t *QC, *KV, *QKVG, *Z;
    __device__ __forceinline__ void operator()(const f32x4 (&acc)[2][2][4][2], const Unit& u, int wr, int wc, int fr, int fq) const {
        const int pn = u.pn; bf16_t* base; int ldc, colt;
        if (pn < 2) { base = QC; ldc = 1024; colt = pn * 256; }
        else if (pn == 2) { base = KV; ldc = 256; colt = 0; }
        else if (pn < 9) { base = QKVG; ldc = 1536; colt = (pn - 3) * 256; }
        else { base = Z; ldc = 512; colt = (pn - 9) * 256; }
        const int row0 = u.pm * BM + wr * 64 + fr, col0 = colt + wc * 32 + 8 * fq;
#pragma unroll
        for (int ai = 0; ai < 2; ++ai)
#pragma unroll
            for (int m = 0; m < 4; ++m) { bf16_t* rowp = base + (size_t)(row0 + ai * HALF + m * 16) * ldc + col0;
#pragma unroll
                for (int bj = 0; bj < 2; ++bj) { const f32x4 v0 = acc[ai][bj][m][0], v1 = acc[ai][bj][m][1];
                    u32x4 w; w.x = cvt_pk_bf16(v0[0], v0[1]); w.y = cvt_pk_bf16(v0[2], v0[3]); w.z = cvt_pk_bf16(v1[0], v1[1]); w.w = cvt_pk_bf16(v1[2], v1[3]);
                    *(u32x4*)(rowp + bj * HALF) = w; } }
    }
};
struct EpiRes {
    static constexpr bool PERM = false, AFTER_DRAIN = false;
    const float* base; float* H; bf16_t* HB; float* SSQ;
    __device__ __forceinline__ void operator()(const f32x4 (&acc)[2][2][4][2], const Unit& u, int wr, int wc, int fr, int fq) const {
        typedef unsigned u32x2v __attribute__((ext_vector_type(2)));
        const int col0 = u.pn * BM + wc * 32 + 4 * fq;
#pragma unroll
        for (int ai = 0; ai < 2; ++ai)
#pragma unroll
            for (int m = 0; m < 4; ++m) { const int row = u.pm * BM + ai * HALF + wr * 64 + m * 16 + fr; const size_t off = (size_t)row * 1024 + col0; float ss = 0.f;
#pragma unroll
                for (int bj = 0; bj < 2; ++bj)
#pragma unroll
                    for (int n = 0; n < 2; ++n) { const f32x4 bs = *(const f32x4*)(base + off + bj * HALF + n * 16); const f32x4 hv = bs + acc[ai][bj][m][n];
                        *(f32x4*)(H + off + bj * HALF + n * 16) = hv; ss += (hv[0] * hv[0] + hv[1] * hv[1]) + (hv[2] * hv[2] + hv[3] * hv[3]);
                        if (HB) { u32x2v w; w.x = cvt_pk_bf16(hv[0], hv[1]); w.y = cvt_pk_bf16(hv[2], hv[3]); *(u32x2v*)(HB + off + bj * HALF + n * 16) = w; } }
                ss += __shfl_xor(ss, 16); ss += __shfl_xor(ss, 32);
                if (fq == 0) SSQ[(size_t)row * 16 + u.pn * 4 + wc] = ss; }
    }
};
struct EpiFfn1 {
    static constexpr bool PERM = true, AFTER_DRAIN = false;
    bf16_t* ACT; const float* SSQ;
    __device__ __forceinline__ void operator()(const f32x4 (&acc)[2][2][4][2], const Unit& u, int wr, int wc, int fr, int fq) const {
        const int row0 = u.pm * BM + wr * 64 + fr, col0 = u.pn * BM + wc * 32 + 8 * fq;
#pragma unroll
        for (int ai = 0; ai < 2; ++ai)
#pragma unroll
            for (int m = 0; m < 4; ++m) { const int row = row0 + ai * HALF + m * 16; const f32x4* sp = (const f32x4*)(SSQ + (size_t)row * 16);
                const f32x4 s0 = sp[0], s1 = sp[1], s2 = sp[2], s3 = sp[3]; const f32x4 st = (s0 + s1) + (s2 + s3);
                const float r = rsqrtf(((st[0] + st[1]) + (st[2] + st[3])) * (1.f / 1024.f) + 1e-6f);
                bf16_t* rowp = ACT + (size_t)row * 4096 + col0;
#pragma unroll
                for (int bj = 0; bj < 2; ++bj) { f32x4 v0 = acc[ai][bj][m][0] * r, v1 = acc[ai][bj][m][1] * r;
#pragma unroll
                    for (int e = 0; e < 4; ++e) { const float a = fmaxf(v0[e], 0.f), b = fmaxf(v1[e], 0.f); v0[e] = a * a; v1[e] = b * b; }
                    u32x4 w; w.x = cvt_pk_bf16(v0[0], v0[1]); w.y = cvt_pk_bf16(v0[2], v0[3]); w.z = cvt_pk_bf16(v1[0], v1[1]); w.w = cvt_pk_bf16(v1[2], v1[3]);
                    *(u32x4*)(rowp + bj * HALF) = w; } }
    }
};
}

constexpr int GEMM_LDS = 131072;
template <class Epi, bool ALIGN>
__global__ void __launch_bounds__(512, 2) k_gemm(pg8::Gemm g, Epi e) {
    extern __shared__ __attribute__((aligned(16))) unsigned char lds_g[];
    pg8::StaticOrder S; S.init(g.M, g.N, (int)gridDim.x, (int)blockIdx.x);
    pg8::gemm_phase<Epi, pg8::StaticOrder, ALIGN, true>((PG8_LAS unsigned char*)lds_g, g, S, e);
}
#define GAS __attribute__((address_space(1)))
typedef float f32x4 __attribute__((ext_vector_type(4)));

__global__ void k_wt(const float* __restrict__ W, int K, int ldw, int col0, int N, const float* __restrict__ kscale, bf16_t* __restrict__ WT) {
    __shared__ float tile[32][33];
    const int n0 = blockIdx.x * 32, k0 = blockIdx.y * 32, tx = threadIdx.x & 31, ty = threadIdx.x >> 5;
    for (int i = ty; i < 32; i += 8) { const int k = k0 + i; float v = W[(size_t)k * ldw + col0 + n0 + tx]; if (kscale) v *= kscale[k]; tile[i][tx] = v; }
    __syncthreads();
    for (int i = ty; i < 32; i += 8) WT[(size_t)(n0 + i) * K + k0 + tx] = (bf16_t)f2bf(tile[tx][i]);
}

__global__ void k_p0_rows(const float* __restrict__ x, const float* __restrict__ nw, const float* __restrict__ w_in, bf16_t* __restrict__ XN, float* __restrict__ GATES) {
    __shared__ float xs[DM]; __shared__ float red[256];
    const int m = blockIdx.x, t = threadIdx.x;
    float v[4], ss = 0.f;
    for (int i = 0; i < 4; ++i) { v[i] = x[(size_t)m * DM + t + 256 * i]; ss += v[i] * v[i]; }
    red[t] = ss; __syncthreads();
    for (int s = 128; s > 0; s >>= 1) { if (t < s) red[t] += red[t + s]; __syncthreads(); }
    const float r = rsqrtf(red[0] * (1.f / DM) + EPS);
    for (int i = 0; i < 4; ++i) { const int k = t + 256 * i; const float xn = v[i] * r * nw[k]; xs[k] = xn; XN[(size_t)m * DM + k] = (bf16_t)f2bf(xn); }
    __syncthreads();
    const int j = t >> 4, l = t & 15; float acc = 0.f;
    for (int k = l; k < DM; k += 16) acc += xs[k] * w_in[(size_t)k * DIN + NPROJ + j];
    for (int o = 8; o > 0; o >>= 1) acc += __shfl_xor(acc, o);
    if (l == 0) GATES[(size_t)m * 16 + j] = acc;
}

__global__ void k_p2a(const bf16_t* __restrict__ QKVG, const float* __restrict__ conv_w, bf16_t* __restrict__ QHAT, bf16_t* __restrict__ KHAT, bf16_t* __restrict__ KHT, bf16_t* __restrict__ VHT) {
    __shared__ float red[128];
    const int m = blockIdx.x, h = blockIdx.y, d = threadIdx.x, b = m / SEQ, t = m % SEQ, n = t / CHUNK, c = t % CHUNK;
    const size_t u = (size_t)((b * GH + h) * NCH + n);
    float s[3];
    for (int which = 0; which < 3; ++which) {
        const int ch = which * 512 + h * GD + d; float y = 0.f;
        for (int j = 0; j < CONVK; ++j) { const int tt = t - 2 + j; if (tt >= 0 && tt < SEQ) y += bf2f(QKVG[(size_t)(b * SEQ + tt) * 1536 + ch]) * conv_w[j * 1536 + ch]; }
        s[which] = y / (1.f + __expf(-y));
    }
    for (int which = 0; which < 2; ++which) {
        red[d] = s[which] * s[which]; __syncthreads();
        for (int st = 64; st > 0; st >>= 1) { if (d < st) red[d] += red[d + st]; __syncthreads(); }
        const float r = rsqrtf(red[0] + EPS); __syncthreads();
        s[which] *= r;
    }
    s[0] *= 0.08838834764831845f;
    QHAT[u * BLOB + offA(c, d)] = (bf16_t)f2bf(s[0]);
    KHAT[u * BLOB + offA(c, d)] = (bf16_t)f2bf(s[1]);
    KHT[u * BLOB + offT(d, c)] = (bf16_t)f2bf(s[1]);
    VHT[u * BLOB + offT(d, c)] = (bf16_t)f2bf(s[2]);
}

__global__ void k_p2b_ref(const bf16_t* __restrict__ QHAT, const bf16_t* __restrict__ KHAT, const bf16_t* __restrict__ VHT, const float* __restrict__ GATES,
                          const float* __restrict__ a_log, const float* __restrict__ dt_bias, bf16_t* __restrict__ Wb, bf16_t* __restrict__ Ub, bf16_t* __restrict__ QKb, float* __restrict__ TAB) {
    extern __shared__ float sm[];
    float* kf = sm;
    float* xf = kf + 64 * 129;
    float* A = xf + 64 * 129;
    float* T = A + 64 * 65;
    float* gc = T + 64 * 65;
    float* bet = gc + 64;
    float* gg = bet + 64;
    const int ud = blockIdx.x, u = ud >> 1, dir = ud & 1, p = threadIdx.x, c = dir ? 63 - p : p;
    const int n = u % NCH, bh = u / NCH, h = bh % GH, b = bh / GH;
    const int m = b * SEQ + n * CHUNK + c;
    {
        const float a = GATES[(size_t)m * 16 + dir * 4 + h], bb = GATES[(size_t)m * 16 + 8 + dir * 4 + h];
        const float z = a + dt_bias[dir * 4 + h];
        const float sp = (z > 20.f) ? z : log1pf(__expf(z));
        gg[p] = -__expf(a_log[dir * 4 + h]) * sp; bet[p] = 1.f / (1.f + __expf(-bb));
    }
    for (int d = 0; d < GD; ++d) kf[p * 129 + d] = bf2f(KHAT[(size_t)u * BLOB + offA(c, d)]);
    __syncthreads();
    { float s = 0.f; for (int j = 0; j <= p; ++j) s += gg[j]; gc[p] = s; }
    __syncthreads();
    for (int j = 0; j < 64; ++j) {
        float v = 0.f;
        if (j < p) { float dd = 0.f; for (int d = 0; d < GD; ++d) dd += kf[p * 129 + d] * kf[j * 129 + d]; v = bet[p] * dd * __expf(gc[p] - gc[j]); }
        A[p * 65 + j] = v;
    }
    __syncthreads();
    for (int j = 63; j >= 0; --j) {
        float acc = (j == p) ? 1.f : 0.f;
        if (j <= p) { for (int k = j + 1; k <= p; ++k) acc -= T[p * 65 + k] * A[k * 65 + j]; } else acc = 0.f;
        T[p * 65 + j] = acc;
    }
    for (int d = 0; d < GD; ++d) {
        float acc = 0.f;
        for (int j = 0; j <= p; ++j) acc += T[p * 65 + j] * bet[j] * __expf(gc[j]) * kf[j * 129 + d];
        Wb[(size_t)ud * BLOB + offA(c, d)] = (bf16_t)f2bf(-acc);
    }
    for (int d = 0; d < GD; ++d) xf[p * 129 + d] = bf2f(VHT[(size_t)u * BLOB + offT(d, c)]);
    __syncthreads();
    for (int d = 0; d < GD; ++d) {
        float acc = 0.f;
        for (int j = 0; j <= p; ++j) acc += T[p * 65 + j] * bet[j] * xf[j * 129 + d];
        Ub[(size_t)ud * BLOB + offU(c, d)] = (bf16_t)f2bf(acc);
    }
    __syncthreads();
    for (int d = 0; d < GD; ++d) xf[p * 129 + d] = bf2f(QHAT[(size_t)u * BLOB + offA(c, d)]);
    __syncthreads();
    for (int j = 0; j < 64; ++j) {
        float v = 0.f;
        if (j <= p) { float dd = 0.f; for (int d = 0; d < GD; ++d) dd += xf[p * 129 + d] * kf[j * 129 + d]; v = dd * __expf(gc[p] - gc[j]); }
        const int cj = dir ? 63 - j : j;
        QKb[(size_t)ud * QKBLOB + offT(c, cj)] = (bf16_t)f2bf(v);
    }
    TAB[(size_t)ud * TABW + c] = __expf(gc[p]);
    TAB[(size_t)ud * TABW + 64 + c] = __expf(gc[63] - gc[p]);
    if (p == 63) TAB[(size_t)ud * TABW + 128] = __expf(gc[63]);
}

__global__ void k_scan_ref(const bf16_t* __restrict__ QHAT, const bf16_t* __restrict__ KHT, const bf16_t* __restrict__ Wb, const bf16_t* __restrict__ Ub, const bf16_t* __restrict__ QKb,
                           const float* __restrict__ TAB, bf16_t* __restrict__ ODIR) {
    extern __shared__ float sm[];
    float* S = sm;
    float* vn = S + 128 * 128;
    float* Wl = vn + 64 * 128;
    float* Ql = Wl + 64 * 128;
    const int chain = blockIdx.x, dir = chain & 1, bh = chain >> 1, h = bh % GH, b = bh / GH, dv = threadIdx.x;
    for (int d = 0; d < 128; ++d) S[d * 128 + dv] = 0.f;
    for (int step = 0; step < NCH; ++step) {
        const int n = dir ? NCH - 1 - step : step; const size_t u = (size_t)bh * NCH + n, ud = u * 2 + dir;
        const float* tab = TAB + ud * TABW;
        __syncthreads();
        for (int i = dv; i < 64 * 128; i += 128) { const int c = i >> 7, d = i & 127; Wl[i] = bf2f(Wb[ud * BLOB + offA(c, d)]); }
        __syncthreads();
        for (int c = 0; c < 64; ++c) { float acc = bf2f(Ub[ud * BLOB + offU(c, dv)]); for (int d = 0; d < 128; ++d) acc += Wl[c * 128 + d] * S[d * 128 + dv]; vn[c * 128 + dv] = acc; }
        __syncthreads();
        for (int i = dv; i < 64 * 128; i += 128) { const int c = i >> 7, d = i & 127; Wl[i] = bf2f(QHAT[u * BLOB + offA(c, d)]); }
        for (int i = dv; i < 64 * 64; i += 128) { const int c = i >> 6, c2 = i & 63; Ql[i] = bf2f(QKb[ud * QKBLOB + offT(c, c2)]); }
        __syncthreads();
        for (int c = 0; c < 64; ++c) {
            float acc = 0.f; for (int d = 0; d < 128; ++d) acc += Wl[c * 128 + d] * S[d * 128 + dv];
            acc *= tab[c];
            for (int c2 = 0; c2 < 64; ++c2) acc += Ql[c * 64 + c2] * vn[c2 * 128 + dv];
            ODIR[((size_t)dir * M + (size_t)b * SEQ + n * CHUNK + c) * 512 + h * GD + dv] = (bf16_t)f2bf(acc);
        }
        __syncthreads();
        for (int i = dv; i < 64 * 128; i += 128) { const int c = i >> 7, d = i & 127; Wl[i] = bf2f(KHT[u * BLOB + offT(d, c)]); }
        __syncthreads();
        const float egl = tab[128];
        for (int d = 0; d < 128; ++d) { float acc = S[d * 128 + dv] * egl; for (int c = 0; c < 64; ++c) acc += Wl[c * 128 + d] * tab[64 + c] * vn[c * 128 + dv]; S[d * 128 + dv] = acc; }
    }
}

__host__ __device__ __forceinline__ int t5_bucket(int rel) {
    const int base = rel > 0 ? 16 : 0; const int n = rel < 0 ? -rel : rel;
    if (n < 8) return base + n;
    int k = (n >= 12) + (n >= 16) + (n >= 23) + (n >= 32) + (n >= 46) + (n >= 64) + (n >= 91) + (n >= 128);
    int large = 8 + k; if (large > 15) large = 15;
    return base + large;
}

__global__ void __launch_bounds__(64) k_attn_ref(bf16_t* QC, const bf16_t* __restrict__ KV, const float* __restrict__ rel_bias, const float* __restrict__ sink) {
    __shared__ float btab[257];
    const int h = blockIdx.y, m = blockIdx.x * 64 + threadIdx.x, b = m / SEQ, t = m % SEQ, kvh = h >> 2;
    for (int i = threadIdx.x; i < 257; i += 64) btab[i] = rel_bias[t5_bucket(i - 128) * AH + h];
    __syncthreads();
    float q[64], acc[64];
#pragma unroll
    for (int d = 0; d < 64; ++d) { q[d] = bf2f(QC[(size_t)m * 1024 + h * 64 + d]); acc[d] = 0.f; }
    float mx = -1e30f, l = 0.f;
    const int lo = t - WIN < 0 ? 0 : t - WIN, hi = t + WIN > SEQ - 1 ? SEQ - 1 : t + WIN;
    for (int kp = lo; kp <= hi; ++kp) {
        const bf16_t* kr = KV + (size_t)(b * SEQ + kp) * 256 + kvh * 64; const bf16_t* vr = kr + 128;
        float s = 0.f;
#pragma unroll
        for (int d = 0; d < 64; ++d) s += q[d] * bf2f(kr[d]);
        s = s * 0.125f + btab[kp - t + 128];
        const float mn = fmaxf(mx, s), f = __expf(mx - mn), pe = __expf(s - mn);
        l = l * f + pe; mx = mn;
#pragma unroll
        for (int d = 0; d < 64; ++d) acc[d] = acc[d] * f + pe * bf2f(vr[d]);
    }
    { const float s = sink[h]; const float mn = fmaxf(mx, s), f = __expf(mx - mn); l = l * f + __expf(s - mn);
#pragma unroll
      for (int d = 0; d < 64; ++d) acc[d] *= f; }
    const float il = 1.f / l;
#pragma unroll
    for (int d = 0; d < 64; ++d) QC[(size_t)m * 1024 + h * 64 + d] = (bf16_t)f2bf(acc[d] * il);
}

__global__ void k_p4(const bf16_t* __restrict__ ODIR, const bf16_t* __restrict__ Z, const float* __restrict__ gnw, bf16_t* __restrict__ QC) {
    __shared__ float red[128];
    const int m = blockIdx.x, h = blockIdx.y, d = threadIdx.x;
    const float o = bf2f(ODIR[(size_t)m * 512 + h * GD + d]) + bf2f(ODIR[((size_t)M + m) * 512 + h * GD + d]);
    red[d] = o * o; __syncthreads();
    for (int st = 64; st > 0; st >>= 1) { if (d < st) red[d] += red[d + st]; __syncthreads(); }
    const float r = rsqrtf(red[0] * (1.f / GD) + EPS);
    const float z = bf2f(Z[(size_t)m * 512 + h * GD + d]);
    QC[(size_t)m * 1024 + 512 + h * GD + d] = (bf16_t)f2bf(o * r * gnw[d] * (z / (1.f + __expf(-z))));
}

__global__ void k_final(float* __restrict__ out, const float* __restrict__ SSQ2, const float* __restrict__ nfw) {
    const int m = blockIdx.x, t = threadIdx.x;
    float ss = 0.f; for (int i = 0; i < 16; ++i) ss += SSQ2[(size_t)m * 16 + i];
    const float r = rsqrtf(ss * (1.f / DM) + EPS);
    for (int i = 0; i < 4; ++i) { const int k = t + 256 * i; out[(size_t)m * DM + k] = out[(size_t)m * DM + k] * r * nfw[k]; }
}
extern "C" void kernel_launch(void* const* d_in, const int* in_sizes, int n_in, void* d_out, int out_size, void* d_ws, size_t ws_size, hipStream_t stream) {
    const float* x = (const float*)d_in[0]; const float* norm_mix_w = (const float*)d_in[1]; const float* w_in = (const float*)d_in[2];
    const float* rel_bias = (const float*)d_in[3]; const float* attn_sink = (const float*)d_in[4]; const float* conv_w = (const float*)d_in[5];
    const float* a_log = (const float*)d_in[6]; const float* dt_bias = (const float*)d_in[7]; const float* gdn_norm_w = (const float*)d_in[8];
    const float* w_out = (const float*)d_in[9]; const float* norm_ffn_w = (const float*)d_in[10]; const float* w_ffn_in = (const float*)d_in[11];
    const float* w_ffn_out = (const float*)d_in[12]; const float* norm_final_w = (const float*)d_in[13];
    unsigned char* ws = (unsigned char*)d_ws; float* out = (float*)d_out;
    if (n_in != 14 || ws_size < WS_END) { fprintf(stderr, "kernel_launch: unexpected inputs (n_in %d, ws %zu)\n", n_in, ws_size); return; }
    bf16_t* WIN_T = (bf16_t*)(ws + WS_WIN); bf16_t* WOUT_T = (bf16_t*)(ws + WS_WOUT); bf16_t* W1_T = (bf16_t*)(ws + WS_W1); bf16_t* W2_T = (bf16_t*)(ws + WS_W2);
    float* GATES = (float*)(ws + WS_GATES); bf16_t* XN = (bf16_t*)(ws + WS_XN); bf16_t* QHAT = (bf16_t*)(ws + WS_QHAT); bf16_t* KHT = (bf16_t*)(ws + WS_KHT); bf16_t* HB = (bf16_t*)(ws + WS_HB);
    bf16_t* QC = (bf16_t*)(ws + WS_QC); bf16_t* KV = (bf16_t*)(ws + WS_KV); bf16_t* Z = (bf16_t*)(ws + WS_Z); bf16_t* QKVG = (bf16_t*)(ws + WS_QKVG);
    bf16_t* Wb = (bf16_t*)(ws + WS_W); bf16_t* QKb = (bf16_t*)(ws + WS_QK); bf16_t* KHAT = (bf16_t*)(ws + WS_KHAT); bf16_t* VHT = (bf16_t*)(ws + WS_VHT); bf16_t* ODIR = (bf16_t*)(ws + WS_ODIR);
    bf16_t* Ub = (bf16_t*)(ws + WS_U); float* TAB = (float*)(ws + WS_TAB); float* SSQ1 = (float*)(ws + WS_SSQ1); float* SSQ2 = (float*)(ws + WS_SSQ2); bf16_t* ACT = (bf16_t*)(ws + WS_ACT);
    constexpr int P2B_SMEM = (64 * 129 * 2 + 64 * 65 * 2 + 192) * 4, SCAN_SMEM = (128 * 128 + 64 * 128 * 2 + 64 * 64) * 4;
    static bool init = false;
    if (!init) {
        init = true;
        (void)hipFuncSetAttribute((const void*)k_gemm<pg8::EpiProj, true>, hipFuncAttributeMaxDynamicSharedMemorySize, GEMM_LDS);
        (void)hipFuncSetAttribute((const void*)k_gemm<pg8::EpiRes, false>, hipFuncAttributeMaxDynamicSharedMemorySize, GEMM_LDS);
        (void)hipFuncSetAttribute((const void*)k_gemm<pg8::EpiFfn1, true>, hipFuncAttributeMaxDynamicSharedMemorySize, GEMM_LDS);
        (void)hipFuncSetAttribute((const void*)k_p2b_ref, hipFuncAttributeMaxDynamicSharedMemorySize, P2B_SMEM);
        (void)hipFuncSetAttribute((const void*)k_scan_ref, hipFuncAttributeMaxDynamicSharedMemorySize, SCAN_SMEM);
    }
    k_wt<<<dim3(NPROJ / 32, DM / 32), 256, 0, stream>>>(w_in, DM, DIN, 0, NPROJ, nullptr, WIN_T);
    k_wt<<<dim3(DM / 32, DM / 32), 256, 0, stream>>>(w_out, DM, DM, 0, DM, nullptr, WOUT_T);
    k_wt<<<dim3(DFF / 32, DM / 32), 256, 0, stream>>>(w_ffn_in, DM, DFF, 0, DFF, norm_ffn_w, W1_T);
    k_wt<<<dim3(DM / 32, DFF / 32), 256, 0, stream>>>(w_ffn_out, DFF, DM, 0, DM, nullptr, W2_T);
    k_p0_rows<<<M, 256, 0, stream>>>(x, norm_mix_w, w_in, XN, GATES);
    { pg8::Gemm g{XN, WIN_T, M, NPROJ, DM}; pg8::EpiProj e{QC, KV, QKVG, Z}; k_gemm<pg8::EpiProj, true><<<256, 512, GEMM_LDS, stream>>>(g, e); }
    k_p2a<<<dim3(M, GH), 128, 0, stream>>>(QKVG, conv_w, QHAT, KHAT, KHT, VHT);
    k_p2b_ref<<<NUNIT * 2, 64, P2B_SMEM, stream>>>(QHAT, KHAT, VHT, GATES, a_log, dt_bias, Wb, Ub, QKb, TAB);
    k_scan_ref<<<16, 128, SCAN_SMEM, stream>>>(QHAT, KHT, Wb, Ub, QKb, TAB, ODIR);
    k_attn_ref<<<dim3(M / 64, AH), 64, 0, stream>>>(QC, KV, rel_bias, attn_sink);
    k_p4<<<dim3(M, GH), 128, 0, stream>>>(ODIR, Z, gdn_norm_w, QC);
    { pg8::Gemm g{QC, WOUT_T, M, DM, DM}; pg8::EpiRes e{x, out, HB, SSQ1}; k_gemm<pg8::EpiRes, false><<<256, 512, GEMM_LDS, stream>>>(g, e); }
    { pg8::Gemm g{HB, W1_T, M, DFF, DM}; pg8::EpiFfn1 e{ACT, SSQ1}; k_gemm<pg8::EpiFfn1, true><<<256, 512, GEMM_LDS, stream>>>(g, e); }
    { pg8::Gemm g{ACT, W2_T, M, DM, DFF}; pg8::EpiRes e{out, out, nullptr, SSQ2}; k_gemm<pg8::EpiRes, false><<<256, 512, GEMM_LDS, stream>>>(g, e); }
    k_final<<<M, 256, 0, stream>>>(out, SSQ2, norm_final_w);
}
```

```cpp
#include <hip/hip_runtime.h>
#include <cstdio>
#include <cstdint>

constexpr int BATCH = 2, SEQ = 8192, DM = 1024, M = BATCH * SEQ;
constexpr int AH = 8, AKVH = 2, AHD = 64, WIN = 128;
constexpr int GH = 4, GD = 128, CONVK = 5, CHUNK = 64, NCH = SEQ / CHUNK;
constexpr int DFF = 4096, DIN = 2832, NPROJ = 2816;
constexpr float EPS = 1e-6f;
constexpr int NUNIT = BATCH * GH * NCH;

constexpr size_t MiB = 1u << 20;
constexpr size_t WS_CTL = 0, CTL_ZERO_BYTES = 1 * MiB;
constexpr size_t WS_WIN = 1 * MiB;
constexpr size_t WS_WOUT = 7 * MiB;
constexpr size_t WS_W1 = 9 * MiB;
constexpr size_t WS_W2 = 17 * MiB;
constexpr size_t WS_GATES = 25 * MiB;
constexpr size_t WS_XN = 26 * MiB;
constexpr size_t WS_QHAT = 26 * MiB, WS_KHT = 42 * MiB, WS_HB = 26 * MiB;
constexpr size_t WS_QC = 58 * MiB;
constexpr size_t WS_KV = 90 * MiB;
constexpr size_t WS_Z = 98 * MiB;
constexpr size_t WS_QKVG = 114 * MiB;
constexpr size_t WS_W = 114 * MiB, WS_QK = 146 * MiB;
constexpr size_t WS_TMP = 162 * MiB;
constexpr size_t WS_KHAT = 162 * MiB, WS_VHT = 178 * MiB, WS_ODIR = 162 * MiB;
constexpr size_t WS_U = 194 * MiB;
constexpr size_t WS_TAB = 226 * MiB;
constexpr size_t WS_SSQ1 = 228 * MiB;
constexpr size_t WS_SSQ2 = 229 * MiB;
constexpr size_t WS_ACT = 58 * MiB;
constexpr size_t WS_END = 256 * MiB;
static_assert(WS_ACT + (size_t)M * DFF * 2 <= WS_U && WS_SSQ2 + (size_t)M * 16 * 4 <= WS_END, "d_ws map");

typedef unsigned short bf16_t;
__host__ __device__ __forceinline__ unsigned f2bf(float f) { unsigned u = __builtin_bit_cast(unsigned, f); return (u + 0x7fffu + ((u >> 16) & 1u)) >> 16; }
__host__ __device__ __forceinline__ float bf2f(unsigned h) { return __builtin_bit_cast(float, (h & 0xffffu) << 16); }
__host__ __device__ __forceinline__ unsigned pk2(float lo, float hi) { return f2bf(lo) | (f2bf(hi) << 16); }

__host__ __device__ __forceinline__ int kperm(int a) { return (a & ~31) | ((a & 12) << 1) | ((a & 16) >> 2) | (a & 3); }
__host__ __device__ __forceinline__ int offA(int row, int col) { const int p = kperm(col); return row * 128 + ((((p >> 3) ^ (row & 15)) << 3) | (p & 7)); }
__host__ __device__ __forceinline__ int offT(int row, int col) { const int p = kperm(col); return row * 64 + ((((p >> 3) ^ ((row >> 1) & 7)) << 3) | (p & 7)); }
__host__ __device__ __forceinline__ int offU(int c, int dv) { return (((dv >> 4) * 4 + (c >> 4)) * 64 + ((c >> 2) & 3) * 16 + (dv & 15)) * 4 + (c & 3); }
constexpr int BLOB = 64 * 128;
constexpr int QKBLOB = 64 * 64;
constexpr int TABW = 192;
namespace pg8 {
#define PG8_LAS __attribute__((address_space(3)))
typedef unsigned short bf16_t;
typedef short bf16x8 __attribute__((ext_vector_type(8)));
typedef float f32x4 __attribute__((ext_vector_type(4)));
typedef unsigned u32x4 __attribute__((ext_vector_type(4)));
constexpr int BM = 256, BK = 64, HALF = 128, HTB = HALF * BK * 2  , STAGE_BYTES = 8 * HTB, NXCD = 8, WGM = 8;

__host__ __device__ __forceinline__ int lds_byte(int r, int c) { const int st = (r >> 4) * 2 + (c >> 5), rr = r & 15, cc = c & 31, ob = rr * 64 + cc * 2; return st * 1024 + (ob ^ (((ob >> 9) & 1) << 5)); }
__host__ __device__ __forceinline__ void stage_rc(int b, int& R, int& C) { const int st = b / 1024, sb = b % 1024, swz = sb ^ (((sb >> 9) & 1) << 5); R = (st >> 1) * 16 + swz / 64; C = (st & 1) * 32 + (swz % 64) / 2; }
__host__ __device__ __forceinline__ int perm32(int rho) { const int n = rho >> 4, i = rho & 15; return 8 * (i >> 2) + 4 * n + (i & 3); }

struct Unit { int pm, pn; };
struct Gemm { const bf16_t* A; const bf16_t* Bt; int M, N, K, pad; };

struct StaticOrder {
    int nM, nN, nwg, G, c;
    __host__ __device__ void init(int M, int N, int G_, int c_) { nM = M / BM; nN = N / BM; nwg = nM * nN; G = G_; c = c_; }
    __host__ __device__ bool next(int i, Unit& u) const {
        const long L = (long)i * G + c; if (L >= nwg) return false;
        int wgid = (int)L; { const int q = nwg / NXCD, r = nwg % NXCD, xcd = wgid % NXCD, off = wgid / NXCD; wgid = (xcd < r ? xcd * (q + 1) : r * (q + 1) + (xcd - r) * q) + off; }
        const int nig = WGM * nN, gid = wgid / nig, fm = gid * WGM, gsz = (nM - fm) < WGM ? (nM - fm) : WGM;
        u.pm = fm + ((wgid % nig) % gsz); u.pn = (wgid % nig) / gsz; return true;
    }
    __device__ __forceinline__ void a_ready(const Unit&) const {}
    __device__ __forceinline__ void done(const Unit&) const {}
};

__device__ __forceinline__ unsigned cvt_pk_bf16(float lo, float hi) { unsigned r; asm volatile("v_cvt_pk_bf16_f32 %0, %1, %2" : "=v"(r) : "v"(lo), "v"(hi)); return r; }
typedef float f32x2 __attribute__((ext_vector_type(2)));
__device__ __forceinline__ f32x2 gelu_pk(f32x2 v) {
    const f32x2 av = __builtin_elementwise_abs(v), d = av * 0.2316418882f + 1.0f;
    f32x2 t; t.x = __builtin_amdgcn_rcpf(d.x); t.y = __builtin_amdgcn_rcpf(d.y);
    f32x2 q = t * 0.5307027145f + (-0.7265760135f); q = q * t + 0.7107068705f; q = q * t + (-0.142248368f); q = q * t + 0.127414796f; q = q * t;
    const f32x2 s = (v * v) * (-0.72134752044f);
    f32x2 e; e.x = __builtin_amdgcn_exp2f(s.x); e.y = __builtin_amdgcn_exp2f(s.y);
    const f32x2 m = v * (q * e), r = v - m;
    f32x2 o; o.x = v.x < 0.f ? m.x : r.x; o.y = v.y < 0.f ? m.y : r.y; return o;
}

template <int ACT  > struct EpiBf16 {
    static constexpr bool PERM = true, AFTER_DRAIN = false; static_assert(ACT == 0 || ACT == 1, "EpiBf16: ACT is 0 (none) or 1 (gelu_pk)");
    bf16_t* O; int ldc; const float* bias; int split_cols; size_t split_stride; float scale0;
    __device__ __forceinline__ void operator()(const f32x4 (&acc)[2][2][4][2], const Unit& u, int wr, int wc, int fr, int fq) const {
        const int row0 = u.pm * BM + wr * 64 + fr; int colt = u.pn * BM; bf16_t* base = O;
        float sc = 1.f; if (split_cols) { const int t = colt / split_cols; base += (size_t)t * split_stride; colt -= t * split_cols; if (t == 0) sc = scale0; }
        const int col0 = colt + wc * 32 + 8 * fq, bcol0 = u.pn * BM + wc * 32 + 8 * fq;
        f32x4 bv[2][2];
#pragma unroll
        for (int bj = 0; bj < 2; ++bj)
#pragma unroll
            for (int n = 0; n < 2; ++n) bv[bj][n] = bias ? *(const f32x4*)(bias + bcol0 + bj * HALF + 4 * n) : (f32x4){0.f, 0.f, 0.f, 0.f};
#pragma unroll
        for (int ai = 0; ai < 2; ++ai)
#pragma unroll
            for (int m = 0; m < 4; ++m) { bf16_t* rowp = base + (size_t)(row0 + ai * HALF + m * 16) * ldc + col0;
#pragma unroll
                for (int bj = 0; bj < 2; ++bj) { f32x4 v0 = acc[ai][bj][m][0] + bv[bj][0], v1 = acc[ai][bj][m][1] + bv[bj][1];
                    if (ACT == 1) { f32x2 a = gelu_pk((f32x2){v0[0], v0[1]}), b = gelu_pk((f32x2){v0[2], v0[3]}), c = gelu_pk((f32x2){v1[0], v1[1]}), d = gelu_pk((f32x2){v1[2], v1[3]});
                        v0 = (f32x4){a.x, a.y, b.x, b.y}; v1 = (f32x4){c.x, c.y, d.x, d.y}; }
                    v0 = v0 * sc; v1 = v1 * sc; u32x4 w; w.x = cvt_pk_bf16(v0[0], v0[1]); w.y = cvt_pk_bf16(v0[2], v0[3]); w.z = cvt_pk_bf16(v1[0], v1[1]); w.w = cvt_pk_bf16(v1[2], v1[3]);
                    *(u32x4*)(rowp + bj * HALF) = w; } }
    }
};

struct PanelStats {
    unsigned* xbuf;
    unsigned* cnt;
    unsigned* tmo;
    int ntn; float eps;
    unsigned code;
    __device__ __forceinline__ bool run(const f32x4 (&v)[2][2][4][2], const Unit& u, int wr, int wc, int fr, int fq, PG8_LAS unsigned char* lds, int wid, int lane) const {
        typedef float f32x2v __attribute__((ext_vector_type(2)));
        PG8_LAS f32x2v* P = (PG8_LAS f32x2v*)lds;
        PG8_LAS f32x2v* S = (PG8_LAS f32x2v*)(lds + 8192);
        PG8_LAS unsigned* flag = (PG8_LAS unsigned*)(lds + 8192 + 2048);
#pragma unroll
        for (int ai = 0; ai < 2; ++ai)
#pragma unroll
            for (int m = 0; m < 4; ++m) {
                float s = 0.f;
#pragma unroll
                for (int bj = 0; bj < 2; ++bj)
#pragma unroll
                    for (int n = 0; n < 2; ++n) { const f32x4 x = v[ai][bj][m][n]; s += (x[0] + x[1]) + (x[2] + x[3]); }
                s += __shfl_xor(s, 16); s += __shfl_xor(s, 32);
                const float mw = s * (1.0f / 64.0f); float q = 0.f;
#pragma unroll
                for (int bj = 0; bj < 2; ++bj)
#pragma unroll
                    for (int n = 0; n < 2; ++n) { const f32x4 d = v[ai][bj][m][n] - mw; q += (d[0] * d[0] + d[1] * d[1]) + (d[2] * d[2] + d[3] * d[3]); }
                q += __shfl_xor(q, 16); q += __shfl_xor(q, 32);
                if (fq == 0) P[(ai * HALF + wr * 64 + m * 16 + fr) * 4 + wc] = (f32x2v){mw, q};
            }
        asm volatile("s_waitcnt lgkmcnt(0)" ::: "memory"); __builtin_amdgcn_s_barrier(); asm volatile("" ::: "memory");
#if defined(BROKEN_EXCHANGE_NO_WAIT)
#warning BROKEN CONTROL BUILD: the row-statistics exchange does not wait; results are wrong by design
        if (blockIdx.x >= 64) { const long long t0_ = clock64(); while (clock64() - t0_ < 60000) __builtin_amdgcn_s_sleep(8); }
#endif
        const int row = wid * 32 + (lane & 31);
        if (lane < 32) {
            const f32x2v a = P[row * 4 + 0], b = P[row * 4 + 1], c = P[row * 4 + 2], d = P[row * 4 + 3];
            const float mt = (a.x + b.x + c.x + d.x) * 0.25f;
            const float da = a.x - mt, db = b.x - mt, dc = c.x - mt, dd = d.x - mt;
            const float m2 = (a.y + b.y) + (c.y + d.y) + 64.0f * ((da * da + db * db) + (dc * dc + dd * dd));
            unsigned long long* slot = (unsigned long long*)xbuf + ((size_t)(u.pm * BM + row) * 4 + u.pn);
            __hip_atomic_store(slot, ((unsigned long long)__float_as_uint(m2) << 32) | __float_as_uint(mt), __ATOMIC_RELAXED, __HIP_MEMORY_SCOPE_AGENT);
        }
        asm volatile("s_waitcnt vmcnt(0)" ::: "memory");
        if (lane == 0) __hip_atomic_fetch_add(cnt + 64 * u.pm, 1u, __ATOMIC_RELAXED, __HIP_MEMORY_SCOPE_AGENT);
        if (wid == 0) {
            bool dead = false; const unsigned long long t0 = __builtin_amdgcn_s_memrealtime(); const unsigned want = 8u * (unsigned)ntn;
            for (;;) {
#if defined(BROKEN_EXCHANGE_NO_WAIT)
                break;
#endif
                if ((unsigned)__builtin_amdgcn_readfirstlane(__hip_atomic_load(cnt + 64 * u.pm, __ATOMIC_RELAXED, __HIP_MEMORY_SCOPE_AGENT)) >= want) break;
                if (__builtin_amdgcn_s_memrealtime() - t0 > 2000000ull) {
                    if (lane == 0) { unsigned expect = 0u; __hip_atomic_compare_exchange_strong(tmo + 1, &expect, code | (unsigned)(u.pm & 0xff), __ATOMIC_RELAXED, __ATOMIC_RELAXED, __HIP_MEMORY_SCOPE_AGENT);
                                     __hip_atomic_store(tmo, 1u, __ATOMIC_RELAXED, __HIP_MEMORY_SCOPE_AGENT); }
                    dead = true; break; }
                __builtin_amdgcn_s_sleep(2);
            }
            __builtin_amdgcn_fence(__ATOMIC_ACQUIRE, "agent");
            if (lane == 0) flag[0] = dead ? 1u : 0u;
        }
        asm volatile("s_waitcnt vmcnt(0) lgkmcnt(0)" ::: "memory"); __builtin_amdgcn_s_barrier(); asm volatile("" ::: "memory");
        const bool bad = flag[0] != 0u;
        if (lane < 32) {
            const unsigned long long* slot = (const unsigned long long*)xbuf + (size_t)(u.pm * BM + row) * 4; float mt[4], m2[4]; float ms = 0.f;
#pragma unroll
            for (int t = 0; t < 4; ++t) { if (t < ntn) { const unsigned long long w = __hip_atomic_load(slot + t, __ATOMIC_RELAXED, __HIP_MEMORY_SCOPE_AGENT); mt[t] = __uint_as_float((unsigned)w); m2[t] = __uint_as_float((unsigned)(w >> 32)); } else { mt[t] = 0.f; m2[t] = 0.f; } ms += mt[t]; }
            const float mean = ms / (float)ntn; float q = 0.f;
#pragma unroll
            for (int t = 0; t < 4; ++t) if (t < ntn) { const float dm = mt[t] - mean; q += m2[t] + 256.0f * dm * dm; }
            S[row] = (f32x2v){mean, 1.0f / sqrtf(q / (256.0f * (float)ntn) + eps)};
        }
        asm volatile("s_waitcnt lgkmcnt(0)" ::: "memory"); __builtin_amdgcn_s_barrier(); asm volatile("" ::: "memory");
        return bad;
    }
};
struct EpiLnRes {
    static constexpr bool PERM = false, AFTER_DRAIN = true;
    const float* base; float* out; int ldc; const float* bias; PanelStats st; unsigned poison;
    __device__ __forceinline__ void fused(f32x4 (&acc)[2][2][4][2], const Unit& u, int wr, int wc, int fr, int fq, PG8_LAS unsigned char* lds, int wid, int lane) const {
        typedef float f32x2v __attribute__((ext_vector_type(2)));
        const PG8_LAS f32x2v* S = (const PG8_LAS f32x2v*)(lds + 8192);
        const int col0 = u.pn * BM + wc * 32 + 4 * fq;
#pragma unroll
        for (int bj = 0; bj < 2; ++bj)
#pragma unroll
            for (int n = 0; n < 2; ++n) { const f32x4 bv = bias ? *(const f32x4*)(bias + col0 + bj * HALF + n * 16) : (f32x4){0.f, 0.f, 0.f, 0.f};
#pragma unroll
                for (int ai = 0; ai < 2; ++ai)
#pragma unroll
                    for (int m = 0; m < 4; ++m) acc[ai][bj][m][n] += bv; }
        f32x4 pre[4][2][2];
#pragma unroll
        for (int m = 0; m < 4; ++m) { const size_t off = (size_t)(u.pm * BM + wr * 64 + m * 16 + fr) * ldc + col0;
#pragma unroll
            for (int bj = 0; bj < 2; ++bj)
#pragma unroll
                for (int n = 0; n < 2; ++n) pre[m][bj][n] = *(const f32x4*)(base + off + bj * HALF + n * 16); }
        const bool bad = st.run(acc, u, wr, wc, fr, fq, lds, wid, lane) || poison != 0u;
        const float qnan = __builtin_nanf("");
#pragma unroll
        for (int ai = 0; ai < 2; ++ai)
#pragma unroll
            for (int m = 0; m < 4; ++m) { const int r = ai * HALF + wr * 64 + m * 16 + fr; const f32x2v sr = S[r]; const size_t off = (size_t)(u.pm * BM + r) * ldc + col0;
#pragma unroll
                for (int bj = 0; bj < 2; ++bj)
#pragma unroll
                    for (int n = 0; n < 2; ++n) { const f32x4 bs = ai == 0 ? pre[m][bj][n] : *(const f32x4*)(base + off + bj * HALF + n * 16); f32x4 o = bs + (acc[ai][bj][m][n] - sr.x) * sr.y;
                        if (bad) o = (f32x4){qnan, qnan, qnan, qnan}; *(f32x4*)(out + off + bj * HALF + n * 16) = o; }
                if (m & 1) asm volatile("" ::: "memory"); }
    }
};
struct EpiLnResLn {
    static constexpr bool PERM = false, AFTER_DRAIN = true;
    const float* base; float* out; bf16_t* xn; int ldc; const float* bias; PanelStats st1, st2; unsigned poison;
    __device__ __forceinline__ void fused(f32x4 (&acc)[2][2][4][2], const Unit& u, int wr, int wc, int fr, int fq, PG8_LAS unsigned char* lds, int wid, int lane) const {
        typedef float f32x2v __attribute__((ext_vector_type(2))); typedef unsigned u32x2v __attribute__((ext_vector_type(2)));
        const PG8_LAS f32x2v* S = (const PG8_LAS f32x2v*)(lds + 8192);
        const int col0 = u.pn * BM + wc * 32 + 4 * fq;
#pragma unroll
        for (int bj = 0; bj < 2; ++bj)
#pragma unroll
            for (int n = 0; n < 2; ++n) { const f32x4 bv = bias ? *(const f32x4*)(bias + col0 + bj * HALF + n * 16) : (f32x4){0.f, 0.f, 0.f, 0.f};
#pragma unroll
                for (int ai = 0; ai < 2; ++ai)
#pragma unroll
                    for (int m = 0; m < 4; ++m) acc[ai][bj][m][n] += bv; }
        bool bad = st1.run(acc, u, wr, wc, fr, fq, lds, wid, lane) || poison != 0u;
        const float qnan = __builtin_nanf("");
#pragma unroll
        for (int ai = 0; ai < 2; ++ai)
#pragma unroll
            for (int m = 0; m < 4; ++m) { const int r = ai * HALF + wr * 64 + m * 16 + fr; const f32x2v sr = S[r]; const size_t off = (size_t)(u.pm * BM + r) * ldc + col0;
#pragma unroll
                for (int bj = 0; bj < 2; ++bj)
#pragma unroll
                    for (int n = 0; n < 2; ++n) { const f32x4 bs = *(const f32x4*)(base + off + bj * HALF + n * 16); acc[ai][bj][m][n] = bs + (acc[ai][bj][m][n] - sr.x) * sr.y; }
                asm volatile("" : "+v"(acc[ai][0][m][0]), "+v"(acc[ai][0][m][1]), "+v"(acc[ai][1][m][0]), "+v"(acc[ai][1][m][1]));
                if (m & 1) asm volatile("" ::: "memory"); }
        const bool bad1 = bad;
        bad = st2.run(acc, u, wr, wc, fr, fq, lds, wid, lane) || bad;
#pragma unroll
        for (int ai = 0; ai < 2; ++ai)
#pragma unroll
            for (int m = 0; m < 4; ++m) { const int r = ai * HALF + wr * 64 + m * 16 + fr; const f32x2v sr = S[r]; const size_t off = (size_t)(u.pm * BM + r) * ldc + col0;
#pragma unroll
                for (int bj = 0; bj < 2; ++bj)
#pragma unroll
                    for (int n = 0; n < 2; ++n) { const f32x4 x1 = acc[ai][bj][m][n]; *(f32x4*)(out + off + bj * HALF + n * 16) = bad1 ? (f32x4){qnan, qnan, qnan, qnan} : x1;
                        const f32x4 o = (x1 - sr.x) * sr.y; u32x2v w; w.x = cvt_pk_bf16(o[0], o[1]); w.y = cvt_pk_bf16(o[2], o[3]);
                        if (bad) { w.x = 0x7fc07fc0u; w.y = 0x7fc07fc0u; } *(u32x2v*)(xn + off + bj * HALF + n * 16) = w; }
                asm volatile("" ::: "memory"); }
    }
};

template <class Epi, class Sched, bool ALIGN_EPI = false, bool SP2 = false>
__device__ __forceinline__ void gemm_phase(PG8_LAS unsigned char* lds, const Gemm g, const Sched& S, const Epi& E) {
    const int tid = threadIdx.x, wid = __builtin_amdgcn_readfirstlane(tid >> 6), lane = tid & 63, wr = wid >> 2, wc = wid & 3, fr = lane & 15, fq = lane >> 4;
    const int K = g.K, nt = K / BK;
    unsigned voffA[2], voffB[2];
#pragma unroll
    for (int i = 0; i < 2; ++i) { int R, C; stage_rc(tid * 16 + i * 8192, R, C); const int Rb = Epi::PERM ? ((R & ~31) + perm32(R & 31)) : R;
        voffA[i] = (unsigned)(R * K + C) * 2u; voffB[i] = (unsigned)(Rb * K + C) * 2u; }
    const size_t kstep = (size_t)(BK * 2);
    const size_t hstep = (size_t)HALF * K * 2;
    const size_t tstep = 2 * hstep;
    const unsigned ldsw = (unsigned)wid * 1024u;
    const int aoff = lds_byte(wr * 64 + fr, fq * 8), boff = lds_byte(wc * 32 + fr, fq * 8);
#define PG8_SA(b, h) (((b) * 2 + (h)) * HTB)
#define PG8_SB(b, h) ((4 + (b) * 2 + (h)) * HTB)
#define PG8_STAGE(bufoff, gbase, voff) do { _Pragma("unroll") for (int _i = 0; _i < 2; ++_i) \
        __builtin_amdgcn_global_load_lds((const unsigned*)((const char*)(gbase) + (voff)[_i]), (PG8_LAS unsigned*)(lds + (bufoff) + ldsw + _i * 8192), 16, 0, 0); } while (0)
#define PG8_LDA(dst, b, h) do { _Pragma("unroll") for (int m = 0; m < 4; ++m) _Pragma("unroll") for (int k = 0; k < 2; ++k) dst[m][k] = *(const PG8_LAS bf16x8*)(lds + PG8_SA(b, h) + aoff + m * 2048 + k * 1024); } while (0)
#define PG8_LDB(dst, b, h) do { _Pragma("unroll") for (int n = 0; n < 2; ++n) _Pragma("unroll") for (int k = 0; k < 2; ++k) dst[n][k] = *(const PG8_LAS bf16x8*)(lds + PG8_SB(b, h) + boff + n * 2048 + k * 1024); } while (0)
#define PG8_MMA(ai, bj, At, Bt) do { __builtin_amdgcn_s_setprio(1); _Pragma("unroll") for (int m = 0; m < 4; ++m) _Pragma("unroll") for (int n = 0; n < 2; ++n) _Pragma("unroll") for (int k = 0; k < 2; ++k) \
        acc[ai][bj][m][n] = __builtin_amdgcn_mfma_f32_16x16x32_bf16(Bt[n][k], At[m][k], acc[ai][bj][m][n], 0, 0, 0); __builtin_amdgcn_s_setprio(0); } while (0)
#define PG8_WAIT_V(n) asm volatile("s_waitcnt vmcnt(" #n ")" ::: "memory")
#define PG8_WAIT_L(n) asm volatile("s_waitcnt lgkmcnt(" #n ")" ::: "memory")
#define PG8_BAR __builtin_amdgcn_s_barrier()
#define PG8_SCHED __builtin_amdgcn_sched_barrier(0)
    Unit cur, nxt; int ui = 0;
    if (!S.next(0, cur)) return;
    f32x4 acc[2][2][4][2];
#pragma unroll
    for (int a = 0; a < 2; ++a)
#pragma unroll
        for (int b = 0; b < 2; ++b)
#pragma unroll
            for (int m = 0; m < 4; ++m)
#pragma unroll
                for (int n = 0; n < 2; ++n) acc[a][b][m][n] = (f32x4){0.f, 0.f, 0.f, 0.f};
    bf16x8 At[4][2], B0[2][2], B1[2][2];
    const char* cA = (const char*)g.A + (size_t)cur.pm * tstep; const char* cB = (const char*)g.Bt + (size_t)cur.pn * tstep;
    S.a_ready(cur);
    if constexpr (SP2) {
        PG8_STAGE(PG8_SB(0, 0), cB, voffB); PG8_STAGE(PG8_SB(0, 1), cB + hstep, voffB); PG8_STAGE(PG8_SA(0, 0), cA, voffA); PG8_STAGE(PG8_SA(0, 1), cA + hstep, voffA);
        if (wr == 1) PG8_BAR;
        PG8_WAIT_V(2); PG8_BAR;
        PG8_STAGE(PG8_SB(1, 0), cB + kstep, voffB); PG8_STAGE(PG8_SA(1, 0), cA + kstep, voffA); PG8_STAGE(PG8_SB(1, 1), cB + hstep + kstep, voffB);
        PG8_WAIT_V(6); PG8_BAR;
    } else {
        PG8_STAGE(PG8_SB(0, 0), cB, voffB); PG8_STAGE(PG8_SA(0, 0), cA, voffA); PG8_STAGE(PG8_SB(0, 1), cB + hstep, voffB); PG8_STAGE(PG8_SA(0, 1), cA + hstep, voffA);
        if (wr == 1) PG8_BAR;
        PG8_WAIT_V(4); PG8_BAR;
        PG8_STAGE(PG8_SB(1, 0), cB + kstep, voffB); PG8_STAGE(PG8_SA(1, 0), cA + kstep, voffA); PG8_STAGE(PG8_SB(1, 1), cB + hstep + kstep, voffB);
        PG8_WAIT_V(6); PG8_BAR;
    }
    for (;;) {
        const bool has_next = S.next(ui + 1, nxt);
        const char* nA = has_next ? (const char*)g.A + (size_t)nxt.pm * tstep : cA; const char* nB = has_next ? (const char*)g.Bt + (size_t)nxt.pn * tstep : cB;
        for (int t = 0; t < nt; t += 2) {
            const bool last = (t == nt - 2);
            const char* a1 = cA + (size_t)(t + 1) * kstep;
            const char* a2 = last ? nA : cA + (size_t)(t + 2) * kstep; const char* b2 = last ? nB : cB + (size_t)(t + 2) * kstep;
            const char* a3 = a2 + kstep; const char* b3 = b2 + kstep;
            if (last && has_next) S.a_ready(nxt);
            if constexpr (SP2) {
            PG8_LDB(B0, 0, 0); PG8_LDB(B1, 0, 1); PG8_SCHED; PG8_LDA(At, 0, 0); PG8_STAGE(PG8_SA(1, 1), a1 + hstep, voffA);
            PG8_WAIT_V(8); PG8_WAIT_L(0); PG8_BAR; PG8_MMA(0, 0, At, B0); PG8_MMA(0, 1, At, B1); PG8_BAR; PG8_SCHED;
            PG8_LDA(At, 0, 1); PG8_STAGE(PG8_SB(0, 0), b2, voffB); PG8_STAGE(PG8_SB(0, 1), b2 + hstep, voffB); PG8_STAGE(PG8_SA(0, 0), a2, voffA);
            PG8_WAIT_V(8); PG8_WAIT_L(0); PG8_BAR; PG8_MMA(1, 0, At, B0); PG8_MMA(1, 1, At, B1); PG8_BAR; PG8_SCHED;
            PG8_LDB(B0, 1, 0); PG8_LDB(B1, 1, 1); PG8_SCHED; PG8_LDA(At, 1, 0); PG8_STAGE(PG8_SA(0, 1), a2 + hstep, voffA);
            PG8_WAIT_V(8); PG8_WAIT_L(0); PG8_BAR; PG8_MMA(0, 0, At, B0); PG8_MMA(0, 1, At, B1); PG8_BAR; PG8_SCHED;
            PG8_LDA(At, 1, 1); PG8_STAGE(PG8_SB(1, 0), b3, voffB); PG8_STAGE(PG8_SB(1, 1), b3 + hstep, voffB); PG8_STAGE(PG8_SA(1, 0), a3, voffA);
            PG8_WAIT_V(8); PG8_WAIT_L(0); PG8_BAR; PG8_MMA(1, 0, At, B0); PG8_MMA(1, 1, At, B1); PG8_BAR; PG8_SCHED;
            } else {
            PG8_LDB(B0, 0, 0); PG8_SCHED; PG8_LDA(At, 0, 0); PG8_STAGE(PG8_SA(1, 1), a1 + hstep, voffA);
            PG8_WAIT_L(8); PG8_BAR; PG8_WAIT_L(0); PG8_MMA(0, 0, At, B0); PG8_BAR; PG8_SCHED;
            PG8_LDB(B1, 0, 1); PG8_STAGE(PG8_SB(0, 0), b2, voffB);
            PG8_BAR; PG8_WAIT_L(0); PG8_MMA(0, 1, At, B1); PG8_BAR;
            PG8_LDA(At, 0, 1); PG8_STAGE(PG8_SA(0, 0), a2, voffA);
            PG8_BAR; PG8_WAIT_L(0); PG8_MMA(1, 0, At, B0); PG8_BAR; PG8_SCHED;
            PG8_STAGE(PG8_SB(0, 1), b2 + hstep, voffB);
            PG8_WAIT_V(6); PG8_BAR; PG8_MMA(1, 1, At, B1); PG8_BAR;
            PG8_LDB(B0, 1, 0); PG8_SCHED; PG8_LDA(At, 1, 0); PG8_STAGE(PG8_SA(0, 1), a2 + hstep, voffA);
            PG8_WAIT_L(8); PG8_BAR; PG8_WAIT_L(0); PG8_MMA(0, 0, At, B0); PG8_BAR; PG8_SCHED;
            PG8_LDB(B1, 1, 1); PG8_STAGE(PG8_SB(1, 0), b3, voffB);
            PG8_BAR; PG8_WAIT_L(0); PG8_MMA(0, 1, At, B1); PG8_BAR;
            PG8_LDA(At, 1, 1); PG8_STAGE(PG8_SA(1, 0), a3, voffA);
            PG8_BAR; PG8_WAIT_L(0); PG8_MMA(1, 0, At, B0); PG8_BAR; PG8_SCHED;
            PG8_STAGE(PG8_SB(1, 1), b3 + hstep, voffB);
            PG8_WAIT_V(6); PG8_BAR; PG8_MMA(1, 1, At, B1); PG8_BAR;
            }
        }
        if constexpr (ALIGN_EPI) { if (wr == 0) PG8_BAR; }
        if constexpr (!Epi::AFTER_DRAIN) { E(acc, cur, wr, wc, fr, fq); S.done(cur); }
        if (!has_next) break;
#pragma unroll
        for (int a = 0; a < 2; ++a)
#pragma unroll
            for (int b = 0; b < 2; ++b)
#pragma unroll
                for (int m = 0; m < 4; ++m)
#pragma unroll
                    for (int n = 0; n < 2; ++n) acc[a][b][m][n] = (f32x4){0.f, 0.f, 0.f, 0.f};
        cur = nxt; cA = nA; cB = nB; ++ui;
        if constexpr (ALIGN_EPI) { if (wr == 1) PG8_BAR; }
    }
    PG8_WAIT_V(0);
    if constexpr (!ALIGN_EPI) { if (wr == 0) PG8_BAR; }
    PG8_BAR;
    if constexpr (Epi::AFTER_DRAIN) { E.fused(acc, cur, wr, wc, fr, fq, lds, wid, lane); S.done(cur); }
#undef PG8_SA
#undef PG8_SB
#undef PG8_STAGE
#undef PG8_LDA
#undef PG8_LDB
#undef PG8_MMA
#undef PG8_WAIT_V
#undef PG8_WAIT_L
#undef PG8_BAR
#undef PG8_SCHED
}
}
namespace pg8 {
struct EpiProj {
    static constexpr bool PERM = true, AFTER_DRAIN = false;
    bf16_t *QC, *KV, *QKVG, *Z;
    __device__ __forceinline__ void operator()(const f32x4 (&acc)[2][2][4][2], const Unit& u, int wr, int wc, int fr, int fq) const {
        const int pn = u.pn; bf16_t* base; int ldc, colt;
        if (pn < 2) { base = QC; ldc = 1024; colt = pn * 256; }
        else if (pn == 2) { base = KV; ldc = 256; colt = 0; }
        else if (pn < 9) { base = QKVG; ldc = 1536; colt = (pn - 3) * 256; }
        else { base = Z; ldc = 512; colt = (pn - 9) * 256; }
        const int row0 = u.pm * BM + wr * 64 + fr, col0 = colt + wc * 32 + 8 * fq;
#pragma unroll
        for (int ai = 0; ai < 2; ++ai)
#pragma unroll
            for (int m = 0; m < 4; ++m) { bf16_t* rowp = base + (size_t)(row0 + ai * HALF + m * 16) * ldc + col0;
#pragma unroll
                for (int bj = 0; bj < 2; ++bj) { const f32x4 v0 = acc[ai][bj][m][0], v1 = acc[ai][bj][m][1];
                    u32x4 w; w.x = cvt_pk_bf16(v0[0], v0[1]); w.y = cvt_pk_bf16(v0[2], v0[3]); w.z = cvt_pk_bf16(v1[0], v1[1]); w.w = cvt_pk_bf16(v1[2], v1[3]);
                    *(u32x4*)(rowp + bj * HALF) = w; } }
    }
};
struct EpiRes {
    static constexpr bool PERM = false, AFTER_DRAIN = false;
    const float* base; float* H; bf16_t* HB; float* SSQ;
    __device__ __forceinline__ void operator()(const f32x4 (&acc)[2][2][4][2], const Unit& u, int wr, int wc, int fr, int fq) const {
        typedef unsigned u32x2v __attribute__((ext_vector_type(2)));
        const int col0 = u.pn * BM + wc * 32 + 4 * fq;
#pragma unroll
        for (int ai = 0; ai < 2; ++ai)
#pragma unroll
            for (int m = 0; m < 4; ++m) { const int row = u.pm * BM + ai * HALF + wr * 64 + m * 16 + fr; const size_t off = (size_t)row * 1024 + col0; float ss = 0.f;
#pragma unroll
                for (int bj = 0; bj < 2; ++bj)
#pragma unroll
                    for (int n = 0; n < 2; ++n) { const f32x4 bs = *(const f32x4*)(base + off + bj * HALF + n * 16); const f32x4 hv = bs + acc[ai][bj][m][n];
                        *(f32x4*)(H + off + bj * HALF + n * 16) = hv; ss += (hv[0] * hv[0] + hv[1] * hv[1]) + (hv[2] * hv[2] + hv[3] * hv[3]);
                        if (HB) { u32x2v w; w.x = cvt_pk_bf16(hv[0], hv[1]); w.y = cvt_pk_bf16(hv[2], hv[3]); *(u32x2v*)(HB + off + bj * HALF + n * 16) = w; } }
                ss += __shfl_xor(ss, 16); ss += __shfl_xor(ss, 32);
                if (fq == 0) SSQ[(size_t)row * 16 + u.pn * 4 + wc] = ss; }
    }
};
struct EpiFfn1 {
    static constexpr bool PERM = true, AFTER_DRAIN = false;
    bf16_t* ACT; const float* SSQ;
    __device__ __forceinline__ void operator()(const f32x4 (&acc)[2][2][4][2], const Unit& u, int wr, int wc, int fr, int fq) const {
        const int row0 = u.pm * BM + wr * 64 + fr, col0 = u.pn * BM + wc * 32 + 8 * fq;
#pragma unroll
        for (int ai = 0; ai < 2; ++ai)
#pragma unroll
            for (int m = 0; m < 4; ++m) { const int row = row0 + ai * HALF + m * 16; const f32x4* sp = (const f32x4*)(SSQ + (size_t)row * 16);
                const f32x4 s0 = sp[0], s1 = sp[1], s2 = sp[2], s3 = sp[3]; const f32x4 st = (s0 + s1) + (s2 + s3);
                const float r = rsqrtf(((st[0] + st[1]) + (st[2] + st[3])) * (1.f / 1024.f) + 1e-6f);
                bf16_t* rowp = ACT + (size_t)row * 4096 + col0;
#pragma unroll
                for (int bj = 0; bj < 2; ++bj) { f32x4 v0 = acc[ai][bj][m][0] * r, v1 = acc[ai][bj][m][1] * r;
#pragma unroll
                    for (int e = 0; e < 4; ++e) { const float a = fmaxf(v0[e], 0.f), b = fmaxf(v1[e], 0.f); v0[e] = a * a; v1[e] = b * b; }
                    u32x4 w; w.x = cvt_pk_bf16(v0[0], v0[1]); w.y = cvt_pk_bf16(v0[2], v0[3]); w.z = cvt_pk_bf16(v1[0], v1[1]); w.w = cvt_pk_bf16(v1[2], v1[3]);
                    *(u32x4*)(rowp + bj * HALF) = w; } }
    }
};
}

constexpr int GEMM_LDS = 131072;
template <class Epi, bool ALIGN>
__global__ void __launch_bounds__(512, 2) k_gemm(pg8::Gemm g, Epi e) {
    extern __shared__ __attribute__((aligned(16))) unsigned char lds_g[];
    pg8::StaticOrder S; S.init(g.M, g.N, (int)gridDim.x, (int)blockIdx.x);
    pg8::gemm_phase<Epi, pg8::StaticOrder, ALIGN, true>((PG8_LAS unsigned char*)lds_g, g, S, e);
}
#define GAS __attribute__((address_space(1)))
typedef float f32x4 __attribute__((ext_vector_type(4)));

__global__ void k_wt(const float* __restrict__ W, int K, int ldw, int col0, int N, const float* __restrict__ kscale, bf16_t* __restrict__ WT) {
    __shared__ float tile[32][33];
    const int n0 = blockIdx.x * 32, k0 = blockIdx.y * 32, tx = threadIdx.x & 31, ty = threadIdx.x >> 5;
    for (int i = ty; i < 32; i += 8) { const int k = k0 + i; float v = W[(size_t)k * ldw + col0 + n0 + tx]; if (kscale) v *= kscale[k]; tile[i][tx] = v; }
    __syncthreads();
    for (int i = ty; i < 32; i += 8) WT[(size_t)(n0 + i) * K + k0 + tx] = (bf16_t)f2bf(tile[tx][i]);
}

__global__ void k_p0_rows(const float* __restrict__ x, const float* __restrict__ nw, const float* __restrict__ w_in, bf16_t* __restrict__ XN, float* __restrict__ GATES) {
    __shared__ float xs[DM]; __shared__ float red[256];
    const int m = blockIdx.x, t = threadIdx.x;
    float v[4], ss = 0.f;
    for (int i = 0; i < 4; ++i) { v[i] = x[(size_t)m * DM + t + 256 * i]; ss += v[i] * v[i]; }
    red[t] = ss; __syncthreads();
    for (int s = 128; s > 0; s >>= 1) { if (t < s) red[t] += red[t + s]; __syncthreads(); }
    const float r = rsqrtf(red[0] * (1.f / DM) + EPS);
    for (int i = 0; i < 4; ++i) { const int k = t + 256 * i; const float xn = v[i] * r * nw[k]; xs[k] = xn; XN[(size_t)m * DM + k] = (bf16_t)f2bf(xn); }
    __syncthreads();
    const int j = t >> 4, l = t & 15; float acc = 0.f;
    for (int k = l; k < DM; k += 16) acc += xs[k] * w_in[(size_t)k * DIN + NPROJ + j];
    for (int o = 8; o > 0; o >>= 1) acc += __shfl_xor(acc, o);
    if (l == 0) GATES[(size_t)m * 16 + j] = acc;
}

__global__ void k_p2a(const bf16_t* __restrict__ QKVG, const float* __restrict__ conv_w, bf16_t* __restrict__ QHAT, bf16_t* __restrict__ KHAT, bf16_t* __restrict__ KHT, bf16_t* __restrict__ VHT) {
    __shared__ float red[128];
    const int m = blockIdx.x, h = blockIdx.y, d = threadIdx.x, b = m / SEQ, t = m % SEQ, n = t / CHUNK, c = t % CHUNK;
    const size_t u = (size_t)((b * GH + h) * NCH + n);
    float s[3];
    for (int which = 0; which < 3; ++which) {
        const int ch = which * 512 + h * GD + d; float y = 0.f;
        for (int j = 0; j < CONVK; ++j) { const int tt = t - 2 + j; if (tt >= 0 && tt < SEQ) y += bf2f(QKVG[(size_t)(b * SEQ + tt) * 1536 + ch]) * conv_w[j * 1536 + ch]; }
        s[which] = y / (1.f + __expf(-y));
    }
    for (int which = 0; which < 2; ++which) {
        red[d] = s[which] * s[which]; __syncthreads();
        for (int st = 64; st > 0; st >>= 1) { if (d < st) red[d] += red[d + st]; __syncthreads(); }
        const float r = rsqrtf(red[0] + EPS); __syncthreads();
        s[which] *= r;
    }
    s[0] *= 0.08838834764831845f;
    QHAT[u * BLOB + offA(c, d)] = (bf16_t)f2bf(s[0]);
    KHAT[u * BLOB + offA(c, d)] = (bf16_t)f2bf(s[1]);
    KHT[u * BLOB + offT(d, c)] = (bf16_t)f2bf(s[1]);
    VHT[u * BLOB + offT(d, c)] = (bf16_t)f2bf(s[2]);
}

__global__ void k_p2b_ref(const bf16_t* __restrict__ QHAT, const bf16_t* __restrict__ KHAT, const bf16_t* __restrict__ VHT, const float* __restrict__ GATES,
                          const float* __restrict__ a_log, const float* __restrict__ dt_bias, bf16_t* __restrict__ Wb, bf16_t* __restrict__ Ub, bf16_t* __restrict__ QKb, float* __restrict__ TAB) {
    extern __shared__ float sm[];
    float* kf = sm;
    float* xf = kf + 64 * 129;
    float* A = xf + 64 * 129;
    float* T = A + 64 * 65;
    float* gc = T + 64 * 65;
    float* bet = gc + 64;
    float* gg = bet + 64;
    const int ud = blockIdx.x, u = ud >> 1, dir = ud & 1, p = threadIdx.x, c = dir ? 63 - p : p;
    const int n = u % NCH, bh = u / NCH, h = bh % GH, b = bh / GH;
    const int m = b * SEQ + n * CHUNK + c;
    {
        const float a = GATES[(size_t)m * 16 + dir * 4 + h], bb = GATES[(size_t)m * 16 + 8 + dir * 4 + h];
        const float z = a + dt_bias[dir * 4 + h];
        const float sp = (z > 20.f) ? z : log1pf(__expf(z));
        gg[p] = -__expf(a_log[dir * 4 + h]) * sp; bet[p] = 1.f / (1.f + __expf(-bb));
    }
    for (int d = 0; d < GD; ++d) kf[p * 129 + d] = bf2f(KHAT[(size_t)u * BLOB + offA(c, d)]);
    __syncthreads();
    { float s = 0.f; for (int j = 0; j <= p; ++j) s += gg[j]; gc[p] = s; }
    __syncthreads();
    for (int j = 0; j < 64; ++j) {
        float v = 0.f;
        if (j < p) { float dd = 0.f; for (int d = 0; d < GD; ++d) dd += kf[p * 129 + d] * kf[j * 129 + d]; v = bet[p] * dd * __expf(gc[p] - gc[j]); }
        A[p * 65 + j] = v;
    }
    __syncthreads();
    for (int j = 63; j >= 0; --j) {
        float acc = (j == p) ? 1.f : 0.f;
        if (j <= p) { for (int k = j + 1; k <= p; ++k) acc -= T[p * 65 + k] * A[k * 65 + j]; } else acc = 0.f;
        T[p * 65 + j] = acc;
    }
    for (int d = 0; d < GD; ++d) {
        float acc = 0.f;
        for (int j = 0; j <= p; ++j) acc += T[p * 65 + j] * bet[j] * __expf(gc[j]) * kf[j * 129 + d];
        Wb[(size_t)ud * BLOB + offA(c, d)] = (bf16_t)f2bf(-acc);
    }
    for (int d = 0; d < GD; ++d) xf[p * 129 + d] = bf2f(VHT[(size_t)u * BLOB + offT(d, c)]);
    __syncthreads();
    for (int d = 0; d < GD; ++d) {
        float acc = 0.f;
        for (int j = 0; j <= p; ++j) acc += T[p * 65 + j] * bet[j] * xf[j * 129 + d];
        Ub[(size_t)ud * BLOB + offU(c, d)] = (bf16_t)f2bf(acc);
    }
    __syncthreads();
    for (int d = 0; d < GD; ++d) xf[p * 129 + d] = bf2f(QHAT[(size_t)u * BLOB + offA(c, d)]);
    __syncthreads();
    for (int j = 0; j < 64; ++j) {
        float v = 0.f;
        if (j <= p) { float dd = 0.f; for (int d = 0; d < GD; ++d) dd += xf[p * 129 + d] * kf[j * 129 + d]; v = dd * __expf(gc[p] - gc[j]); }
        const int cj = dir ? 63 - j : j;
        QKb[(size_t)ud * QKBLOB + offT(c, cj)] = (bf16_t)f2bf(v);
    }
    TAB[(size_t)ud * TABW + c] = __expf(gc[p]);
    TAB[(size_t)ud * TABW + 64 + c] = __expf(gc[63] - gc[p]);
    if (p == 63) TAB[(size_t)ud * TABW + 128] = __expf(gc[63]);
}

__global__ void k_scan_ref(const bf16_t* __restrict__ QHAT, const bf16_t* __restrict__ KHT, const bf16_t* __restrict__ Wb, const bf16_t* __restrict__ Ub, const bf16_t* __restrict__ QKb,
                           const float* __restrict__ TAB, bf16_t* __restrict__ ODIR) {
    extern __shared__ float sm[];
    float* S = sm;
    float* vn = S + 128 * 128;
    float* Wl = vn + 64 * 128;
    float* Ql = Wl + 64 * 128;
    const int chain = blockIdx.x, dir = chain & 1, bh = chain >> 1, h = bh % GH, b = bh / GH, dv = threadIdx.x;
    for (int d = 0; d < 128; ++d) S[d * 128 + dv] = 0.f;
    for (int step = 0; step < NCH; ++step) {
        const int n = dir ? NCH - 1 - step : step; const size_t u = (size_t)bh * NCH + n, ud = u * 2 + dir;
        const float* tab = TAB + ud * TABW;
        __syncthreads();
        for (int i = dv; i < 64 * 128; i += 128) { const int c = i >> 7, d = i & 127; Wl[i] = bf2f(Wb[ud * BLOB + offA(c, d)]); }
        __syncthreads();
        for (int c = 0; c < 64; ++c) { float acc = bf2f(Ub[ud * BLOB + offU(c, dv)]); for (int d = 0; d < 128; ++d) acc += Wl[c * 128 + d] * S[d * 128 + dv]; vn[c * 128 + dv] = acc; }
        __syncthreads();
        for (int i = dv; i < 64 * 128; i += 128) { const int c = i >> 7, d = i & 127; Wl[i] = bf2f(QHAT[u * BLOB + offA(c, d)]); }
        for (int i = dv; i < 64 * 64; i += 128) { const int c = i >> 6, c2 = i & 63; Ql[i] = bf2f(QKb[ud * QKBLOB + offT(c, c2)]); }
        __syncthreads();
        for (int c = 0; c < 64; ++c) {
            float acc = 0.f; for (int d = 0; d < 128; ++d) acc += Wl[c * 128 + d] * S[d * 128 + dv];
            acc *= tab[c];
            for (int c2 = 0; c2 < 64; ++c2) acc += Ql[c * 64 + c2] * vn[c2 * 128 + dv];
            ODIR[((size_t)dir * M + (size_t)b * SEQ + n * CHUNK + c) * 512 + h * GD + dv] = (bf16_t)f2bf(acc);
        }
        __syncthreads();
        for (int i = dv; i < 64 * 128; i += 128) { const int c = i >> 7, d = i & 127; Wl[i] = bf2f(KHT[u * BLOB + offT(d, c)]); }
        __syncthreads();
        const float egl = tab[128];
        for (int d = 0; d < 128; ++d) { float acc = S[d * 128 + dv] * egl; for (int c = 0; c < 64; ++c) acc += Wl[c * 128 + d] * tab[64 + c] * vn[c * 128 + dv]; S[d * 128 + dv] = acc; }
    }
}

__host__ __device__ __forceinline__ int t5_bucket(int rel) {
    const int base = rel > 0 ? 16 : 0; const int n = rel < 0 ? -rel : rel;
    if (n < 8) return base + n;
    int k = (n >= 12) + (n >= 16) + (n >= 23) + (n >= 32) + (n >= 46) + (n >= 64) + (n >= 91) + (n >= 128);
    int large = 8 + k; if (large > 15) large = 15;
    return base + large;
}

__global__ void __launch_bounds__(64) k_attn_ref(bf16_t* QC, const bf16_t* __restrict__ KV, const float* __restrict__ rel_bias, const float* __restrict__ sink) {
    __shared__ float btab[257];
    const int h = blockIdx.y, m = blockIdx.x * 64 + threadIdx.x, b = m / SEQ, t = m % SEQ, kvh = h >> 2;
    for (int i = threadIdx.x; i < 257; i += 64) btab[i] = rel_bias[t5_bucket(i - 128) * AH + h];
    __syncthreads();
    float q[64], acc[64];
#pragma unroll
    for (int d = 0; d < 64; ++d) { q[d] = bf2f(QC[(size_t)m * 1024 + h * 64 + d]); acc[d] = 0.f; }
    float mx = -1e30f, l = 0.f;
    const int lo = t - WIN < 0 ? 0 : t - WIN, hi = t + WIN > SEQ - 1 ? SEQ - 1 : t + WIN;
    for (int kp = lo; kp <= hi; ++kp) {
        const bf16_t* kr = KV + (size_t)(b * SEQ + kp) * 256 + kvh * 64; const bf16_t* vr = kr + 128;
        float s = 0.f;
#pragma unroll
        for (int d = 0; d < 64; ++d) s += q[d] * bf2f(kr[d]);
        s = s * 0.125f + btab[kp - t + 128];
        const float mn = fmaxf(mx, s), f = __expf(mx - mn), pe = __expf(s - mn);
        l = l * f + pe; mx = mn;
#pragma unroll
        for (int d = 0; d < 64; ++d) acc[d] = acc[d] * f + pe * bf2f(vr[d]);
    }
    { const float s = sink[h]; const float mn = fmaxf(mx, s), f = __expf(mx - mn); l = l * f + __expf(s - mn);
#pragma unroll
      for (int d = 0; d < 64; ++d) acc[d] *= f; }
    const float il = 1.f / l;
#pragma unroll
    for (int d = 0; d < 64; ++d) QC[(size_t)m * 1024 + h * 64 + d] = (bf16_t)f2bf(acc[d] * il);
}

__global__ void k_p4(const bf16_t* __restrict__ ODIR, const bf16_t* __restrict__ Z, const float* __restrict__ gnw, bf16_t* __restrict__ QC) {
    __shared__ float red[128];
    const int m = blockIdx.x, h = blockIdx.y, d = threadIdx.x;
    const float o = bf2f(ODIR[(size_t)m * 512 + h * GD + d]) + bf2f(ODIR[((size_t)M + m) * 512 + h * GD + d]);
    red[d] = o * o; __syncthreads();
    for (int st = 64; st > 0; st >>= 1) { if (d < st) red[d] += red[d + st]; __syncthreads(); }
    const float r = rsqrtf(red[0] * (1.f / GD) + EPS);
    const float z = bf2f(Z[(size_t)m * 512 + h * GD + d]);
    QC[(size_t)m * 1024 + 512 + h * GD + d] = (bf16_t)f2bf(o * r * gnw[d] * (z / (1.f + __expf(-z))));
}

__global__ void k_final(float* __restrict__ out, const float* __restrict__ SSQ2, const float* __restrict__ nfw) {
    const int m = blockIdx.x, t = threadIdx.x;
    float ss = 0.f; for (int i = 0; i < 16; ++i) ss += SSQ2[(size_t)m * 16 + i];
    const float r = rsqrtf(ss * (1.f / DM) + EPS);
    for (int i = 0; i < 4; ++i) { const int k = t + 256 * i; out[(size_t)m * DM + k] = out[(size_t)m * DM + k] * r * nfw[k]; }
}
constexpr int NWAVES = 8;
constexpr int RING_BYTES = 131072;
constexpr int LDSCTL_OFF = RING_BYTES, MISC_OFF = LDSCTL_OFF + 320;
constexpr int LDS_BYTES = 147456;
constexpr int CW_TMO = 0, CW_CODE = 1, CW_BAR = 4096;
#define LAS __attribute__((address_space(3)))
typedef unsigned v4u __attribute__((ext_vector_type(4)));
typedef unsigned v2u __attribute__((ext_vector_type(2)));
typedef short bf16x8 __attribute__((ext_vector_type(8)));
typedef GAS unsigned gu32;
#define RLX_AGENT __ATOMIC_RELAXED, __HIP_MEMORY_SCOPE_AGENT
#define LDS_WAIT() asm volatile("s_waitcnt lgkmcnt(0)" ::: "memory")
#define VM_WAIT() asm volatile("s_waitcnt vmcnt(0)" ::: "memory")
#define XB_TMO      128
#define XB_XCNT(j)  (256  + 64 * (j))
#define XB_XSUB(j)  (1280 + 64 * (j))
#define XB_XGEN(j)  (2304 + 64 * (j))
#define XB_TOP      3328
#define XB_TOPGEN   3392
#define XCD_BAR_WORDS 3456
#define XB_SPIN_CAP (1u << 18)

__device__ __forceinline__ unsigned xb_ld(unsigned* p)              { return __hip_atomic_load(p, __ATOMIC_RELAXED, __HIP_MEMORY_SCOPE_AGENT); }
__device__ __forceinline__ unsigned xb_add(unsigned* p, unsigned v) { return __hip_atomic_fetch_add(p, v, __ATOMIC_RELAXED, __HIP_MEMORY_SCOPE_AGENT); }
__device__ __forceinline__ unsigned xb_xcc_id() { return (unsigned)__builtin_amdgcn_s_getreg((3 << 11) | 20) & 0xFu; }
#define XB_SPIN(cond, bar) do { unsigned _sp = 0; while (cond) { __builtin_amdgcn_s_sleep(1); \
    if ((++_sp & 255u) == 0u) { if (xb_ld(&(bar)[XB_TMO])) break; if (_sp > XB_SPIN_CAP) { atomicAdd(&(bar)[XB_TMO], 1u); break; } } } } while (0)

struct XcdBarrier {
    unsigned* bar; unsigned x;
    volatile LAS unsigned* st;
};

__device__ __forceinline__ XcdBarrier xcd_barrier_post(unsigned* bar, volatile LAS unsigned* st) {
    XcdBarrier b; b.bar = bar; b.x = xb_xcc_id(); b.st = st;
    if (threadIdx.x == 0) (void)xb_add(&bar[XB_XCNT(b.x)], 1u);
    return b;
}
__device__ __forceinline__ void xcd_barrier_complete(unsigned* bar, unsigned x, unsigned& nloc, unsigned& nx) {
    const unsigned G = gridDim.x * gridDim.y * gridDim.z;
    unsigned sum, cnt, mine, sp = 0u;
    for (;;) {
        sum = 0u; cnt = 0u; mine = 0u;
#pragma unroll
        for (unsigned j = 0; j < 16; ++j) { const unsigned c = xb_ld(&bar[XB_XCNT(j)]); sum += c; cnt += (c > 0u) ? 1u : 0u; mine = (j == x) ? c : mine; }
        if (sum == G) break;
        __builtin_amdgcn_s_sleep(1);
        if ((++sp & 255u) == 0u) { if (xb_ld(&bar[XB_TMO])) break; if (sp > XB_SPIN_CAP) { atomicAdd(&bar[XB_TMO], 1u); break; } }
    }
    nloc = mine > 0u ? mine : 1u; nx = cnt > 0u ? cnt : 1u;
}

__device__ __forceinline__ void xcd_barrier(const XcdBarrier& b) {
    asm volatile("s_waitcnt vmcnt(0)" ::: "memory");
    __syncthreads();
    if (threadIdx.x == 0) {
        unsigned* bar = b.bar;
        __builtin_amdgcn_s_waitcnt(0);
        unsigned nloc = b.st[0], nx = b.st[1];
        if (nloc == 0u) { xcd_barrier_complete(bar, b.x, nloc, nx); b.st[0] = nloc; b.st[1] = nx; }
        const unsigned old = xb_add(&bar[XB_XSUB(b.x)], 1u);
        const unsigned gen = old / nloc;
        if (old + 1u == (gen + 1u) * nloc) {
            __builtin_amdgcn_fence(__ATOMIC_RELEASE, "agent");
            asm volatile("s_waitcnt vmcnt(0)" ::: "memory");
            const unsigned og = xb_add(&bar[XB_TOP], 1u);
            const unsigned tg = og / nx;
            if (og + 1u == (tg + 1u) * nx) xb_add(&bar[XB_TOPGEN], 1u);
            else XB_SPIN(xb_ld(&bar[XB_TOPGEN]) == tg, bar);
            __builtin_amdgcn_fence(__ATOMIC_ACQUIRE, "agent");
            xb_add(&bar[XB_XGEN(b.x)], 1u);
            asm volatile("s_waitcnt vmcnt(0)" ::: "memory");
        } else {
            XB_SPIN(xb_ld(&bar[XB_XGEN(b.x)]) == gen, bar);
            __builtin_amdgcn_fence(__ATOMIC_ACQUIRE, "agent");
            asm volatile("s_waitcnt vmcnt(0)" ::: "memory");
        }
    }
    __syncthreads();
}
struct Frame {
    LAS unsigned char* lds; volatile LAS unsigned* MISC; gu32* ctl;
    int tid, lane, wave, vcu, G;
};
__device__ __forceinline__ float wave_sum(float v) {
#pragma unroll
    for (int o = 1; o < 64; o <<= 1) v += __shfl_xor(v, o);
    return v;
}
__device__ __forceinline__ void p0_transpose_item(const float* W, int K, int ldw, int N, const float* ksc, bf16_t* WT, LAS float* scr, int item, int lane) {
    const int nblk = N / 32, kb = item / nblk, nb = item % nblk, k0 = 64 * kb, n0 = 32 * nb;
#pragma unroll 8
    for (int i = 0; i < 32; ++i) { const int kk = 2 * i + (lane >> 5); float v = W[(size_t)(k0 + kk) * ldw + n0 + (lane & 31)]; if (ksc) v *= ksc[k0 + kk]; scr[kk * 33 + (lane & 31)] = v; }
    LDS_WAIT(); asm volatile("" ::: "memory");
    const int c = lane & 7;
#pragma unroll
    for (int j = 0; j < 4; ++j) { const int n = (lane >> 3) + 8 * j; const LAS float* s = scr + (8 * c) * 33 + n;
        v4u o; o.x = pk2(s[0 * 33], s[1 * 33]); o.y = pk2(s[2 * 33], s[3 * 33]); o.z = pk2(s[4 * 33], s[5 * 33]); o.w = pk2(s[6 * 33], s[7 * 33]);
        *(GAS v4u*)(WT + (size_t)(n0 + n) * K + k0 + 8 * c) = o; }
    LDS_WAIT(); asm volatile("" ::: "memory");
}
struct P0Args { const float *x, *nmw, *w_in, *w_out, *nfw, *w1, *w2; bf16_t *WIN_T, *WOUT_T, *W1_T, *W2_T, *XN; float* GATES; };
__device__ __forceinline__ void phase_p0(Frame& F, const P0Args& a) {
    LAS float* scr = (LAS float*)(F.lds + F.wave * 16384);
    const int gw = F.vcu * NWAVES + F.wave, NGW = F.G * NWAVES, lane = F.lane;
    constexpr int I_IN = (DM / 64) * (NPROJ / 32), I_O = (DM / 64) * (DM / 32), I_1 = (DM / 64) * (DFF / 32), I_2 = (DFF / 64) * (DM / 32);
    constexpr int NITEMS = I_IN + I_O + I_1 + I_2;
    for (int it = gw; it < NITEMS; it += NGW) {
        int r = it;
        if (r < I_IN) { p0_transpose_item(a.w_in, DM, DIN, NPROJ, nullptr, a.WIN_T, scr, r, lane); continue; } r -= I_IN;
        if (r < I_O) { p0_transpose_item(a.w_out, DM, DM, DM, nullptr, a.WOUT_T, scr, r, lane); continue; } r -= I_O;
        if (r < I_1) { p0_transpose_item(a.w1, DM, DFF, DFF, a.nfw, a.W1_T, scr, r, lane); continue; } r -= I_1;
        p0_transpose_item(a.w2, DFF, DM, DM, nullptr, a.W2_T, scr, r, lane);
    }
    __syncthreads();
    LAS float* GW = (LAS float*)F.lds;
    for (int k = F.tid; k < DM; k += NWAVES * 64) {
        const f32x4* src = (const f32x4*)(a.w_in + (size_t)k * DIN + NPROJ); const int kg = k >> 2, e = k & 3;
#pragma unroll
        for (int q = 0; q < 4; ++q) { const f32x4 w = src[q];
#pragma unroll
            for (int t = 0; t < 4; ++t) { const int i = q * 4 + t; GW[kg * 64 + ((i ^ (kg & 15)) << 2) + e] = w[t]; } }
    }
    __syncthreads();
    f32x4 nwv[4];
#pragma unroll
    for (int j = 0; j < 4; ++j) nwv[j] = *(const f32x4*)(a.nmw + 256 * j + 4 * lane);
    for (int m = gw; m < M; m += NGW) {
        const GAS f32x4* xr = (const GAS f32x4*)(a.x + (size_t)m * DM) + lane;
        f32x4 v[4]; float s = 0.f;
#pragma unroll
        for (int j = 0; j < 4; ++j) { v[j] = xr[64 * j]; s += (v[j].x * v[j].x + v[j].y * v[j].y) + (v[j].z * v[j].z + v[j].w * v[j].w); }
        const float r = rsqrtf(wave_sum(s) * (1.f / DM) + EPS);
        GAS unsigned long long* o8 = (GAS unsigned long long*)(a.XN + (size_t)m * DM) + lane;
        float acc[16];
#pragma unroll
        for (int i = 0; i < 16; ++i) acc[i] = 0.f;
#pragma unroll
        for (int j = 0; j < 4; ++j) {
            v[j] = v[j] * r * nwv[j];
            o8[64 * j] = (unsigned long long)pk2(v[j].x, v[j].y) | ((unsigned long long)pk2(v[j].z, v[j].w) << 32);
            const LAS float* base = GW + (64 * j + lane) * 64;
#pragma unroll
            for (int i = 0; i < 16; ++i) { const f32x4 w = *(const LAS f32x4*)(base + ((i ^ (lane & 15)) << 2)); acc[i] += (v[j].x * w.x + v[j].y * w.y) + (v[j].z * w.z + v[j].w * w.w);
                if ((i & 7) == 7) asm volatile("" ::: "memory"); }
        }
        float a8[8], a4[4], a2[2], a1;
        { const bool hb = (lane >> 5) & 1;
#pragma unroll
          for (int i = 0; i < 8; ++i) { const float send = hb ? acc[i] : acc[i + 8]; const float recv = __shfl_xor(send, 32); a8[i] = (hb ? acc[i + 8] : acc[i]) + recv; } }
        { const bool hb = (lane >> 4) & 1;
#pragma unroll
          for (int i = 0; i < 4; ++i) { const float send = hb ? a8[i] : a8[i + 4]; const float recv = __shfl_xor(send, 16); a4[i] = (hb ? a8[i + 4] : a8[i]) + recv; } }
        { const bool hb = (lane >> 3) & 1;
#pragma unroll
          for (int i = 0; i < 2; ++i) { const float send = hb ? a4[i] : a4[i + 2]; const float recv = __shfl_xor(send, 8); a2[i] = (hb ? a4[i + 2] : a4[i]) + recv; } }
        { const bool hb = (lane >> 2) & 1; const float send = hb ? a2[0] : a2[1]; const float recv = __shfl_xor(send, 4); a1 = (hb ? a2[1] : a2[0]) + recv; }
        a1 += __shfl_xor(a1, 2); a1 += __shfl_xor(a1, 1);
        if ((lane & 3) == 0) a.GATES[(size_t)m * 16 + (lane >> 2)] = a1;
    }
}
__device__ __forceinline__ void phase_p4(Frame& F, const bf16_t* ODIR, const bf16_t* Z, const float* gnw, bf16_t* QC) {
    const int gw = F.vcu * NWAVES + F.wave, NGW = F.G * NWAVES, lane = F.lane;
    const float g0 = gnw[2 * lane], g1 = gnw[2 * lane + 1];
    for (int idx = gw; idx < M * GH; idx += NGW) {
        const int m = idx >> 2, h = idx & 3;
        const unsigned of = *(const GAS unsigned*)(ODIR + (size_t)m * 512 + h * GD + 2 * lane), ob = *(const GAS unsigned*)(ODIR + ((size_t)M + m) * 512 + h * GD + 2 * lane);
        const unsigned zz = *(const GAS unsigned*)(Z + (size_t)m * 512 + h * GD + 2 * lane);
        const float o0 = bf2f(of) + bf2f(ob), o1 = bf2f(of >> 16) + bf2f(ob >> 16);
        const float r = rsqrtf(wave_sum(o0 * o0 + o1 * o1) * (1.f / GD) + EPS);
        const float z0 = bf2f(zz), z1 = bf2f(zz >> 16);
        *(GAS unsigned*)(QC + (size_t)m * 1024 + 512 + h * GD + 2 * lane) = pk2(o0 * r * g0 * (z0 / (1.f + __expf(-z0))), o1 * r * g1 * (z1 / (1.f + __expf(-z1))));
    }
}
__device__ __forceinline__ void phase_p8(Frame& F, float* out, const float* SSQ2, const float* nfw) {
    const int gw = F.vcu * NWAVES + F.wave, NGW = F.G * NWAVES, lane = F.lane;
    f32x4 wv[4];
#pragma unroll
    for (int j = 0; j < 4; ++j) wv[j] = *(const f32x4*)(nfw + 256 * j + 4 * lane);
    for (int m = gw; m < M; m += NGW) {
        const GAS f32x4* sp = (const GAS f32x4*)(SSQ2 + (size_t)m * 16);
        const f32x4 st = (sp[0] + sp[1]) + (sp[2] + sp[3]);
        const float r = rsqrtf(((st[0] + st[1]) + (st[2] + st[3])) * (1.f / DM) + EPS);
        GAS f32x4* xr = (GAS f32x4*)(out + (size_t)m * DM) + lane;
#pragma unroll
        for (int j = 0; j < 4; ++j) xr[64 * j] = xr[64 * j] * r * wv[j];
    }
}
constexpr size_t WS_VTP = 232 * MiB;
__host__ __device__ __forceinline__ int perm16(int a) { return (a & ~12) | ((a & 4) << 1) | ((a & 8) >> 1); }
__device__ __forceinline__ float silu_f(float y) { return y / (1.f + __expf(-y)); }
__device__ __forceinline__ void phase_p2a(Frame& F, const bf16_t* QKVG, const bf16_t* KV, const float* conv_w, bf16_t* QHAT, bf16_t* KHAT, bf16_t* KHT, bf16_t* VHT, bf16_t* VTP) {
    const int lane = F.lane, w = F.wave;
    const int upw = (NUNIT + F.G - 1) / F.G;
    const int cbase = 32 * (w >> 2) + 8 * ((w >> 1) & 1) + 4 * (w & 1);
    const int P0 = (cbase & 32) | ((cbase & 12) << 1);
    for (int ui = 0; ui < upw; ++ui) {
        const int u = F.vcu * upw + ui; if (u >= NUNIT) break;
        const int n = u % NCH, bh = u / NCH, h = bh % GH, b = bh / GH;
        float cw[CONVK][3][2];
#pragma unroll
        for (int j = 0; j < CONVK; ++j)
#pragma unroll
            for (int wh = 0; wh < 3; ++wh) { const float* p = conv_w + j * 1536 + wh * 512 + h * GD + 2 * lane; cw[j][wh][0] = p[0]; cw[j][wh][1] = p[1]; }
        unsigned kt[2][4], vt[2][4];
#pragma unroll
        for (int run = 0; run < 2; ++run) {
            const int c0 = cbase + 16 * run, t0 = n * CHUNK + c0;
            unsigned xw[8][3];
#pragma unroll
            for (int rr = 0; rr < 8; ++rr) { const int t = t0 - 2 + rr; const bool ok = (t >= 0) && (t < SEQ);
                const GAS unsigned* rp = (const GAS unsigned*)(QKVG + (size_t)(b * SEQ + (ok ? t : 0)) * 1536 + h * GD + 2 * lane);
#pragma unroll
                for (int wh = 0; wh < 3; ++wh) { const unsigned v = rp[wh * 256]; xw[rr][wh] = ok ? v : 0u; } }
            float kv0[4], kv1[4], vv0[4], vv1[4];
#pragma unroll
            for (int i = 0; i < 4; ++i) {
                float y[3][2];
#pragma unroll
                for (int wh = 0; wh < 3; ++wh) { float a0 = 0.f, a1 = 0.f;
#pragma unroll
                    for (int j = 0; j < CONVK; ++j) { a0 += bf2f(xw[i + j][wh]) * cw[j][wh][0]; a1 += bf2f(xw[i + j][wh] >> 16) * cw[j][wh][1]; }
                    y[wh][0] = silu_f(a0); y[wh][1] = silu_f(a1); }
                const float sq = wave_sum(y[0][0] * y[0][0] + y[0][1] * y[0][1]), sk = wave_sum(y[1][0] * y[1][0] + y[1][1] * y[1][1]);
                const float rq = rsqrtf(sq + EPS) * 0.08838834764831845f, rk = rsqrtf(sk + EPS);
                const int c = c0 + i;
                const float k0 = y[1][0] * rk, k1 = y[1][1] * rk;
                *(GAS unsigned*)(QHAT + (size_t)u * BLOB + offA(c, 2 * lane)) = pk2(y[0][0] * rq, y[0][1] * rq);
                *(GAS unsigned*)(KHAT + (size_t)u * BLOB + offA(c, 2 * lane)) = pk2(k0, k1);
                kv0[i] = k0; kv1[i] = k1; vv0[i] = y[2][0]; vv1[i] = y[2][1];
            }
            kt[0][2 * run] = pk2(kv0[0], kv0[1]); kt[0][2 * run + 1] = pk2(kv0[2], kv0[3]);
            kt[1][2 * run] = pk2(kv1[0], kv1[1]); kt[1][2 * run + 1] = pk2(kv1[2], kv1[3]);
            vt[0][2 * run] = pk2(vv0[0], vv0[1]); vt[0][2 * run + 1] = pk2(vv0[2], vv0[3]);
            vt[1][2 * run] = pk2(vv1[0], vv1[1]); vt[1][2 * run + 1] = pk2(vv1[2], vv1[3]);
        }
        const int chunk = (P0 >> 3) ^ (lane & 7);
#pragma unroll
        for (int e = 0; e < 2; ++e) { const size_t off = (size_t)u * BLOB + (size_t)(2 * lane + e) * 64 + chunk * 8;
            *(GAS v4u*)(KHT + off) = (v4u){kt[e][0], kt[e][1], kt[e][2], kt[e][3]};
            *(GAS v4u*)(VHT + off) = (v4u){vt[e][0], vt[e][1], vt[e][2], vt[e][3]}; }
    }
    const int gw = F.vcu * NWAVES + F.wave, NGW = F.G * NWAVES;
    for (int it = gw; it < BATCH * AKVH * (SEQ / 64); it += NGW) {
        const int tb = it % (SEQ / 64), bk = it / (SEQ / 64), kvh = bk % AKVH, b = bk / AKVH;
        const GAS bf16_t* src = (const GAS bf16_t*)(KV + (size_t)(b * SEQ + tb * 64) * 256 + 128 + kvh * 64 + lane);
        unsigned pkd[32];
#pragma unroll
        for (int i = 0; i < 32; ++i) pkd[i] = 0u;
#pragma unroll
        for (int tt = 0; tt < 64; ++tt) { const unsigned v = src[(size_t)tt * 256]; const int pos = perm16(tt); pkd[pos >> 1] |= (pos & 1) ? (v << 16) : v; }
        GAS v4u* dst = (GAS v4u*)(VTP + ((size_t)(b * AKVH + kvh) * 64 + lane) * SEQ + tb * 64);
#pragma unroll
        for (int q = 0; q < 8; ++q) dst[q] = (v4u){pkd[4 * q], pkd[4 * q + 1], pkd[4 * q + 2], pkd[4 * q + 3]};
    }
}
__host__ __device__ constexpr int kpinv(int p) { return (p & ~31) | ((p & 4) << 2) | ((p & 24) >> 1) | (p & 3); }
__device__ __forceinline__ bf16x8 fragA_g(const bf16_t* blob, int rt, int s, int fr, int g) { const int row = 16 * rt + fr; return *(const GAS bf16x8*)(blob + row * 128 + (((4 * s + g) ^ fr) << 3)); }
__device__ __forceinline__ bf16x8 fragT_g(const bf16_t* blob, int rt, int s, int fr, int g) { const int row = 16 * rt + fr; return *(const GAS bf16x8*)(blob + row * 64 + (((4 * s + g) ^ ((row >> 1) & 7)) << 3)); }
__device__ __forceinline__ bf16x8 fragT_l(const LAS unsigned char* img, int rt, int s, int fr, int g) { const int row = 16 * rt + fr; return *(const LAS bf16x8*)(img + row * 128 + (((4 * s + g) ^ ((row >> 1) & 7)) << 4)); }

template <int DIR>
__device__ __forceinline__ void p2b_write_ts(LAS unsigned char* img, const float (&T)[64], const LAS float* sct, int c, float sign) {
#pragma unroll
    for (int q = 0; q < 8; ++q) {
        const f32x4 s0 = *(const LAS f32x4*)(sct + 8 * q), s1 = *(const LAS f32x4*)(sct + 8 * q + 4);
        float v[8];
#pragma unroll
        for (int i = 0; i < 8; ++i) { const int cp = kpinv(8 * q + i); const int j = DIR ? 63 - cp : cp; v[i] = T[j] * (i < 4 ? s0[i] : s1[i - 4]) * sign; }
        v4u pw; pw.x = pk2(v[0], v[1]); pw.y = pk2(v[2], v[3]); pw.z = pk2(v[4], v[5]); pw.w = pk2(v[6], v[7]);
        *(LAS v4u*)(img + c * 128 + ((q ^ ((c >> 1) & 7)) << 4)) = pw;
        asm volatile("" ::: "memory");
    }
}

__device__ __forceinline__ void p2b_task(LAS unsigned char* R, LAS float* sct, int ud, int lane, const bf16_t* QHAT, const bf16_t* KHAT, const bf16_t* KHT, const bf16_t* VHT, const float* GATES,
                                         const float* a_log, const float* dt_bias, bf16_t* Wb, bf16_t* Ub, bf16_t* QKb, float* TAB) {
    const int fr = lane & 15, g = lane >> 4;
    const int u = ud >> 1, dir = ud & 1, n = u % NCH, bh = u / NCH, h = bh % GH, b = bh / GH;
    const int c = dir ? 63 - lane : lane;
    float beta, gc, glast;
    {
        const size_t m = (size_t)b * SEQ + n * CHUNK + c;
        const float a = GATES[m * 16 + dir * 4 + h], bb = GATES[m * 16 + 8 + dir * 4 + h];
        const float z = a + dt_bias[dir * 4 + h];
        const float sp = (z > 20.f) ? z : log1pf(__expf(z));
        float s = -__expf(a_log[dir * 4 + h]) * sp; beta = 1.f / (1.f + __expf(-bb));
#pragma unroll
        for (int o = 1; o < 64; o <<= 1) { const float t = __shfl_up(s, o); if (lane >= o) s += t; }
        gc = s; glast = __shfl(gc, 63);
        TAB[(size_t)ud * TABW + c] = __expf(gc); TAB[(size_t)ud * TABW + 64 + c] = __expf(glast - gc);
        if (lane == 63) TAB[(size_t)ud * TABW + 128] = __expf(glast);
    }
    sct[kperm(c)] = beta * __expf(gc); sct[64 + kperm(c)] = beta;
    float gcr[4][4], ber[4][4], gcc[4];
#pragma unroll
    for (int t = 0; t < 4; ++t) {
        { const int cc = 16 * t + fr; const int pl = dir ? 63 - cc : cc; gcc[t] = __shfl(gc, pl); }
#pragma unroll
        for (int r = 0; r < 4; ++r) { const int cr = 16 * t + 4 * g + r; const int pl = dir ? 63 - cr : cr; gcr[t][r] = __shfl(gc, pl); ber[t][r] = __shfl(beta, pl); }
    }
    const bf16_t* kb = KHAT + (size_t)u * BLOB; const bf16_t* qb = QHAT + (size_t)u * BLOB;
    LAS float* AT = (LAS float*)R;
    {
        bf16x8 kf[4][4];
#pragma unroll
        for (int t = 0; t < 4; ++t)
#pragma unroll
            for (int s = 0; s < 4; ++s) kf[t][s] = fragA_g(kb, t, s, fr, g);
#pragma unroll
        for (int ta = 0; ta < 4; ++ta)
#pragma unroll
            for (int tb = 0; tb < 4; ++tb) {
                f32x4 acc = (f32x4){0.f, 0.f, 0.f, 0.f};
#pragma unroll
                for (int s = 0; s < 4; ++s) acc = __builtin_amdgcn_mfma_f32_16x16x32_bf16(kf[ta][s], kf[tb][s], acc, 0, 0, 0);
                const int ccol = 16 * tb + fr; int pc = dir ? 63 - ccol : ccol; asm volatile("" : "+v"(pc));
                f32x4 v;
#pragma unroll
                for (int r = 0; r < 4; ++r) { const int crow = 16 * ta + 4 * g + r, pr = dir ? 63 - crow : crow;
                    const float e = __expf(fminf(gcr[ta][r] - gcc[tb], 0.f)); v[r] = (pc < pr) ? ber[ta][r] * acc[r] * e : 0.f; }
                const int pr0 = dir ? 63 - (16 * ta + 4 * g + 3) : 16 * ta + 4 * g;
                if (dir) v = (f32x4){v[3], v[2], v[1], v[0]};
                *(LAS f32x4*)(AT + pc * 64 + (pr0 ^ (4 * (pc & 15)))) = v;
            }
#pragma unroll
        for (int tb = 0; tb < 4; ++tb) {
            const int cq = 16 * tb + fr; int pq = dir ? 63 - cq : cq; asm volatile("" : "+v"(pq));
            bf16x8 qf[4];
#pragma unroll
            for (int s = 0; s < 4; ++s) qf[s] = fragA_g(qb, tb, s, fr, g);
#pragma unroll
            for (int sg = 0; sg < 2; ++sg) {
                f32x4 a0 = (f32x4){0.f, 0.f, 0.f, 0.f}, a1 = a0;
#pragma unroll
                for (int s = 0; s < 4; ++s) { a0 = __builtin_amdgcn_mfma_f32_16x16x32_bf16(kf[2 * sg][s], qf[s], a0, 0, 0, 0); a1 = __builtin_amdgcn_mfma_f32_16x16x32_bf16(kf[2 * sg + 1][s], qf[s], a1, 0, 0, 0); }
                float v[8];
#pragma unroll
                for (int r = 0; r < 4; ++r) {
                    { const int ck = 16 * (2 * sg) + 4 * g + r, pk = dir ? 63 - ck : ck; v[r] = (pk <= pq) ? a0[r] * __expf(fminf(gcc[tb] - gcr[2 * sg][r], 0.f)) : 0.f; }
                    { const int ck = 16 * (2 * sg + 1) + 4 * g + r, pk = dir ? 63 - ck : ck; v[4 + r] = (pk <= pq) ? a1[r] * __expf(fminf(gcc[tb] - gcr[2 * sg + 1][r], 0.f)) : 0.f; }
                }
                v4u pw; pw.x = pk2(v[0], v[1]); pw.y = pk2(v[2], v[3]); pw.z = pk2(v[4], v[5]); pw.w = pk2(v[6], v[7]);
                *(GAS v4u*)(QKb + (size_t)ud * QKBLOB + cq * 64 + (((4 * sg + g) ^ ((cq >> 1) & 7)) << 3)) = pw;
            }
        }
    }
    LDS_WAIT(); asm volatile("" ::: "memory");
    float T[64];
#pragma unroll
    for (int j = 63; j >= 0; --j) {
        int lj = lane; asm volatile("" : "+v"(lj));
        float acc = (lj == j) ? 1.f : 0.f;
#pragma unroll
        for (int k4 = ((j + 1) & ~3); k4 < 64; k4 += 4) {
            const f32x4 a = *(const LAS f32x4*)(AT + j * 64 + (k4 ^ (4 * (j & 15))));
#pragma unroll
            for (int e = 0; e < 4; ++e) if (k4 + e > j) acc -= T[k4 + e] * a[e];
        }
        T[j] = acc;
        asm volatile("" ::: "memory");
    }
    asm volatile("" ::: "memory");
    LAS unsigned char* Tw = R; LAS unsigned char* Tu = R + 8192;
    if (dir) { p2b_write_ts<1>(Tw, T, sct, c, -1.f); p2b_write_ts<1>(Tu, T, sct + 64, c, 1.f); }
    else { p2b_write_ts<0>(Tw, T, sct, c, -1.f); p2b_write_ts<0>(Tu, T, sct + 64, c, 1.f); }
    LDS_WAIT(); asm volatile("" ::: "memory");
    int lane2 = lane; asm volatile("" : "+v"(lane2));
    const int fr_ = fr, g_ = g; (void)fr_; (void)g_;
    #define fr (lane2 & 15)
    #define g (lane2 >> 4)
    #define lane lane2
    const bf16_t* ktb = KHT + (size_t)u * BLOB; const bf16_t* vtb = VHT + (size_t)u * BLOB;
#pragma unroll
    for (int sg = 0; sg < 4; ++sg) {
        bf16x8 ka[2][2];
#pragma unroll
        for (int i = 0; i < 2; ++i)
#pragma unroll
            for (int s2 = 0; s2 < 2; ++s2) ka[i][s2] = fragT_g(ktb, 2 * sg + i, s2, fr, g);
#pragma unroll
        for (int ct = 0; ct < 4; ++ct) {
            f32x4 a0 = (f32x4){0.f, 0.f, 0.f, 0.f}, a1 = a0;
#pragma unroll
            for (int s2 = 0; s2 < 2; ++s2) { const bf16x8 tb_ = fragT_l(Tw, ct, s2, fr, g);
                a0 = __builtin_amdgcn_mfma_f32_16x16x32_bf16(ka[0][s2], tb_, a0, 0, 0, 0); a1 = __builtin_amdgcn_mfma_f32_16x16x32_bf16(ka[1][s2], tb_, a1, 0, 0, 0); }
            const int cc = 16 * ct + fr;
            v4u pw; pw.x = pk2(a0[0], a0[1]); pw.y = pk2(a0[2], a0[3]); pw.z = pk2(a1[0], a1[1]); pw.w = pk2(a1[2], a1[3]);
            *(GAS v4u*)(Wb + (size_t)ud * BLOB + cc * 128 + (((4 * sg + g) ^ fr) << 3)) = pw;
        }
    }
#pragma unroll
    for (int ct = 0; ct < 4; ++ct) {
        bf16x8 ta_[2];
#pragma unroll
        for (int s2 = 0; s2 < 2; ++s2) ta_[s2] = fragT_l(Tu, ct, s2, fr, g);
#pragma unroll
        for (int vt = 0; vt < 8; ++vt) {
            f32x4 a0 = (f32x4){0.f, 0.f, 0.f, 0.f};
#pragma unroll
            for (int s2 = 0; s2 < 2; ++s2) a0 = __builtin_amdgcn_mfma_f32_16x16x32_bf16(ta_[s2], fragT_g(vtb, vt, s2, fr, g), a0, 0, 0, 0);
            v2u pw; pw.x = pk2(a0[0], a0[1]); pw.y = pk2(a0[2], a0[3]);
            *(GAS v2u*)(Ub + (size_t)ud * BLOB + (size_t)((vt * 4 + ct) * 64 + lane) * 4) = pw;
        }
    }
    LDS_WAIT(); asm volatile("" ::: "memory");
    #undef fr
    #undef g
    #undef lane
}
__device__ __forceinline__ void phase_p2b(Frame& F, const bf16_t* QHAT, const bf16_t* KHAT, const bf16_t* KHT, const bf16_t* VHT, const float* GATES,
                                          const float* a_log, const float* dt_bias, bf16_t* Wb, bf16_t* Ub, bf16_t* QKb, float* TAB) {
    const int gw = F.vcu * NWAVES + F.wave, NGW = F.G * NWAVES;
    LAS unsigned char* R = F.lds + F.wave * 16384; LAS float* sct = (LAS float*)(F.lds + RING_BYTES + 1024 + F.wave * 512);
    for (int ud = gw; ud < NUNIT * 2; ud += NGW) p2b_task(R, sct, ud, F.lane, QHAT, KHAT, KHT, VHT, GATES, a_log, dt_bias, Wb, Ub, QKb, TAB);
}
typedef float f32x4s __attribute__((ext_vector_type(4)));
__device__ __forceinline__ bf16x8 pack8(f32x4 a, f32x4 b) {
    v4u r; r.x = pk2(a[0], a[1]); r.y = pk2(a[2], a[3]); r.z = pk2(b[0], b[1]); r.w = pk2(b[2], b[3]); return __builtin_bit_cast(bf16x8, r);
}
constexpr int SC_W = 0, SC_Q = 16384, SC_K = 32768, SC_QK = 49152, SC_BUF = 57344;
__device__ __forceinline__ void scan_stage(LAS unsigned char* buf, const bf16_t* Wb, const bf16_t* QHAT, const bf16_t* KHT, const bf16_t* QKb, size_t u, size_t ud, int wave, int lane) {
#pragma unroll
    for (int i = 0; i < 7; ++i) {
        const int pc = wave + 8 * i;
        const bf16_t* src; int poff;
        if (pc < 16) { src = Wb + ud * BLOB; poff = pc; }
        else if (pc < 32) { src = QHAT + u * BLOB; poff = pc - 16; }
        else if (pc < 48) { src = KHT + u * BLOB; poff = pc - 32; }
        else { src = QKb + ud * QKBLOB; poff = pc - 48; }
        __builtin_amdgcn_global_load_lds((const unsigned*)((const char*)src + poff * 1024 + lane * 16), (LAS unsigned*)(buf + pc * 1024), 16, 0, 0);
    }
}
__device__ __forceinline__ void phase_scan(Frame& F, int chain, const bf16_t* QHAT, const bf16_t* KHT, const bf16_t* Wb, const bf16_t* Ub, const bf16_t* QKb, const float* TAB, bf16_t* ODIR) {
    const int lane = F.lane, w = F.wave, fr = lane & 15, g = lane >> 4;
    const int dir = chain & 1, bh = chain >> 1, h = bh % GH, b = bh / GH;
    f32x4 S[8];
#pragma unroll
    for (int t = 0; t < 8; ++t) S[t] = (f32x4){0.f, 0.f, 0.f, 0.f};
    const size_t u0 = (size_t)bh * NCH + (dir ? NCH - 1 : 0);
    scan_stage(F.lds, Wb, QHAT, KHT, QKb, u0, u0 * 2 + dir, w, lane);
    VM_WAIT(); __syncthreads();
    for (int step = 0; step < NCH; ++step) {
        const int n = dir ? NCH - 1 - step : step; const size_t u = (size_t)bh * NCH + n, ud = u * 2 + dir;
        LAS unsigned char* cur = F.lds + (step & 1) * SC_BUF; LAS unsigned char* nxt = F.lds + ((step + 1) & 1) * SC_BUF;
        if (step + 1 < NCH) { const int n2 = dir ? n - 1 : n + 1; const size_t u2 = (size_t)bh * NCH + n2; scan_stage(nxt, Wb, QHAT, KHT, QKb, u2, u2 * 2 + dir, w, lane); }
        v2u ub[4]; f32x4 eg[4], ek[4];
        const float* tab = TAB + ud * TABW;
#pragma unroll
        for (int ct = 0; ct < 4; ++ct) { ub[ct] = *(const GAS v2u*)(Ub + ud * BLOB + (size_t)((w * 4 + ct) * 64 + lane) * 4);
            eg[ct] = *(const GAS f32x4*)(tab + 16 * ct + 4 * g); ek[ct] = *(const GAS f32x4*)(tab + 64 + 16 * ct + 4 * g); }
        const float egl = tab[128];
        bf16x8 bS[4];
#pragma unroll
        for (int s = 0; s < 4; ++s) bS[s] = pack8(S[2 * s], S[2 * s + 1]);
        f32x4 vn[4], oa[4];
#pragma unroll
        for (int ct = 0; ct < 4; ++ct) {
            vn[ct] = (f32x4){bf2f(ub[ct].x), bf2f(ub[ct].x >> 16), bf2f(ub[ct].y), bf2f(ub[ct].y >> 16)};
            oa[ct] = (f32x4){0.f, 0.f, 0.f, 0.f};
            const int row = 16 * ct + fr;
#pragma unroll
            for (int s = 0; s < 4; ++s) {
                const int off = row * 256 + (((4 * s + g) ^ fr) << 4);
                const bf16x8 aw = *(const LAS bf16x8*)(cur + SC_W + off);
                const bf16x8 aq = *(const LAS bf16x8*)(cur + SC_Q + off);
                vn[ct] = __builtin_amdgcn_mfma_f32_16x16x32_bf16(aw, bS[s], vn[ct], 0, 0, 0);
                oa[ct] = __builtin_amdgcn_mfma_f32_16x16x32_bf16(aq, bS[s], oa[ct], 0, 0, 0);
            }
            oa[ct] = oa[ct] * eg[ct];
        }
        bf16x8 bV[2], bK[2];
#pragma unroll
        for (int s2 = 0; s2 < 2; ++s2) { bV[s2] = pack8(vn[2 * s2], vn[2 * s2 + 1]); bK[s2] = pack8(vn[2 * s2] * ek[2 * s2], vn[2 * s2 + 1] * ek[2 * s2 + 1]); }
#pragma unroll
        for (int ct = 0; ct < 4; ++ct) {
            const int row = 16 * ct + fr;
#pragma unroll
            for (int s2 = 0; s2 < 2; ++s2) {
                const bf16x8 aqk = *(const LAS bf16x8*)(cur + SC_QK + row * 128 + (((4 * s2 + g) ^ ((row >> 1) & 7)) << 4));
                oa[ct] = __builtin_amdgcn_mfma_f32_16x16x32_bf16(aqk, bV[s2], oa[ct], 0, 0, 0);
            }
            bf16_t* op = ODIR + ((size_t)dir * M + (size_t)b * SEQ + n * CHUNK + 16 * ct + 4 * g) * 512 + h * GD + 16 * w + fr;
#pragma unroll
            for (int r = 0; r < 4; ++r) op[(size_t)r * 512] = (bf16_t)f2bf(oa[ct][r]);
        }
#pragma unroll
        for (int t = 0; t < 8; ++t) {
            S[t] = S[t] * egl;
            const int row = 16 * t + fr;
#pragma unroll
            for (int s2 = 0; s2 < 2; ++s2) {
                const bf16x8 ak = *(const LAS bf16x8*)(cur + SC_K + row * 128 + (((4 * s2 + g) ^ ((row >> 1) & 7)) << 4));
                S[t] = __builtin_amdgcn_mfma_f32_16x16x32_bf16(ak, bK[s2], S[t], 0, 0, 0);
            }
        }
        VM_WAIT(); __syncthreads();
    }
}
typedef float f32x16 __attribute__((ext_vector_type(16)));
constexpr int AT_BTAB = 0;
constexpr int AT_WS = 8 * 260 * 4;
__device__ __forceinline__ void attn_tables(Frame& F, const float* rel_bias) {
    LAS float* bt = (LAS float*)(F.lds + AT_BTAB);
    for (int i = F.tid; i < 8 * 257; i += NWAVES * 64) { const int h = i / 257, r = i % 257; bt[h * 260 + r] = rel_bias[t5_bucket(r - 128) * AH + h]; }
    __syncthreads();
}
__device__ __forceinline__ void attn_task(Frame& F, int task, bf16_t* QC, const bf16_t* KV, const bf16_t* VTP, const float* sink) {
    const int lane = F.lane, q = lane & 31, hh = lane >> 5;
    const int gq = task & 3, qblk = (task >> 2) & 255, bk = task >> 10, kvh = bk & 1, b = bk >> 1, h = kvh * 4 + gq, q0 = qblk * 32;
    const LAS float* bt = (const LAS float*)(F.lds + AT_BTAB) + h * 260;
    LAS float* wsf = (LAS float*)(F.lds + AT_WS) + F.wave * 64;
    bf16x8 qf[4];
    { const bf16_t* qp = QC + (size_t)(b * SEQ + q0 + q) * 1024 + h * 64 + 8 * hh;
#pragma unroll
      for (int s = 0; s < 4; ++s) qf[s] = *(const GAS bf16x8*)(qp + 16 * s); }
    const int T0 = (qblk - 4 < 0) ? 0 : qblk - 4, T1 = (qblk + 4 > SEQ / 32 - 1) ? SEQ / 32 - 1 : qblk + 4;
    const bf16_t* kbase = KV + (size_t)(b * SEQ) * 256 + kvh * 64 + 8 * hh;
    const int qpos = q0 + q;
    float mx = sink[h];
    for (int T = T0; T <= T1; ++T) {
        f32x16 acc;
#pragma unroll
        for (int r = 0; r < 16; ++r) acc[r] = 0.f;
        const bf16_t* kp = kbase + (size_t)(32 * T + q) * 256;
#pragma unroll
        for (int s = 0; s < 4; ++s) { const bf16x8 kf = *(const GAS bf16x8*)(kp + 16 * s); acc = __builtin_amdgcn_mfma_f32_32x32x16_bf16(kf, qf[s], acc, 0, 0, 0); }
#pragma unroll
        for (int r = 0; r < 16; ++r) { const int key = 32 * T + (r & 3) + 8 * (r >> 2) + 4 * hh; const int rel = key - qpos;
            if (rel >= -WIN && rel <= WIN) mx = fmaxf(mx, acc[r] * 0.125f + bt[rel + 128]); }
    }
    mx = fmaxf(mx, __shfl_xor(mx, 32));
    f32x16 o0, o1;
#pragma unroll
    for (int r = 0; r < 16; ++r) { o0[r] = 0.f; o1[r] = 0.f; }
    float l = 0.f;
    const bf16_t* vbase = VTP + ((size_t)(b * AKVH + kvh) * 64 + q) * SEQ + 8 * hh;
    for (int T = T0; T <= T1; ++T) {
        f32x16 acc;
#pragma unroll
        for (int r = 0; r < 16; ++r) acc[r] = 0.f;
        const bf16_t* kp = kbase + (size_t)(32 * T + q) * 256;
#pragma unroll
        for (int s = 0; s < 4; ++s) { const bf16x8 kf = *(const GAS bf16x8*)(kp + 16 * s); acc = __builtin_amdgcn_mfma_f32_32x32x16_bf16(kf, qf[s], acc, 0, 0, 0); }
        float p[16];
#pragma unroll
        for (int r = 0; r < 16; ++r) { const int key = 32 * T + (r & 3) + 8 * (r >> 2) + 4 * hh; const int rel = key - qpos;
            const bool ok = (rel >= -WIN && rel <= WIN);
            const float sc = acc[r] * 0.125f + bt[ok ? rel + 128 : 128];
            p[r] = ok ? __expf(sc - mx) : 0.f; l += p[r]; }
#pragma unroll
        for (int s2 = 0; s2 < 2; ++s2) {
            v4u pw; pw.x = pk2(p[8 * s2], p[8 * s2 + 1]); pw.y = pk2(p[8 * s2 + 2], p[8 * s2 + 3]); pw.z = pk2(p[8 * s2 + 4], p[8 * s2 + 5]); pw.w = pk2(p[8 * s2 + 6], p[8 * s2 + 7]);
            const bf16x8 pa = __builtin_bit_cast(bf16x8, pw);
            const bf16x8 v0 = *(const GAS bf16x8*)(vbase + 32 * T + 16 * s2);
            const bf16x8 v1 = *(const GAS bf16x8*)(vbase + (size_t)32 * SEQ + 32 * T + 16 * s2);
            o0 = __builtin_amdgcn_mfma_f32_32x32x16_bf16(pa, v0, o0, 0, 0, 0);
            o1 = __builtin_amdgcn_mfma_f32_32x32x16_bf16(pa, v1, o1, 0, 0, 0);
        }
    }
    l += __shfl_xor(l, 32);
    l += __expf(sink[h] - mx);
    if (hh == 0) wsf[q] = 1.f / l;
    LDS_WAIT(); asm volatile("" ::: "memory");
    bf16_t* op = QC + (size_t)(b * SEQ + q0) * 1024 + h * 64 + q;
#pragma unroll
    for (int r = 0; r < 16; ++r) { const int qr = (r & 3) + 8 * (r >> 2) + 4 * hh; const float il = wsf[qr];
        op[(size_t)qr * 1024] = (bf16_t)f2bf(o0[r] * il); op[(size_t)qr * 1024 + 32] = (bf16_t)f2bf(o1[r] * il); }
    LDS_WAIT(); asm volatile("" ::: "memory");
}
__device__ __forceinline__ void phase_attn(Frame& F, int aw, int naw, bf16_t* QC, const bf16_t* KV, const bf16_t* VTP, const float* rel_bias, const float* sink) {
    attn_tables(F, rel_bias);
    for (int task = aw; task < BATCH * AKVH * 256 * 4; task += naw) attn_task(F, task, QC, KV, VTP, sink);
}
#define MIXER_PHASES \
    bf16_t* VTP = (bf16_t*)(ws + WS_VTP); (void)VTP; \
    if (IN(2)) { phase_p2a(F, QKVG, KV, conv_w, QHAT, KHAT, KHT, VHT, VTP); if (BOTH(2)) GRID_BAR(); } \
    if (IN(3)) { phase_p2b(F, QHAT, KHAT, KHT, VHT, GATES, a_log, dt_bias, Wb, Ub, QKb, TAB); if (BOTH(3)) GRID_BAR(); } \
    if (IN(4)) { if (blockIdx.x < 16) phase_scan(F, (int)blockIdx.x, QHAT, KHT, Wb, Ub, QKb, TAB, ODIR); \
                 else phase_attn(F, ((int)blockIdx.x - 16) * NWAVES + F.wave, (F.G - 16) * NWAVES, QC, KV, VTP, rel_bias, attn_sink); \
                 if (BOTH(4)) GRID_BAR(); }
#define HAVE_REF_MIXERS 1
#define REF_P2A k_p2a<<<dim3(M, GH), 128, 0, stream>>>((bf16_t*)(ws + WS_QKVG), (const float*)d_in[5], (bf16_t*)(ws + WS_QHAT), (bf16_t*)(ws + WS_KHAT), (bf16_t*)(ws + WS_KHT), (bf16_t*)(ws + WS_VHT));
#define REF_P2B k_p2b_ref<<<NUNIT * 2, 64, P2B_SMEM, stream>>>((bf16_t*)(ws + WS_QHAT), (bf16_t*)(ws + WS_KHAT), (bf16_t*)(ws + WS_VHT), (float*)(ws + WS_GATES), (const float*)d_in[6], (const float*)d_in[7], (bf16_t*)(ws + WS_W), (bf16_t*)(ws + WS_U), (bf16_t*)(ws + WS_QK), (float*)(ws + WS_TAB));
#define REF_SCAN k_scan_ref<<<16, 128, SCAN_SMEM, stream>>>((bf16_t*)(ws + WS_QHAT), (bf16_t*)(ws + WS_KHT), (bf16_t*)(ws + WS_W), (bf16_t*)(ws + WS_U), (bf16_t*)(ws + WS_QK), (float*)(ws + WS_TAB), (bf16_t*)(ws + WS_ODIR));
#define REF_ATTN k_attn_ref<<<dim3(M / 64, AH), 64, 0, stream>>>((bf16_t*)(ws + WS_QC), (bf16_t*)(ws + WS_KV), (const float*)d_in[3], (const float*)d_in[4]);
#define MEGA(lo, hi, idx) a.ph_lo = lo; a.ph_hi = hi; a.li = idx; hipLaunchKernelGGL(mega, dim3(grid), dim3(NWAVES * 64), LDS_BYTES, stream, a);
#define LAUNCH_PROGRAM { MEGA(0, 10, 0) }
struct Args { const float* in[14]; float* out; unsigned char* ws; int ph_lo, ph_hi, li, pad; };
__global__ void __launch_bounds__(NWAVES * 64, 2) mega(Args args) {
    extern __shared__ __attribute__((aligned(16))) unsigned char lds[];
    Frame F;
    F.lds = (LAS unsigned char*)lds; F.MISC = (volatile LAS unsigned*)(F.lds + MISC_OFF);
    F.tid = threadIdx.x; F.lane = F.tid & 63; F.wave = __builtin_amdgcn_readfirstlane(F.tid >> 6);
    F.G = gridDim.x; { const int bx = blockIdx.x; F.vcu = (F.G % 8 == 0) ? (bx % 8) * (F.G / 8) + bx / 8 : bx; }
    unsigned char* ws = args.ws; F.ctl = (gu32*)(ws + WS_CTL);
    const float* x = args.in[0]; const float* norm_mix_w = args.in[1]; const float* w_in = args.in[2];
    const float* rel_bias = args.in[3]; const float* attn_sink = args.in[4]; const float* conv_w = args.in[5];
    const float* a_log = args.in[6]; const float* dt_bias = args.in[7]; const float* gdn_norm_w = args.in[8];
    const float* w_out = args.in[9]; const float* norm_ffn_w = args.in[10]; const float* w_ffn_in = args.in[11];
    const float* w_ffn_out = args.in[12]; const float* norm_final_w = args.in[13]; float* out = args.out;
    bf16_t* WIN_T = (bf16_t*)(ws + WS_WIN); bf16_t* WOUT_T = (bf16_t*)(ws + WS_WOUT); bf16_t* W1_T = (bf16_t*)(ws + WS_W1); bf16_t* W2_T = (bf16_t*)(ws + WS_W2);
    float* GATES = (float*)(ws + WS_GATES); bf16_t* XN = (bf16_t*)(ws + WS_XN); bf16_t* QHAT = (bf16_t*)(ws + WS_QHAT); bf16_t* KHT = (bf16_t*)(ws + WS_KHT); bf16_t* HB = (bf16_t*)(ws + WS_HB);
    bf16_t* QC = (bf16_t*)(ws + WS_QC); bf16_t* KV = (bf16_t*)(ws + WS_KV); bf16_t* Z = (bf16_t*)(ws + WS_Z); bf16_t* QKVG = (bf16_t*)(ws + WS_QKVG);
    bf16_t* Wb = (bf16_t*)(ws + WS_W); bf16_t* QKb = (bf16_t*)(ws + WS_QK); bf16_t* KHAT = (bf16_t*)(ws + WS_KHAT); bf16_t* VHT = (bf16_t*)(ws + WS_VHT); bf16_t* ODIR = (bf16_t*)(ws + WS_ODIR);
    bf16_t* Ub = (bf16_t*)(ws + WS_U); float* TAB = (float*)(ws + WS_TAB); float* SSQ1 = (float*)(ws + WS_SSQ1); float* SSQ2 = (float*)(ws + WS_SSQ2); bf16_t* ACT = (bf16_t*)(ws + WS_ACT);
    (void)rel_bias; (void)attn_sink; (void)conv_w; (void)a_log; (void)dt_bias; (void)QHAT; (void)KHT; (void)QKVG; (void)Wb; (void)QKb; (void)KHAT; (void)VHT; (void)Ub; (void)TAB; (void)KV;
    for (int u = F.tid; u < (LDS_BYTES - LDSCTL_OFF) / 4; u += NWAVES * 64) ((LAS unsigned*)(F.lds + LDSCTL_OFF))[u] = 0u;
    __syncthreads();
    XcdBarrier bar = xcd_barrier_post((unsigned*)(F.ctl + CW_BAR) + args.li * XCD_BAR_WORDS, F.MISC + 8);
    const int lo = args.ph_lo, hi = args.ph_hi;
#define IN(k) (lo <= (k) && (k) < hi)
#define BOTH(k) (IN(k) && IN((k) + 1))
#define GRID_BAR() xcd_barrier(bar)
    if (IN(0)) { P0Args a{x, norm_mix_w, w_in, w_out, norm_ffn_w, w_ffn_in, w_ffn_out, WIN_T, WOUT_T, W1_T, W2_T, XN, GATES}; phase_p0(F, a); if (BOTH(0)) GRID_BAR(); }
    if (IN(1)) { pg8::Gemm g{XN, WIN_T, M, NPROJ, DM, 0}; pg8::StaticOrder S; S.init(M, NPROJ, F.G, (int)blockIdx.x); pg8::EpiProj E{QC, KV, QKVG, Z};
        pg8::gemm_phase<pg8::EpiProj, pg8::StaticOrder, true, true>(F.lds, g, S, E); if (BOTH(1)) GRID_BAR(); }
    MIXER_PHASES
    if (IN(5)) { phase_p4(F, ODIR, Z, gdn_norm_w, QC); if (BOTH(5)) GRID_BAR(); }
    if (IN(6)) { pg8::Gemm g{QC, WOUT_T, M, DM, DM, 0}; pg8::StaticOrder S; S.init(M, DM, F.G, (int)blockIdx.x); pg8::EpiRes E{x, out, HB, SSQ1};
        pg8::gemm_phase<pg8::EpiRes, pg8::StaticOrder, false, true>(F.lds, g, S, E); if (BOTH(6)) GRID_BAR(); }
    if (IN(7)) { pg8::Gemm g{HB, W1_T, M, DFF, DM, 0}; pg8::StaticOrder S; S.init(M, DFF, F.G, (int)blockIdx.x); pg8::EpiFfn1 E{ACT, SSQ1};
        pg8::gemm_phase<pg8::EpiFfn1, pg8::StaticOrder, true, true>(F.lds, g, S, E); if (BOTH(7)) GRID_BAR(); }
    if (IN(8)) { pg8::Gemm g{ACT, W2_T, M, DM, DFF, 0}; pg8::StaticOrder S; S.init(M, DM, F.G, (int)blockIdx.x); pg8::EpiRes E{out, out, nullptr, SSQ2};
        pg8::gemm_phase<pg8::EpiRes, pg8::StaticOrder, false, true>(F.lds, g, S, E); if (BOTH(8)) GRID_BAR(); }
    if (IN(9)) { phase_p8(F, out, SSQ2, norm_final_w); }
#undef IN
#undef BOTH
}
extern "C" void kernel_launch(void* const* d_in, const int* in_sizes, int n_in, void* d_out, int out_size, void* d_ws, size_t ws_size, hipStream_t stream) {
    static int grid = 0;
    constexpr int P2B_SMEM = (64 * 129 * 2 + 64 * 65 * 2 + 192) * 4, SCAN_SMEM = (128 * 128 + 64 * 128 * 2 + 64 * 64) * 4;
    if (grid == 0) {
        if (n_in != 14 || ws_size < WS_END) { fprintf(stderr, "kernel_launch: unexpected inputs (n_in %d, ws %zu)\n", n_in, ws_size); grid = -1; return; }
        int dev = 0, cus = 0, per_cu = 0;
        if (hipGetDevice(&dev) != hipSuccess || hipDeviceGetAttribute(&cus, hipDeviceAttributeMultiprocessorCount, dev) != hipSuccess) { grid = -1; return; }
        if (hipFuncSetAttribute((const void*)mega, hipFuncAttributeMaxDynamicSharedMemorySize, LDS_BYTES) != hipSuccess) { fprintf(stderr, "kernel_launch: hipFuncSetAttribute failed\n"); grid = -1; return; }
        if (hipOccupancyMaxActiveBlocksPerMultiprocessor(&per_cu, (const void*)mega, NWAVES * 64, LDS_BYTES) != hipSuccess || per_cu < 1) { fprintf(stderr, "kernel_launch: occupancy query says %d\n", per_cu); per_cu = 1; }
        (void)hipGetLastError();
        grid = cus * 1;
#ifdef HAVE_REF_MIXERS
        (void)hipFuncSetAttribute((const void*)k_p2b_ref, hipFuncAttributeMaxDynamicSharedMemorySize, P2B_SMEM);
        (void)hipFuncSetAttribute((const void*)k_scan_ref, hipFuncAttributeMaxDynamicSharedMemorySize, SCAN_SMEM);
#endif
    }
    if (grid < 0) return;
    if (hipMemsetAsync((char*)d_ws + WS_CTL, 0, CTL_ZERO_BYTES, stream) != hipSuccess) return;
    Args a{};
    for (int i = 0; i < 14; ++i) a.in[i] = (const float*)d_in[i];
    a.out = (float*)d_out; a.ws = (unsigned char*)d_ws;
    LAUNCH_PROGRAM
}
```

```cpp
#include <hip/hip_runtime.h>
#include <cstdio>
#include <cstdint>

constexpr int BATCH = 2, SEQ = 8192, DM = 1024, M = BATCH * SEQ;
constexpr int AH = 8, AKVH = 2, AHD = 64, WIN = 128;
constexpr int GH = 4, GD = 128, CONVK = 5, CHUNK = 64, NCH = SEQ / CHUNK;
constexpr int DFF = 4096, DIN = 2832, NPROJ = 2816;
constexpr float EPS = 1e-6f;
constexpr int NUNIT = BATCH * GH * NCH;

constexpr size_t MiB = 1u << 20;
constexpr size_t WS_CTL = 0, CTL_ZERO_BYTES = 1 * MiB;
constexpr size_t WS_WIN = 1 * MiB;
constexpr size_t WS_WOUT = 7 * MiB;
constexpr size_t WS_W1 = 9 * MiB;
constexpr size_t WS_W2 = 17 * MiB;
constexpr size_t WS_GATES = 25 * MiB;
constexpr size_t WS_XN = 26 * MiB;
constexpr size_t WS_QHAT = 26 * MiB, WS_KHT = 42 * MiB, WS_HB = 26 * MiB;
constexpr size_t WS_QC = 58 * MiB;
constexpr size_t WS_KV = 90 * MiB;
constexpr size_t WS_Z = 98 * MiB;
constexpr size_t WS_QKVG = 114 * MiB;
constexpr size_t WS_W = 114 * MiB, WS_QK = 146 * MiB;
constexpr size_t WS_TMP = 162 * MiB;
constexpr size_t WS_KHAT = 162 * MiB, WS_VHT = 178 * MiB, WS_ODIR = 162 * MiB;
constexpr size_t WS_U = 194 * MiB;
constexpr size_t WS_TAB = 226 * MiB;
constexpr size_t WS_SSQ1 = 228 * MiB;
constexpr size_t WS_SSQ2 = 229 * MiB;
constexpr size_t WS_ACT = 58 * MiB;
constexpr size_t WS_END = 256 * MiB;
static_assert(WS_ACT + (size_t)M * DFF * 2 <= WS_U && WS_SSQ2 + (size_t)M * 16 * 4 <= WS_END, "d_ws map");

typedef unsigned short bf16_t;
__host__ __device__ __forceinline__ unsigned f2bf(float f) { unsigned u = __builtin_bit_cast(unsigned, f); return (u + 0x7fffu + ((u >> 16) & 1u)) >> 16; }
__host__ __device__ __forceinline__ float bf2f(unsigned h) { return __builtin_bit_cast(float, (h & 0xffffu) << 16); }
__host__ __device__ __forceinline__ unsigned pk2(float lo, float hi) { return f2bf(lo) | (f2bf(hi) << 16); }

__host__ __device__ __forceinline__ int kperm(int a) { return (a & ~31) | ((a & 12) << 1) | ((a & 16) >> 2) | (a & 3); }
__host__ __device__ __forceinline__ int offA(int row, int col) { const int p = kperm(col); return row * 128 + ((((p >> 3) ^ (row & 15)) << 3) | (p & 7)); }
__host__ __device__ __forceinline__ int offT(int row, int col) { const int p = kperm(col); return row * 64 + ((((p >> 3) ^ ((row >> 1) & 7)) << 3) | (p & 7)); }
__host__ __device__ __forceinline__ int offU(int c, int dv) { return (((dv >> 4) * 4 + (c >> 4)) * 64 + ((c >> 2) & 3) * 16 + (dv & 15)) * 4 + (c & 3); }
constexpr int BLOB = 64 * 128;
constexpr int QKBLOB = 64 * 64;
constexpr int TABW = 192;
namespace pg8 {
#define PG8_LAS __attribute__((address_space(3)))
typedef unsigned short bf16_t;
typedef short bf16x8 __attribute__((ext_vector_type(8)));
typedef float f32x4 __attribute__((ext_vector_type(4)));
typedef unsigned u32x4 __attribute__((ext_vector_type(4)));
constexpr int BM = 256, BK = 64, HALF = 128, HTB = HALF * BK * 2  , STAGE_BYTES = 8 * HTB, NXCD = 8, WGM = 8;

__host__ __device__ __forceinline__ int lds_byte(int r, int c) { const int st = (r >> 4) * 2 + (c >> 5), rr = r & 15, cc = c & 31, ob = rr * 64 + cc * 2; return st * 1024 + (ob ^ (((ob >> 9) & 1) << 5)); }
__host__ __device__ __forceinline__ void stage_rc(int b, int& R, int& C) { const int st = b / 1024, sb = b % 1024, swz = sb ^ (((sb >> 9) & 1) << 5); R = (st >> 1) * 16 + swz / 64; C = (st & 1) * 32 + (swz % 64) / 2; }
__host__ __device__ __forceinline__ int perm32(int rho) { const int n = rho >> 4, i = rho & 15; return 8 * (i >> 2) + 4 * n + (i & 3); }

struct Unit { int pm, pn; };
struct Gemm { const bf16_t* A; const bf16_t* Bt; int M, N, K, pad; };

struct StaticOrder {
    int nM, nN, nwg, G, c;
    __host__ __device__ void init(int M, int N, int G_, int c_) { nM = M / BM; nN = N / BM; nwg = nM * nN; G = G_; c = c_; }
    __host__ __device__ bool next(int i, Unit& u) const {
        const long L = (long)i * G + c; if (L >= nwg) return false;
        int wgid = (int)L; { const int q = nwg / NXCD, r = nwg % NXCD, xcd = wgid % NXCD, off = wgid / NXCD; wgid = (xcd < r ? xcd * (q + 1) : r * (q + 1) + (xcd - r) * q) + off; }
        const int nig = WGM * nN, gid = wgid / nig, fm = gid * WGM, gsz = (nM - fm) < WGM ? (nM - fm) : WGM;
        u.pm = fm + ((wgid % nig) % gsz); u.pn = (wgid % nig) / gsz; return true;
    }
    __device__ __forceinline__ void a_ready(const Unit&) const {}
    __device__ __forceinline__ void done(const Unit&) const {}
};

__device__ __forceinline__ unsigned cvt_pk_bf16(float lo, float hi) { unsigned r; asm volatile("v_cvt_pk_bf16_f32 %0, %1, %2" : "=v"(r) : "v"(lo), "v"(hi)); return r; }
typedef float f32x2 __attribute__((ext_vector_type(2)));
__device__ __forceinline__ f32x2 gelu_pk(f32x2 v) {
    const f32x2 av = __builtin_elementwise_abs(v), d = av * 0.2316418882f + 1.0f;
    f32x2 t; t.x = __builtin_amdgcn_rcpf(d.x); t.y = __builtin_amdgcn_rcpf(d.y);
    f32x2 q = t * 0.5307027145f + (-0.7265760135f); q = q * t + 0.7107068705f; q = q * t + (-0.142248368f); q = q * t + 0.127414796f; q = q * t;
    const f32x2 s = (v * v) * (-0.72134752044f);
    f32x2 e; e.x = __builtin_amdgcn_exp2f(s.x); e.y = __builtin_amdgcn_exp2f(s.y);
    const f32x2 m = v * (q * e), r = v - m;
    f32x2 o; o.x = v.x < 0.f ? m.x : r.x; o.y = v.y < 0.f ? m.y : r.y; return o;
}

template <int ACT  > struct EpiBf16 {
    static constexpr bool PERM = true, AFTER_DRAIN = false; static_assert(ACT == 0 || ACT == 1, "EpiBf16: ACT is 0 (none) or 1 (gelu_pk)");
    bf16_t* O; int ldc; const float* bias; int split_cols; size_t split_stride; float scale0;
    __device__ __forceinline__ void operator()(const f32x4 (&acc)[2][2][4][2], const Unit& u, int wr, int wc, int fr, int fq) const {
        const int row0 = u.pm * BM + wr * 64 + fr; int colt = u.pn * BM; bf16_t* base = O;
        float sc = 1.f; if (split_cols) { const int t = colt / split_cols; base += (size_t)t * split_stride; colt -= t * split_cols; if (t == 0) sc = scale0; }
        const int col0 = colt + wc * 32 + 8 * fq, bcol0 = u.pn * BM + wc * 32 + 8 * fq;
        f32x4 bv[2][2];
#pragma unroll
        for (int bj = 0; bj < 2; ++bj)
#pragma unroll
            for (int n = 0; n < 2; ++n) bv[bj][n] = bias ? *(const f32x4*)(bias + bcol0 + bj * HALF + 4 * n) : (f32x4){0.f, 0.f, 0.f, 0.f};
#pragma unroll
        for (int ai = 0; ai < 2; ++ai)
#pragma unroll
            for (int m = 0; m < 4; ++m) { bf16_t* rowp = base + (size_t)(row0 + ai * HALF + m * 16) * ldc + col0;
#pragma unroll
                for (int bj = 0; bj < 2; ++bj) { f32x4 v0 = acc[ai][bj][m][0] + bv[bj][0], v1 = acc[ai][bj][m][1] + bv[bj][1];
                    if (ACT == 1) { f32x2 a = gelu_pk((f32x2){v0[0], v0[1]}), b = gelu_pk((f32x2){v0[2], v0[3]}), c = gelu_pk((f32x2){v1[0], v1[1]}), d = gelu_pk((f32x2){v1[2], v1[3]});
                        v0 = (f32x4){a.x, a.y, b.x, b.y}; v1 = (f32x4){c.x, c.y, d.x, d.y}; }
                    v0 = v0 * sc; v1 = v1 * sc; u32x4 w; w.x = cvt_pk_bf16(v0[0], v0[1]); w.y = cvt_pk_bf16(v0[2], v0[3]); w.z = cvt_pk_bf16(v1[0], v1[1]); w.w = cvt_pk_bf16(v1[2], v1[3]);
                    *(u32x4*)(rowp + bj * HALF) = w; } }
    }
};

struct PanelStats {
    unsigned* xbuf;
    unsigned* cnt;
    unsigned* tmo;
    int ntn; float eps;
    unsigned code;
    __device__ __forceinline__ bool run(const f32x4 (&v)[2][2][4][2], const Unit& u, int wr, int wc, int fr, int fq, PG8_LAS unsigned char* lds, int wid, int lane) const {
        typedef float f32x2v __attribute__((ext_vector_type(2)));
        PG8_LAS f32x2v* P = (PG8_LAS f32x2v*)lds;
        PG8_LAS f32x2v* S = (PG8_LAS f32x2v*)(lds + 8192);
        PG8_LAS unsigned* flag = (PG8_LAS unsigned*)(lds + 8192 + 2048);
#pragma unroll
        for (int ai = 0; ai < 2; ++ai)
#pragma unroll
            for (int m = 0; m < 4; ++m) {
                float s = 0.f;
#pragma unroll
                for (int bj = 0; bj < 2; ++bj)
#pragma unroll
                    for (int n = 0; n < 2; ++n) { const f32x4 x = v[ai][bj][m][n]; s += (x[0] + x[1]) + (x[2] + x[3]); }
                s += __shfl_xor(s, 16); s += __shfl_xor(s, 32);
                const float mw = s * (1.0f / 64.0f); float q = 0.f;
#pragma unroll
                for (int bj = 0; bj < 2; ++bj)
#pragma unroll
                    for (int n = 0; n < 2; ++n) { const f32x4 d = v[ai][bj][m][n] - mw; q += (d[0] * d[0] + d[1] * d[1]) + (d[2] * d[2] + d[3] * d[3]); }
                q += __shfl_xor(q, 16); q += __shfl_xor(q, 32);
                if (fq == 0) P[(ai * HALF + wr * 64 + m * 16 + fr) * 4 + wc] = (f32x2v){mw, q};
            }
        asm volatile("s_waitcnt lgkmcnt(0)" ::: "memory"); __builtin_amdgcn_s_barrier(); asm volatile("" ::: "memory");
#if defined(BROKEN_EXCHANGE_NO_WAIT)
#warning BROKEN CONTROL BUILD: the row-statistics exchange does not wait; results are wrong by design
        if (blockIdx.x >= 64) { const long long t0_ = clock64(); while (clock64() - t0_ < 60000) __builtin_amdgcn_s_sleep(8); }
#endif
        const int row = wid * 32 + (lane & 31);
        if (lane < 32) {
            const f32x2v a = P[row * 4 + 0], b = P[row * 4 + 1], c = P[row * 4 + 2], d = P[row * 4 + 3];
            const float mt = (a.x + b.x + c.x + d.x) * 0.25f;
            const float da = a.x - mt, db = b.x - mt, dc = c.x - mt, dd = d.x - mt;
            const float m2 = (a.y + b.y) + (c.y + d.y) + 64.0f * ((da * da + db * db) + (dc * dc + dd * dd));
            unsigned long long* slot = (unsigned long long*)xbuf + ((size_t)(u.pm * BM + row) * 4 + u.pn);
            __hip_atomic_store(slot, ((unsigned long long)__float_as_uint(m2) << 32) | __float_as_uint(mt), __ATOMIC_RELAXED, __HIP_MEMORY_SCOPE_AGENT);
        }
        asm volatile("s_waitcnt vmcnt(0)" ::: "memory");
        if (lane == 0) __hip_atomic_fetch_add(cnt + 64 * u.pm, 1u, __ATOMIC_RELAXED, __HIP_MEMORY_SCOPE_AGENT);
        if (wid == 0) {
            bool dead = false; const unsigned long long t0 = __builtin_amdgcn_s_memrealtime(); const unsigned want = 8u * (unsigned)ntn;
            for (;;) {
#if defined(BROKEN_EXCHANGE_NO_WAIT)
                break;
#endif
                if ((unsigned)__builtin_amdgcn_readfirstlane(__hip_atomic_load(cnt + 64 * u.pm, __ATOMIC_RELAXED, __HIP_MEMORY_SCOPE_AGENT)) >= want) break;
                if (__builtin_amdgcn_s_memrealtime() - t0 > 2000000ull) {
                    if (lane == 0) { unsigned expect = 0u; __hip_atomic_compare_exchange_strong(tmo + 1, &expect, code | (unsigned)(u.pm & 0xff), __ATOMIC_RELAXED, __ATOMIC_RELAXED, __HIP_MEMORY_SCOPE_AGENT);
                                     __hip_atomic_store(tmo, 1u, __ATOMIC_RELAXED, __HIP_MEMORY_SCOPE_AGENT); }
                    dead = true; break; }
                __builtin_amdgcn_s_sleep(2);
            }
            __builtin_amdgcn_fence(__ATOMIC_ACQUIRE, "agent");
            if (lane == 0) flag[0] = dead ? 1u : 0u;
        }
        asm volatile("s_waitcnt vmcnt(0) lgkmcnt(0)" ::: "memory"); __builtin_amdgcn_s_barrier(); asm volatile("" ::: "memory");
        const bool bad = flag[0] != 0u;
        if (lane < 32) {
            const unsigned long long* slot = (const unsigned long long*)xbuf + (size_t)(u.pm * BM + row) * 4; float mt[4], m2[4]; float ms = 0.f;
#pragma unroll
            for (int t = 0; t < 4; ++t) { if (t < ntn) { const unsigned long long w = __hip_atomic_load(slot + t, __ATOMIC_RELAXED, __HIP_MEMORY_SCOPE_AGENT); mt[t] = __uint_as_float((unsigned)w); m2[t] = __uint_as_float((unsigned)(w >> 32)); } else { mt[t] = 0.f; m2[t] = 0.f; } ms += mt[t]; }
            const float mean = ms / (float)ntn; float q = 0.f;
#pragma unroll
            for (int t = 0; t < 4; ++t) if (t < ntn) { const float dm = mt[t] - mean; q += m2[t] + 256.0f * dm * dm; }
            S[row] = (f32x2v){mean, 1.0f / sqrtf(q / (256.0f * (float)ntn) + eps)};
        }
        asm volatile("s_waitcnt lgkmcnt(0)" ::: "memory"); __builtin_amdgcn_s_barrier(); asm volatile("" ::: "memory");
        return bad;
    }
};
struct EpiLnRes {
    static constexpr bool PERM = false, AFTER_DRAIN = true;
    const float* base; float* out; int ldc; const float* bias; PanelStats st; unsigned poison;
    __device__ __forceinline__ void fused(f32x4 (&acc)[2][2][4][2], const Unit& u, int wr, int wc, int fr, int fq, PG8_LAS unsigned char* lds, int wid, int lane) const {
        typedef float f32x2v __attribute__((ext_vector_type(2)));
        const PG8_LAS f32x2v* S = (const PG8_LAS f32x2v*)(lds + 8192);
        const int col0 = u.pn * BM + wc * 32 + 4 * fq;
#pragma unroll
        for (int bj = 0; bj < 2; ++bj)
#pragma unroll
            for (int n = 0; n < 2; ++n) { const f32x4 bv = bias ? *(const f32x4*)(bias + col0 + bj * HALF + n * 16) : (f32x4){0.f, 0.f, 0.f, 0.f};
#pragma unroll
                for (int ai = 0; ai < 2; ++ai)
#pragma unroll
                    for (int m = 0; m < 4; ++m) acc[ai][bj][m][n] += bv; }
        f32x4 pre[4][2][2];
#pragma unroll
        for (int m = 0; m < 4; ++m) { const size_t off = (size_t)(u.pm * BM + wr * 64 + m * 16 + fr) * ldc + col0;
#pragma unroll
            for (int bj = 0; bj < 2; ++bj)
#pragma unroll
                for (int n = 0; n < 2; ++n) pre[m][bj][n] = *(const f32x4*)(base + off + bj * HALF + n * 16); }
        const bool bad = st.run(acc, u, wr, wc, fr, fq, lds, wid, lane) || poison != 0u;
        const float qnan = __builtin_nanf("");
#pragma unroll
        for (int ai = 0; ai < 2; ++ai)
#pragma unroll
            for (int m = 0; m < 4; ++m) { const int r = ai * HALF + wr * 64 + m * 16 + fr; const f32x2v sr = S[r]; const size_t off = (size_t)(u.pm * BM + r) * ldc + col0;
#pragma unroll
                for (int bj = 0; bj < 2; ++bj)
#pragma unroll
                    for (int n = 0; n < 2; ++n) { const f32x4 bs = ai == 0 ? pre[m][bj][n] : *(const f32x4*)(base + off + bj * HALF + n * 16); f32x4 o = bs + (acc[ai][bj][m][n] - sr.x) * sr.y;
                        if (bad) o = (f32x4){qnan, qnan, qnan, qnan}; *(f32x4*)(out + off + bj * HALF + n * 16) = o; }
                if (m & 1) asm volatile("" ::: "memory"); }
    }
};
struct EpiLnResLn {
    static constexpr bool PERM = false, AFTER_DRAIN = true;
    const float* base; float* out; bf16_t* xn; int ldc; const float* bias; PanelStats st1, st2; unsigned poison;
    __device__ __forceinline__ void fused(f32x4 (&acc)[2][2][4][2], const Unit& u, int wr, int wc, int fr, int fq, PG8_LAS unsigned char* lds, int wid, int lane) const {
        typedef float f32x2v __attribute__((ext_vector_type(2))); typedef unsigned u32x2v __attribute__((ext_vector_type(2)));
        const PG8_LAS f32x2v* S = (const PG8_LAS f32x2v*)(lds + 8192);
        const int col0 = u.pn * BM + wc * 32 + 4 * fq;
#pragma unroll
        for (int bj = 0; bj < 2; ++bj)
#pragma unroll
            for (int n = 0; n < 2; ++n) { const f32x4 bv = bias ? *(const f32x4*)(bias + col0 + bj * HALF + n * 16) : (f32x4){0.f, 0.f, 0.f, 0.f};
#pragma unroll
                for (int ai = 0; ai < 2; ++ai)
#pragma unroll
                    for (int m = 0; m < 4; ++m) acc[ai][bj][m][n] += bv; }
        bool bad = st1.run(acc, u, wr, wc, fr, fq, lds, wid, lane) || poison != 0u;
        const float qnan = __builtin_nanf("");
#pragma unroll
        for (int ai = 0; ai < 2; ++ai)
#pragma unroll
            for (int m = 0; m < 4; ++m) { const int r = ai * HALF + wr * 64 + m * 16 + fr; const f32x2v sr = S[r]; const size_t off = (size_t)(u.pm * BM + r) * ldc + col0;
#pragma unroll
                for (int bj = 0; bj < 2; ++bj)
#pragma unroll
                    for (int n = 0; n < 2; ++n) { const f32x4 bs = *(const f32x4*)(base + off + bj * HALF + n * 16); acc[ai][bj][m][n] = bs + (acc[ai][bj][m][n] - sr.x) * sr.y; }
                asm volatile("" : "+v"(acc[ai][0][m][0]), "+v"(acc[ai][0][m][1]), "+v"(acc[ai][1][m][0]), "+v"(acc[ai][1][m][1]));
                if (m & 1) asm volatile("" ::: "memory"); }
        const bool bad1 = bad;
        bad = st2.run(acc, u, wr, wc, fr, fq, lds, wid, lane) || bad;
#pragma unroll
        for (int ai = 0; ai < 2; ++ai)
#pragma unroll
            for (int m = 0; m < 4; ++m) { const int r = ai * HALF + wr * 64 + m * 16 + fr; const f32x2v sr = S[r]; const size_t off = (size_t)(u.pm * BM + r) * ldc + col0;
#pragma unroll
                for (int bj = 0; bj < 2; ++bj)
#pragma unroll
                    for (int n = 0; n < 2; ++n) { const f32x4 x1 = acc[ai][bj][m][n]; *(f32x4*)(out + off + bj * HALF + n * 16) = bad1 ? (f32x4){qnan, qnan, qnan, qnan} : x1;
                        const f32x4 o = (x1 - sr.x) * sr.y; u32x2v w; w.x = cvt_pk_bf16(o[0], o[1]); w.y = cvt_pk_bf16(o[2], o[3]);
                        if (bad) { w.x = 0x7fc07fc0u; w.y = 0x7fc07fc0u; } *(u32x2v*)(xn + off + bj * HALF + n * 16) = w; }
                asm volatile("" ::: "memory"); }
    }
};

template <class Epi, class Sched, bool ALIGN_EPI = false, bool SP2 = false>
__device__ __forceinline__ void gemm_phase(PG8_LAS unsigned char* lds, const Gemm g, const Sched& S, const Epi& E) {
    const int tid = threadIdx.x, wid = __builtin_amdgcn_readfirstlane(tid >> 6), lane = tid & 63, wr = wid >> 2, wc = wid & 3, fr = lane & 15, fq = lane >> 4;
    const int K = g.K, nt = K / BK;
    unsigned voffA[2], voffB[2];
#pragma unroll
    for (int i = 0; i < 2; ++i) { int R, C; stage_rc(tid * 16 + i * 8192, R, C); const int Rb = Epi::PERM ? ((R & ~31) + perm32(R & 31)) : R;
        voffA[i] = (unsigned)(R * K + C) * 2u; voffB[i] = (unsigned)(Rb * K + C) * 2u; }
    const size_t kstep = (size_t)(BK * 2);
    const size_t hstep = (size_t)HALF * K * 2;
    const size_t tstep = 2 * hstep;
    const unsigned ldsw = (unsigned)wid * 1024u;
    const int aoff = lds_byte(wr * 64 + fr, fq * 8), boff = lds_byte(wc * 32 + fr, fq * 8);
#define PG8_SA(b, h) (((b) * 2 + (h)) * HTB)
#define PG8_SB(b, h) ((4 + (b) * 2 + (h)) * HTB)
#define PG8_STAGE(bufoff, gbase, voff) do { _Pragma("unroll") for (int _i = 0; _i < 2; ++_i) \
        __builtin_amdgcn_global_load_lds((const unsigned*)((const char*)(gbase) + (voff)[_i]), (PG8_LAS unsigned*)(lds + (bufoff) + ldsw + _i * 8192), 16, 0, 0); } while (0)
#define PG8_LDA(dst, b, h) do { _Pragma("unroll") for (int m = 0; m < 4; ++m) _Pragma("unroll") for (int k = 0; k < 2; ++k) dst[m][k] = *(const PG8_LAS bf16x8*)(lds + PG8_SA(b, h) + aoff + m * 2048 + k * 1024); } while (0)
#define PG8_LDB(dst, b, h) do { _Pragma("unroll") for (int n = 0; n < 2; ++n) _Pragma("unroll") for (int k = 0; k < 2; ++k) dst[n][k] = *(const PG8_LAS bf16x8*)(lds + PG8_SB(b, h) + boff + n * 2048 + k * 1024); } while (0)
#define PG8_MMA(ai, bj, At, Bt) do { __builtin_amdgcn_s_setprio(1); _Pragma("unroll") for (int m = 0; m < 4; ++m) _Pragma("unroll") for (int n = 0; n < 2; ++n) _Pragma("unroll") for (int k = 0; k < 2; ++k) \
        acc[ai][bj][m][n] = __builtin_amdgcn_mfma_f32_16x16x32_bf16(Bt[n][k], At[m][k], acc[ai][bj][m][n], 0, 0, 0); __builtin_amdgcn_s_setprio(0); } while (0)
#define PG8_WAIT_V(n) asm volatile("s_waitcnt vmcnt(" #n ")" ::: "memory")
#define PG8_WAIT_L(n) asm volatile("s_waitcnt lgkmcnt(" #n ")" ::: "memory")
#define PG8_BAR __builtin_amdgcn_s_barrier()
#define PG8_SCHED __builtin_amdgcn_sched_barrier(0)
    Unit cur, nxt; int ui = 0;
    if (!S.next(0, cur)) return;
    f32x4 acc[2][2][4][2];
#pragma unroll
    for (int a = 0; a < 2; ++a)
#pragma unroll
        for (int b = 0; b < 2; ++b)
#pragma unroll
            for (int m = 0; m < 4; ++m)
#pragma unroll
                for (int n = 0; n < 2; ++n) acc[a][b][m][n] = (f32x4){0.f, 0.f, 0.f, 0.f};
    bf16x8 At[4][2], B0[2][2], B1[2][2];
    const char* cA = (const char*)g.A + (size_t)cur.pm * tstep; const char* cB = (const char*)g.Bt + (size_t)cur.pn * tstep;
    S.a_ready(cur);
    if constexpr (SP2) {
        PG8_STAGE(PG8_SB(0, 0), cB, voffB); PG8_STAGE(PG8_SB(0, 1), cB + hstep, voffB); PG8_STAGE(PG8_SA(0, 0), cA, voffA); PG8_STAGE(PG8_SA(0, 1), cA + hstep, voffA);
        if (wr == 1) PG8_BAR;
        PG8_WAIT_V(2); PG8_BAR;
        PG8_STAGE(PG8_SB(1, 0), cB + kstep, voffB); PG8_STAGE(PG8_SA(1, 0), cA + kstep, voffA); PG8_STAGE(PG8_SB(1, 1), cB + hstep + kstep, voffB);
        PG8_WAIT_V(6); PG8_BAR;
    } else {
        PG8_STAGE(PG8_SB(0, 0), cB, voffB); PG8_STAGE(PG8_SA(0, 0), cA, voffA); PG8_STAGE(PG8_SB(0, 1), cB + hstep, voffB); PG8_STAGE(PG8_SA(0, 1), cA + hstep, voffA);
        if (wr == 1) PG8_BAR;
        PG8_WAIT_V(4); PG8_BAR;
        PG8_STAGE(PG8_SB(1, 0), cB + kstep, voffB); PG8_STAGE(PG8_SA(1, 0), cA + kstep, voffA); PG8_STAGE(PG8_SB(1, 1), cB + hstep + kstep, voffB);
        PG8_WAIT_V(6); PG8_BAR;
    }
    for (;;) {
        const bool has_next = S.next(ui + 1, nxt);
        const char* nA = has_next ? (const char*)g.A + (size_t)nxt.pm * tstep : cA; const char* nB = has_next ? (const char*)g.Bt + (size_t)nxt.pn * tstep : cB;
        for (int t = 0; t < nt; t += 2) {
            const bool last = (t == nt - 2);
            const char* a1 = cA + (size_t)(t + 1) * kstep;
            const char* a2 = last ? nA : cA + (size_t)(t + 2) * kstep; const char* b2 = last ? nB : cB + (size_t)(t + 2) * kstep;
            const char* a3 = a2 + kstep; const char* b3 = b2 + kstep;
            if (last && has_next) S.a_ready(nxt);
            if constexpr (SP2) {
            PG8_LDB(B0, 0, 0); PG8_LDB(B1, 0, 1); PG8_SCHED; PG8_LDA(At, 0, 0); PG8_STAGE(PG8_SA(1, 1), a1 + hstep, voffA);
            PG8_WAIT_V(8); PG8_WAIT_L(0); PG8_BAR; PG8_MMA(0, 0, At, B0); PG8_MMA(0, 1, At, B1); PG8_BAR; PG8_SCHED;
            PG8_LDA(At, 0, 1); PG8_STAGE(PG8_SB(0, 0), b2, voffB); PG8_STAGE(PG8_SB(0, 1), b2 + hstep, voffB); PG8_STAGE(PG8_SA(0, 0), a2, voffA);
            PG8_WAIT_V(8); PG8_WAIT_L(0); PG8_BAR; PG8_MMA(1, 0, At, B0); PG8_MMA(1, 1, At, B1); PG8_BAR; PG8_SCHED;
            PG8_LDB(B0, 1, 0); PG8_LDB(B1, 1, 1); PG8_SCHED; PG8_LDA(At, 1, 0); PG8_STAGE(PG8_SA(0, 1), a2 + hstep, voffA);
            PG8_WAIT_V(8); PG8_WAIT_L(0); PG8_BAR; PG8_MMA(0, 0, At, B0); PG8_MMA(0, 1, At, B1); PG8_BAR; PG8_SCHED;
            PG8_LDA(At, 1, 1); PG8_STAGE(PG8_SB(1, 0), b3, voffB); PG8_STAGE(PG8_SB(1, 1), b3 + hstep, voffB); PG8_STAGE(PG8_SA(1, 0), a3, voffA);
            PG8_WAIT_V(8); PG8_WAIT_L(0); PG8_BAR; PG8_MMA(1, 0, At, B0); PG8_MMA(1, 1, At, B1); PG8_BAR; PG8_SCHED;
            } else {
            PG8_LDB(B0, 0, 0); PG8_SCHED; PG8_LDA(At, 0, 0); PG8_STAGE(PG8_SA(1, 1), a1 + hstep, voffA);
            PG8_WAIT_L(8); PG8_BAR; PG8_WAIT_L(0); PG8_MMA(0, 0, At, B0); PG8_BAR; PG8_SCHED;
            PG8_LDB(B1, 0, 1); PG8_STAGE(PG8_SB(0, 0), b2, voffB);
            PG8_BAR; PG8_WAIT_L(0); PG8_MMA(0, 1, At, B1); PG8_BAR;
            PG8_LDA(At, 0, 1); PG8_STAGE(PG8_SA(0, 0), a2, voffA);
            PG8_BAR; PG8_WAIT_L(0); PG8_MMA(1, 0, At, B0); PG8_BAR; PG8_SCHED;
            PG8_STAGE(PG8_SB(0, 1), b2 + hstep, voffB);
            PG8_WAIT_V(6); PG8_BAR; PG8_MMA(1, 1, At, B1); PG8_BAR;
            PG8_LDB(B0, 1, 0); PG8_SCHED; PG8_LDA(At, 1, 0); PG8_STAGE(PG8_SA(0, 1), a2 + hstep, voffA);
            PG8_WAIT_L(8); PG8_BAR; PG8_WAIT_L(0); PG8_MMA(0, 0, At, B0); PG8_BAR; PG8_SCHED;
            PG8_LDB(B1, 1, 1); PG8_STAGE(PG8_SB(1, 0), b3, voffB);
            PG8_BAR; PG8_WAIT_L(0); PG8_MMA(0, 1, At, B1); PG8_BAR;
            PG8_LDA(At, 1, 1); PG8_STAGE(PG8_SA(1, 0), a3, voffA);
            PG8_BAR; PG8_WAIT_L(0); PG8_MMA(1, 0, At, B0); PG8_BAR; PG8_SCHED;
            PG8_STAGE(PG8_SB(1, 1), b3 + hstep, voffB);
            PG8_WAIT_V(6); PG8_BAR; PG8_MMA(1, 1, At, B1); PG8_BAR;
            }
        }
        if constexpr (ALIGN_EPI) { if (wr == 0) PG8_BAR; }
        if constexpr (!Epi::AFTER_DRAIN) { E(acc, cur, wr, wc, fr, fq); S.done(cur); }
        if (!has_next) break;
#pragma unroll
        for (int a = 0; a < 2; ++a)
#pragma unroll
            for (int b = 0; b < 2; ++b)
#pragma unroll
                for (int m = 0; m < 4; ++m)
#pragma unroll
                    for (int n = 0; n < 2; ++n) acc[a][b][m][n] = (f32x4){0.f, 0.f, 0.f, 0.f};
        cur = nxt; cA = nA; cB = nB; ++ui;
        if constexpr (ALIGN_EPI) { if (wr == 1) PG8_BAR; }
    }
    PG8_WAIT_V(0);
    if constexpr (!ALIGN_EPI) { if (wr == 0) PG8_BAR; }
    PG8_BAR;
    if constexpr (Epi::AFTER_DRAIN) { E.fused(acc, cur, wr, wc, fr, fq, lds, wid, lane); S.done(cur); }
#undef PG8_SA
#undef PG8_SB
#undef PG8_STAGE
#undef PG8_LDA
#undef PG8_LDB
#undef PG8_MMA
#undef PG8_WAIT_V
#undef PG8_WAIT_L
#undef PG8_BAR
#undef PG8_SCHED
}
}
namespace pg8 {
struct EpiProj {
    static constexpr bool PERM = true, AFTER_DRAIN = false;
    bf16_t *QC, *KV, *QKVG, *Z;
    __device__ __forceinline__ void operator()(const f32x4 (&acc)[2][2][4][2], const Unit& u, int wr, int wc, int fr, int fq) const {
        const int pn = u.pn; bf16_t* base; int ldc, colt;
        if (pn < 2) { base = QC; ldc = 1024; colt = pn * 256; }
        else if (pn == 2) { base = KV; ldc = 256; colt = 0; }
        else if (pn < 9) { base = QKVG; ldc = 1536; colt = (pn - 3) * 256; }
        else { base = Z; ldc = 512; colt = (pn - 9) * 256; }
        const int row0 = u.pm * BM + wr * 64 + fr, col0 = colt + wc * 32 + 8 * fq;
#pragma unroll
        for (int ai = 0; ai < 2; ++ai)
#pragma unroll
            for (int m = 0; m < 4; ++m) { bf16_t* rowp = base + (size_t)(row0 + ai * HALF + m * 16) * ldc + col0;
#pragma unroll
                for (int bj = 0; bj < 2; ++bj) { const f32x4 v0 = acc[ai][bj][m][0], v1 = acc[ai][bj][m][1];
                    u32x4 w; w.x = cvt_pk_bf16(v0[0], v0[1]); w.y = cvt_pk_bf16(v0[2], v0[3]); w.z = cvt_pk_bf16(v1[0], v1[1]); w.w = cvt_pk_bf16(v1[2], v1[3]);
                    *(u32x4*)(rowp + bj * HALF) = w; } }
    }
};
struct EpiRes {
    static constexpr bool PERM = false, AFTER_DRAIN = false;
    const float* base; float* H; bf16_t* HB; float* SSQ;
    __device__ __forceinline__ void operator()(const f32x4 (&acc)[2][2][4][2], const Unit& u, int wr, int wc, int fr, int fq) const {
        typedef unsigned u32x2v __attribute__((ext_vector_type(2)));
        const int col0 = u.pn * BM + wc * 32 + 4 * fq;
#pragma unroll
        for (int ai = 0; ai < 2; ++ai)
#pragma unroll
            for (int m = 0; m < 4; ++m) { const int row = u.pm * BM + ai * HALF + wr * 64 + m * 16 + fr; const size_t off = (size_t)row * 1024 + col0; float ss = 0.f;
#pragma unroll
                for (int bj = 0; bj < 2; ++bj)
#pragma unroll
                    for (int n = 0; n < 2; ++n) { const f32x4 bs = *(const f32x4*)(base + off + bj * HALF + n * 16); const f32x4 hv = bs + acc[ai][bj][m][n];
                        *(f32x4*)(H + off + bj * HALF + n * 16) = hv; ss += (hv[0] * hv[0] + hv[1] * hv[1]) + (hv[2] * hv[2] + hv[3] * hv[3]);
                        if (HB) { u32x2v w; w.x = cvt_pk_bf16(hv[0], hv[1]); w.y = cvt_pk_bf16(hv[2], hv[3]); *(u32x2v*)(HB + off + bj * HALF + n * 16) = w; } }
                ss += __shfl_xor(ss, 16); ss += __shfl_xor(ss, 32);
                if (fq == 0) SSQ[(size_t)row * 16 + u.pn * 4 + wc] = ss; }
    }
};
struct EpiFfn1 {
    static constexpr bool PERM = true, AFTER_DRAIN = false;
    bf16_t* ACT; const float* SSQ;
    __device__ __forceinline__ void operator()(const f32x4 (&acc)[2][2][4][2], const Unit& u, int wr, int wc, int fr, int fq) const {
        const int row0 = u.pm * BM + wr * 64 + fr, col0 = u.pn * BM + wc * 32 + 8 * fq;
#pragma unroll
        for (int ai = 0; ai < 2; ++ai)
#pragma unroll
            for (int m = 0; m < 4; ++m) { const int row = row0 + ai * HALF + m * 16; const f32x4* sp = (const f32x4*)(SSQ + (size_t)row * 16);
                const f32x4 s0 = sp[0], s1 = sp[1], s2 = sp[2], s3 = sp[3]; const f32x4 st = (s0 + s1) + (s2 + s3);
                const float r = rsqrtf(((st[0] + st[1]) + (st[2] + st[3])) * (1.f / 1024.f) + 1e-6f);
                bf16_t* rowp = ACT + (size_t)row * 4096 + col0;
#pragma unroll
                for (int bj = 0; bj < 2; ++bj) { f32x4 v0 = acc[ai][bj][m][0] * r, v1 = acc[ai][bj][m][1] * r;
#pragma unroll
                    for (int e = 0; e < 4; ++e) { const float a = fmaxf(v0[e], 0.f), b = fmaxf(v1[e], 0.f); v0[e] = a * a; v1[e] = b * b; }
                    u32x4 w; w.x = cvt_pk_bf16(v0[0], v0[1]); w.y = cvt_pk_bf16(v0[2], v0[3]); w.z = cvt_pk_bf16(v1[0], v1[1]); w.w = cvt_pk_bf16(v1[2], v1[3]);
                    *(u32x4*)(rowp + bj * HALF) = w; } }
    }
};
}

constexpr int GEMM_LDS = 131072;
template <class Epi, bool ALIGN>
__global__ void __launch_bounds__(512, 2) k_gemm(pg8::Gemm g, Epi e) {
    extern __shared__ __attribute__((aligned(16))) unsigned char lds_g[];
    pg8::StaticOrder S; S.init(g.M, g.N, (int)gridDim.x, (int)blockIdx.x);
    pg8::gemm_phase<Epi, pg8::StaticOrder, ALIGN, true>((PG8_LAS unsigned char*)lds_g, g, S, e);
}
#define GAS __attribute__((address_space(1)))
typedef float f32x4 __attribute__((ext_vector_type(4)));

__global__ void k_wt(const float* __restrict__ W, int K, int ldw, int col0, int N, const float* __restrict__ kscale, bf16_t* __restrict__ WT) {
    __shared__ float tile[32][33];
    const int n0 = blockIdx.x * 32, k0 = blockIdx.y * 32, tx = threadIdx.x & 31, ty = threadIdx.x >> 5;
    for (int i = ty; i < 32; i += 8) { const int k = k0 + i; float v = W[(size_t)k * ldw + col0 + n0 + tx]; if (kscale) v *= kscale[k]; tile[i][tx] = v; }
    __syncthreads();
    for (int i = ty; i < 32; i += 8) WT[(size_t)(n0 + i) * K + k0 + tx] = (bf16_t)f2bf(tile[tx][i]);
}

__global__ void k_p0_rows(const float* __restrict__ x, const float* __restrict__ nw, const float* __restrict__ w_in, bf16_t* __restrict__ XN, float* __restrict__ GATES) {
    __shared__ float xs[DM]; __shared__ float red[256];
    const int m = blockIdx.x, t = threadIdx.x;
    float v[4], ss = 0.f;
    for (int i = 0; i < 4; ++i) { v[i] = x[(size_t)m * DM + t + 256 * i]; ss += v[i] * v[i]; }
    red[t] = ss; __syncthreads();
    for (int s = 128; s > 0; s >>= 1) { if (t < s) red[t] += red[t + s]; __syncthreads(); }
    const float r = rsqrtf(red[0] * (1.f / DM) + EPS);
    for (int i = 0; i < 4; ++i) { const int k = t + 256 * i; const float xn = v[i] * r * nw[k]; xs[k] = xn; XN[(size_t)m * DM + k] = (bf16_t)f2bf(xn); }
    __syncthreads();
    const int j = t >> 4, l = t & 15; float acc = 0.f;
    for (int k = l; k < DM; k += 16) acc += xs[k] * w_in[(size_t)k * DIN + NPROJ + j];
    for (int o = 8; o > 0; o >>= 1) acc += __shfl_xor(acc, o);
    if (l == 0) GATES[(size_t)m * 16 + j] = acc;
}

__global__ void k_p2a(const bf16_t* __restrict__ QKVG, const float* __restrict__ conv_w, bf16_t* __restrict__ QHAT, bf16_t* __restrict__ KHAT, bf16_t* __restrict__ KHT, bf16_t* __restrict__ VHT) {
    __shared__ float red[128];
    const int m = blockIdx.x, h = blockIdx.y, d = threadIdx.x, b = m / SEQ, t = m % SEQ, n = t / CHUNK, c = t % CHUNK;
    const size_t u = (size_t)((b * GH + h) * NCH + n);
    float s[3];
    for (int which = 0; which < 3; ++which) {
        const int ch = which * 512 + h * GD + d; float y = 0.f;
        for (int j = 0; j < CONVK; ++j) { const int tt = t - 2 + j; if (tt >= 0 && tt < SEQ) y += bf2f(QKVG[(size_t)(b * SEQ + tt) * 1536 + ch]) * conv_w[j * 1536 + ch]; }
        s[which] = y / (1.f + __expf(-y));
    }
    for (int which = 0; which < 2; ++which) {
        red[d] = s[which] * s[which]; __syncthreads();
        for (int st = 64; st > 0; st >>= 1) { if (d < st) red[d] += red[d + st]; __syncthreads(); }
        const float r = rsqrtf(red[0] + EPS); __syncthreads();
        s[which] *= r;
    }
    s[0] *= 0.08838834764831845f;
    QHAT[u * BLOB + offA(c, d)] = (bf16_t)f2bf(s[0]);
    KHAT[u * BLOB + offA(c, d)] = (bf16_t)f2bf(s[1]);
    KHT[u * BLOB + offT(d, c)] = (bf16_t)f2bf(s[1]);
    VHT[u * BLOB + offT(d, c)] = (bf16_t)f2bf(s[2]);
}

__global__ void k_p2b_ref(const bf16_t* __restrict__ QHAT, const bf16_t* __restrict__ KHAT, const bf16_t* __restrict__ VHT, const float* __restrict__ GATES,
                          const float* __restrict__ a_log, const float* __restrict__ dt_bias, bf16_t* __restrict__ Wb, bf16_t* __restrict__ Ub, bf16_t* __restrict__ QKb, float* __restrict__ TAB) {
    extern __shared__ float sm[];
    float* kf = sm;
    float* xf = kf + 64 * 129;
    float* A = xf + 64 * 129;
    float* T = A + 64 * 65;
    float* gc = T + 64 * 65;
    float* bet = gc + 64;
    float* gg = bet + 64;
    const int ud = blockIdx.x, u = ud >> 1, dir = ud & 1, p = threadIdx.x, c = dir ? 63 - p : p;
    const int n = u % NCH, bh = u / NCH, h = bh % GH, b = bh / GH;
    const int m = b * SEQ + n * CHUNK + c;
    {
        const float a = GATES[(size_t)m * 16 + dir * 4 + h], bb = GATES[(size_t)m * 16 + 8 + dir * 4 + h];
        const float z = a + dt_bias[dir * 4 + h];
        const float sp = (z > 20.f) ? z : log1pf(__expf(z));
        gg[p] = -__expf(a_log[dir * 4 + h]) * sp; bet[p] = 1.f / (1.f + __expf(-bb));
    }
    for (int d = 0; d < GD; ++d) kf[p * 129 + d] = bf2f(KHAT[(size_t)u * BLOB + offA(c, d)]);
    __syncthreads();
    { float s = 0.f; for (int j = 0; j <= p; ++j) s += gg[j]; gc[p] = s; }
    __syncthreads();
    for (int j = 0; j < 64; ++j) {
        float v = 0.f;
        if (j < p) { float dd = 0.f; for (int d = 0; d < GD; ++d) dd += kf[p * 129 + d] * kf[j * 129 + d]; v = bet[p] * dd * __expf(gc[p] - gc[j]); }
        A[p * 65 + j] = v;
    }
    __syncthreads();
    for (int j = 63; j >= 0; --j) {
        float acc = (j == p) ? 1.f : 0.f;
        if (j <= p) { for (int k = j + 1; k <= p; ++k) acc -= T[p * 65 + k] * A[k * 65 + j]; } else acc = 0.f;
        T[p * 65 + j] = acc;
    }
    for (int d = 0; d < GD; ++d) {
        float acc = 0.f;
        for (int j = 0; j <= p; ++j) acc += T[p * 65 + j] * bet[j] * __expf(gc[j]) * kf[j * 129 + d];
        Wb[(size_t)ud * BLOB + offA(c, d)] = (bf16_t)f2bf(-acc);
    }
    for (int d = 0; d < GD; ++d) xf[p * 129 + d] = bf2f(VHT[(size_t)u * BLOB + offT(d, c)]);
    __syncthreads();
    for (int d = 0; d < GD; ++d) {
        float acc = 0.f;
        for (int j = 0; j <= p; ++j) acc += T[p * 65 + j] * bet[j] * xf[j * 129 + d];
        Ub[(size_t)ud * BLOB + offU(c, d)] = (bf16_t)f2bf(acc);
    }
    __syncthreads();
    for (int d = 0; d < GD; ++d) xf[p * 129 + d] = bf2f(QHAT[(size_t)u * BLOB + offA(c, d)]);
    __syncthreads();
    for (int j = 0; j < 64; ++j) {
        float v = 0.f;
        if (j <= p) { float dd = 0.f; for (int d = 0; d < GD; ++d) dd += xf[p * 129 + d] * kf[j * 129 + d]; v = dd * __expf(gc[p] - gc[j]); }
        const int cj = dir ? 63 - j : j;
        QKb[(size_t)ud * QKBLOB + offT(c, cj)] = (bf16_t)f2bf(v);
    }
    TAB[(size_t)ud * TABW + c] = __expf(gc[p]);
    TAB[(size_t)ud * TABW + 64 + c] = __expf(gc[63] - gc[p]);
    if (p == 63) TAB[(size_t)ud * TABW + 128] = __expf(gc[63]);
}

__global__ void k_scan_ref(const bf16_t* __restrict__ QHAT, const bf16_t* __restrict__ KHT, const bf16_t* __restrict__ Wb, const bf16_t* __restrict__ Ub, const bf16_t* __restrict__ QKb,
                           const float* __restrict__ TAB, bf16_t* __restrict__ ODIR) {
    extern __shared__ float sm[];
    float* S = sm;
    float* vn = S + 128 * 128;
    float* Wl = vn + 64 * 128;
    float* Ql = Wl + 64 * 128;
    const int chain = blockIdx.x, dir = chain & 1, bh = chain >> 1, h = bh % GH, b = bh / GH, dv = threadIdx.x;
    for (int d = 0; d < 128; ++d) S[d * 128 + dv] = 0.f;
    for (int step = 0; step < NCH; ++step) {
        const int n = dir ? NCH - 1 - step : step; const size_t u = (size_t)bh * NCH + n, ud = u * 2 + dir;
        const float* tab = TAB + ud * TABW;
        __syncthreads();
        for (int i = dv; i < 64 * 128; i += 128) { const int c = i >> 7, d = i & 127; Wl[i] = bf2f(Wb[ud * BLOB + offA(c, d)]); }
        __syncthreads();
        for (int c = 0; c < 64; ++c) { float acc = bf2f(Ub[ud * BLOB + offU(c, dv)]); for (int d = 0; d < 128; ++d) acc += Wl[c * 128 + d] * S[d * 128 + dv]; vn[c * 128 + dv] = acc; }
        __syncthreads();
        for (int i = dv; i < 64 * 128; i += 128) { const int c = i >> 7, d = i & 127; Wl[i] = bf2f(QHAT[u * BLOB + offA(c, d)]); }
        for (int i = dv; i < 64 * 64; i += 128) { const int c = i >> 6, c2 = i & 63; Ql[i] = bf2f(QKb[ud * QKBLOB + offT(c, c2)]); }
        __syncthreads();
        for (int c = 0; c < 64; ++c) {
            float acc = 0.f; for (int d = 0; d < 128; ++d) acc += Wl[c * 128 + d] * S[d * 128 + dv];
            acc *= tab[c];
            for (int c2 = 0; c2 < 64; ++c2) acc += Ql[c * 64 + c2] * vn[c2 * 128 + dv];
            ODIR[((size_t)dir * M + (size_t)b * SEQ + n * CHUNK + c) * 512 + h * GD + dv] = (bf16_t)f2bf(acc);
        }
        __syncthreads();
        for (int i = dv; i < 64 * 128; i += 128) { const int c = i >> 7, d = i & 127; Wl[i] = bf2f(KHT[u * BLOB + offT(d, c)]); }
        __syncthreads();
        const float egl = tab[128];
        for (int d = 0; d < 128; ++d) { float acc = S[d * 128 + dv] * egl; for (int c = 0; c < 64; ++c) acc += Wl[c * 128 + d] * tab[64 + c] * vn[c * 128 + dv]; S[d * 128 + dv] = acc; }
    }
}

__host__ __device__ __forceinline__ int t5_bucket(int rel) {
    const int base = rel > 0 ? 16 : 0; const int n = rel < 0 ? -rel : rel;
    if (n < 8) return base + n;
    int k = (n >= 12) + (n >= 16) + (n >= 23) + (n >= 32) + (n >= 46) + (n >= 64) + (n >= 91) + (n >= 128);
    int large = 8 + k; if (large > 15) large = 15;
    return base + large;
}

__global__ void __launch_bounds__(64) k_attn_ref(bf16_t* QC, const bf16_t* __restrict__ KV, const float* __restrict__ rel_bias, const float* __restrict__ sink) {
    __shared__ float btab[257];
    const int h = blockIdx.y, m = blockIdx.x * 64 + threadIdx.x, b = m / SEQ, t = m % SEQ, kvh = h >> 2;
    for (int i = threadIdx.x; i < 257; i += 64) btab[i] = rel_bias[t5_bucket(i - 128) * AH + h];
    __syncthreads();
    float q[64], acc[64];
#pragma unroll
    for (int d = 0; d < 64; ++d) { q[d] = bf2f(QC[(size_t)m * 1024 + h * 64 + d]); acc[d] = 0.f; }
    float mx = -1e30f, l = 0.f;
    const int lo = t - WIN < 0 ? 0 : t - WIN, hi = t + WIN > SEQ - 1 ? SEQ - 1 : t + WIN;
    for (int kp = lo; kp <= hi; ++kp) {
        const bf16_t* kr = KV + (size_t)(b * SEQ + kp) * 256 + kvh * 64; const bf16_t* vr = kr + 128;
        float s = 0.f;
#pragma unroll
        for (int d = 0; d < 64; ++d) s += q[d] * bf2f(kr[d]);
        s = s * 0.125f + btab[kp - t + 128];
        const float mn = fmaxf(mx, s), f = __expf(mx - mn), pe = __expf(s - mn);
        l = l * f + pe; mx = mn;
#pragma unroll
        for (int d = 0; d < 64; ++d) acc[d] = acc[d] * f + pe * bf2f(vr[d]);
    }
    { const float s = sink[h]; const float mn = fmaxf(mx, s), f = __expf(mx - mn); l = l * f + __expf(s - mn);
#pragma unroll
      for (int d = 0; d < 64; ++d) acc[d] *= f; }
    const float il = 1.f / l;
#pragma unroll
    for (int d = 0; d < 64; ++d) QC[(size_t)m * 1024 + h * 64 + d] = (bf16_t)f2bf(acc[d] * il);
}

__global__ void k_p4(const bf16_t* __restrict__ ODIR, const bf16_t* __restrict__ Z, const float* __restrict__ gnw, bf16_t* __restrict__ QC) {
    __shared__ float red[128];
    const int m = blockIdx.x, h = blockIdx.y, d = threadIdx.x;
    const float o = bf2f(ODIR[(size_t)m * 512 + h * GD + d]) + bf2f(ODIR[((size_t)M + m) * 512 + h * GD + d]);
    red[d] = o * o; __syncthreads();
    for (int st = 64; st > 0; st >>= 1) { if (d < st) red[d] += red[d + st]; __syncthreads(); }
    const float r = rsqrtf(red[0] * (1.f / GD) + EPS);
    const float z = bf2f(Z[(size_t)m * 512 + h * GD + d]);
    QC[(size_t)m * 1024 + 512 + h * GD + d] = (bf16_t)f2bf(o * r * gnw[d] * (z / (1.f + __expf(-z))));
}

__global__ void k_final(float* __restrict__ out, const float* __restrict__ SSQ2, const float* __restrict__ nfw) {
    const int m = blockIdx.x, t = threadIdx.x;
    float ss = 0.f; for (int i = 0; i < 16; ++i) ss += SSQ2[(size_t)m * 16 + i];
    const float r = rsqrtf(ss * (1.f / DM) + EPS);
    for (int i = 0; i < 4; ++i) { const int k = t + 256 * i; out[(size_t)m * DM + k] = out[(size_t)m * DM + k] * r * nfw[k]; }
}
constexpr int NWAVES = 8;
constexpr int RING_BYTES = 131072;
constexpr int LDSCTL_OFF = RING_BYTES, MISC_OFF = LDSCTL_OFF + 320;
constexpr int LDS_BYTES = 147456;
constexpr int CW_TMO = 0, CW_CODE = 1, CW_BAR = 4096;
#define LAS __attribute__((address_space(3)))
typedef unsigned v4u __attribute__((ext_vector_type(4)));
typedef unsigned v2u __attribute__((ext_vector_type(2)));
typedef short bf16x8 __attribute__((ext_vector_type(8)));
typedef GAS unsigned gu32;
#define RLX_AGENT __ATOMIC_RELAXED, __HIP_MEMORY_SCOPE_AGENT
#define LDS_WAIT() asm volatile("s_waitcnt lgkmcnt(0)" ::: "memory")
#define VM_WAIT() asm volatile("s_waitcnt vmcnt(0)" ::: "memory")
#define XB_TMO      128
#define XB_XCNT(j)  (256  + 64 * (j))
#define XB_XSUB(j)  (1280 + 64 * (j))
#define XB_XGEN(j)  (2304 + 64 * (j))
#define XB_TOP      3328
#define XB_TOPGEN   3392
#define XCD_BAR_WORDS 3456
#define XB_SPIN_CAP (1u << 18)

__device__ __forceinline__ unsigned xb_ld(unsigned* p)              { return __hip_atomic_load(p, __ATOMIC_RELAXED, __HIP_MEMORY_SCOPE_AGENT); }
__device__ __forceinline__ unsigned xb_add(unsigned* p, unsigned v) { return __hip_atomic_fetch_add(p, v, __ATOMIC_RELAXED, __HIP_MEMORY_SCOPE_AGENT); }
__device__ __forceinline__ unsigned xb_xcc_id() { return (unsigned)__builtin_amdgcn_s_getreg((3 << 11) | 20) & 0xFu; }
#define XB_SPIN(cond, bar) do { unsigned _sp = 0; while (cond) { __builtin_amdgcn_s_sleep(1); \
    if ((++_sp & 255u) == 0u) { if (xb_ld(&(bar)[XB_TMO])) break; if (_sp > XB_SPIN_CAP) { atomicAdd(&(bar)[XB_TMO], 1u); break; } } } } while (0)

struct XcdBarrier {
    unsigned* bar; unsigned x;
    volatile LAS unsigned* st;
};

__device__ __forceinline__ XcdBarrier xcd_barrier_post(unsigned* bar, volatile LAS unsigned* st) {
    XcdBarrier b; b.bar = bar; b.x = xb_xcc_id(); b.st = st;
    if (threadIdx.x == 0) (void)xb_add(&bar[XB_XCNT(b.x)], 1u);
    return b;
}
__device__ __forceinline__ void xcd_barrier_complete(unsigned* bar, unsigned x, unsigned& nloc, unsigned& nx) {
    const unsigned G = gridDim.x * gridDim.y * gridDim.z;
    unsigned sum, cnt, mine, sp = 0u;
    for (;;) {
        sum = 0u; cnt = 0u; mine = 0u;
#pragma unroll
        for (unsigned j = 0; j < 16; ++j) { const unsigned c = xb_ld(&bar[XB_XCNT(j)]); sum += c; cnt += (c > 0u) ? 1u : 0u; mine = (j == x) ? c : mine; }
        if (sum == G) break;
        __builtin_amdgcn_s_sleep(1);
        if ((++sp & 255u) == 0u) { if (xb_ld(&bar[XB_TMO])) break; if (sp > XB_SPIN_CAP) { atomicAdd(&bar[XB_TMO], 1u); break; } }
    }
    nloc = mine > 0u ? mine : 1u; nx = cnt > 0u ? cnt : 1u;
}

__device__ __forceinline__ void xcd_barrier(const XcdBarrier& b) {
    asm volatile("s_waitcnt vmcnt(0)" ::: "memory");
    __syncthreads();
    if (threadIdx.x == 0) {
        unsigned* bar = b.bar;
        __builtin_amdgcn_s_waitcnt(0);
        unsigned nloc = b.st[0], nx = b.st[1];
        if (nloc == 0u) { xcd_barrier_complete(bar, b.x, nloc, nx); b.st[0] = nloc; b.st[1] = nx; }
        const unsigned old = xb_add(&bar[XB_XSUB(b.x)], 1u);
        const unsigned gen = old / nloc;
        if (old + 1u == (gen + 1u) * nloc) {
            __builtin_amdgcn_fence(__ATOMIC_RELEASE, "agent");
            asm volatile("s_waitcnt vmcnt(0)" ::: "memory");
            const unsigned og = xb_add(&bar[XB_TOP], 1u);
            const unsigned tg = og / nx;
            if (og + 1u == (tg + 1u) * nx) xb_add(&bar[XB_TOPGEN], 1u);
            else XB_SPIN(xb_ld(&bar[XB_TOPGEN]) == tg, bar);
            __builtin_amdgcn_fence(__ATOMIC_ACQUIRE, "agent");
            xb_add(&bar[XB_XGEN(b.x)], 1u);
            asm volatile("s_waitcnt vmcnt(0)" ::: "memory");
        } else {
            XB_SPIN(xb_ld(&bar[XB_XGEN(b.x)]) == gen, bar);
            __builtin_amdgcn_fence(__ATOMIC_ACQUIRE, "agent");
            asm volatile("s_waitcnt vmcnt(0)" ::: "memory");
        }
    }
    __syncthreads();
}
struct Frame {
    LAS unsigned char* lds; volatile LAS unsigned* MISC; gu32* ctl;
    int tid, lane, wave, vcu, G;
};
__device__ __forceinline__ float wave_sum(float v) {
#pragma unroll
    for (int o = 1; o < 64; o <<= 1) v += __shfl_xor(v, o);
    return v;
}
__device__ __forceinline__ void p0_transpose_item(const float* W, int K, int ldw, int N, const float* ksc, bf16_t* WT, LAS float* scr, int item, int lane) {
    const int nblk = N / 32, kb = item / nblk, nb = item % nblk, k0 = 64 * kb, n0 = 32 * nb;
#pragma unroll 8
    for (int i = 0; i < 32; ++i) { const int kk = 2 * i + (lane >> 5); float v = W[(size_t)(k0 + kk) * ldw + n0 + (lane & 31)]; if (ksc) v *= ksc[k0 + kk]; scr[kk * 33 + (lane & 31)] = v; }
    LDS_WAIT(); asm volatile("" ::: "memory");
    const int c = lane & 7;
#pragma unroll
    for (int j = 0; j < 4; ++j) { const int n = (lane >> 3) + 8 * j; const LAS float* s = scr + (8 * c) * 33 + n;
        v4u o; o.x = pk2(s[0 * 33], s[1 * 33]); o.y = pk2(s[2 * 33], s[3 * 33]); o.z = pk2(s[4 * 33], s[5 * 33]); o.w = pk2(s[6 * 33], s[7 * 33]);
        *(GAS v4u*)(WT + (size_t)(n0 + n) * K + k0 + 8 * c) = o; }
    LDS_WAIT(); asm volatile("" ::: "memory");
}
struct P0Args { const float *x, *nmw, *w_in, *w_out, *nfw, *w1, *w2; bf16_t *WIN_T, *WOUT_T, *W1_T, *W2_T, *XN; float* GATES; };
__device__ __forceinline__ void phase_p0(Frame& F, const P0Args& a) {
    LAS float* scr = (LAS float*)(F.lds + F.wave * 16384);
    const int gw = F.vcu * NWAVES + F.wave, NGW = F.G * NWAVES, lane = F.lane;
    constexpr int I_IN = (DM / 64) * (NPROJ / 32), I_O = (DM / 64) * (DM / 32), I_1 = (DM / 64) * (DFF / 32), I_2 = (DFF / 64) * (DM / 32);
    constexpr int NITEMS = I_IN + I_O + I_1 + I_2;
    for (int it = gw; it < NITEMS; it += NGW) {
        int r = it;
        if (r < I_IN) { p0_transpose_item(a.w_in, DM, DIN, NPROJ, nullptr, a.WIN_T, scr, r, lane); continue; } r -= I_IN;
        if (r < I_O) { p0_transpose_item(a.w_out, DM, DM, DM, nullptr, a.WOUT_T, scr, r, lane); continue; } r -= I_O;
        if (r < I_1) { p0_transpose_item(a.w1, DM, DFF, DFF, a.nfw, a.W1_T, scr, r, lane); continue; } r -= I_1;
        p0_transpose_item(a.w2, DFF, DM, DM, nullptr, a.W2_T, scr, r, lane);
    }
    __syncthreads();
    LAS float* GW = (LAS float*)F.lds;
    for (int k = F.tid; k < DM; k += NWAVES * 64) {
        const f32x4* src = (const f32x4*)(a.w_in + (size_t)k * DIN + NPROJ); const int kg = k >> 2, e = k & 3;
#pragma unroll
        for (int q = 0; q < 4; ++q) { const f32x4 w = src[q];
#pragma unroll
            for (int t = 0; t < 4; ++t) { const int i = q * 4 + t; GW[kg * 64 + ((i ^ (kg & 15)) << 2) + e] = w[t]; } }
    }
    __syncthreads();
    f32x4 nwv[4];
#pragma unroll
    for (int j = 0; j < 4; ++j) nwv[j] = *(const f32x4*)(a.nmw + 256 * j + 4 * lane);
    for (int m = gw; m < M; m += NGW) {
        const GAS f32x4* xr = (const GAS f32x4*)(a.x + (size_t)m * DM) + lane;
        f32x4 v[4]; float s = 0.f;
#pragma unroll
        for (int j = 0; j < 4; ++j) { v[j] = xr[64 * j]; s += (v[j].x * v[j].x + v[j].y * v[j].y) + (v[j].z * v[j].z + v[j].w * v[j].w); }
        const float r = rsqrtf(wave_sum(s) * (1.f / DM) + EPS);
        GAS unsigned long long* o8 = (GAS unsigned long long*)(a.XN + (size_t)m * DM) + lane;
        float acc[16];
#pragma unroll
        for (int i = 0; i < 16; ++i) acc[i] = 0.f;
#pragma unroll
        for (int j = 0; j < 4; ++j) {
            v[j] = v[j] * r * nwv[j];
            o8[64 * j] = (unsigned long long)pk2(v[j].x, v[j].y) | ((unsigned long long)pk2(v[j].z, v[j].w) << 32);
            const LAS float* base = GW + (64 * j + lane) * 64;
#pragma unroll
            for (int i = 0; i < 16; ++i) { const f32x4 w = *(const LAS f32x4*)(base + ((i ^ (lane & 15)) << 2)); acc[i] += (v[j].x * w.x + v[j].y * w.y) + (v[j].z * w.z + v[j].w * w.w);
                if ((i & 7) == 7) asm volatile("" ::: "memory"); }
        }
        float a8[8], a4[4], a2[2], a1;
        { const bool hb = (lane >> 5) & 1;
#pragma unroll
          for (int i = 0; i < 8; ++i) { const float send = hb ? acc[i] : acc[i + 8]; const float recv = __shfl_xor(send, 32); a8[i] = (hb ? acc[i + 8] : acc[i]) + recv; } }
        { const bool hb = (lane >> 4) & 1;
#pragma unroll
          for (int i = 0; i < 4; ++i) { const float send = hb ? a8[i] : a8[i + 4]; const float recv = __shfl_xor(send, 16); a4[i] = (hb ? a8[i + 4] : a8[i]) + recv; } }
        { const bool hb = (lane >> 3) & 1;
#pragma unroll
          for (int i = 0; i < 2; ++i) { const float send = hb ? a4[i] : a4[i + 2]; const float recv = __shfl_xor(send, 8); a2[i] = (hb ? a4[i + 2] : a4[i]) + recv; } }
        { const bool hb = (lane >> 2) & 1; const float send = hb ? a2[0] : a2[1]; const float recv = __shfl_xor(send, 4); a1 = (hb ? a2[1] : a2[0]) + recv; }
        a1 += __shfl_xor(a1, 2); a1 += __shfl_xor(a1, 1);
        if ((lane & 3) == 0) a.GATES[(size_t)m * 16 + (lane >> 2)] = a1;
    }
}
__device__ __forceinline__ void phase_p4(Frame& F, const bf16_t* ODIR, const bf16_t* Z, const float* gnw, bf16_t* QC) {
    const int gw = F.vcu * NWAVES + F.wave, NGW = F.G * NWAVES, lane = F.lane;
    const float g0 = gnw[2 * lane], g1 = gnw[2 * lane + 1];
    for (int idx = gw; idx < M * GH; idx += NGW) {
        const int m = idx >> 2, h = idx & 3;
        const unsigned of = *(const GAS unsigned*)(ODIR + (size_t)m * 512 + h * GD + 2 * lane), ob = *(const GAS unsigned*)(ODIR + ((size_t)M + m) * 512 + h * GD + 2 * lane);
        const unsigned zz = *(const GAS unsigned*)(Z + (size_t)m * 512 + h * GD + 2 * lane);
        const float o0 = bf2f(of) + bf2f(ob), o1 = bf2f(of >> 16) + bf2f(ob >> 16);
        const float r = rsqrtf(wave_sum(o0 * o0 + o1 * o1) * (1.f / GD) + EPS);
        const float z0 = bf2f(zz), z1 = bf2f(zz >> 16);
        *(GAS unsigned*)(QC + (size_t)m * 1024 + 512 + h * GD + 2 * lane) = pk2(o0 * r * g0 * (z0 / (1.f + __expf(-z0))), o1 * r * g1 * (z1 / (1.f + __expf(-z1))));
    }
}
__device__ __forceinline__ void phase_p8(Frame& F, float* out, const float* SSQ2, const float* nfw) {
    const int gw = F.vcu * NWAVES + F.wave, NGW = F.G * NWAVES, lane = F.lane;
    f32x4 wv[4];
#pragma unroll
    for (int j = 0; j < 4; ++j) wv[j] = *(const f32x4*)(nfw + 256 * j + 4 * lane);
    for (int m = gw; m < M; m += NGW) {
        const GAS f32x4* sp = (const GAS f32x4*)(SSQ2 + (size_t)m * 16);
        const f32x4 st = (sp[0] + sp[1]) + (sp[2] + sp[3]);
        const float r = rsqrtf(((st[0] + st[1]) + (st[2] + st[3])) * (1.f / DM) + EPS);
        GAS f32x4* xr = (GAS f32x4*)(out + (size_t)m * DM) + lane;
#pragma unroll
        for (int j = 0; j < 4; ++j) xr[64 * j] = xr[64 * j] * r * wv[j];
    }
}
constexpr size_t WS_VTP = 232 * MiB;
__host__ __device__ __forceinline__ int perm16(int a) { return (a & ~12) | ((a & 4) << 1) | ((a & 8) >> 1); }
__device__ __forceinline__ float silu_f(float y) { return y / (1.f + __expf(-y)); }
__device__ __forceinline__ void phase_p2a(Frame& F, const bf16_t* QKVG, const bf16_t* KV, const float* conv_w, bf16_t* QHAT, bf16_t* KHAT, bf16_t* KHT, bf16_t* VHT, bf16_t* VTP) {
    const int lane = F.lane, w = F.wave;
    const int upw = (NUNIT + F.G - 1) / F.G;
    const int cbase = 32 * (w >> 2) + 8 * ((w >> 1) & 1) + 4 * (w & 1);
    const int P0 = (cbase & 32) | ((cbase & 12) << 1);
    for (int ui = 0; ui < upw; ++ui) {
        const int u = F.vcu * upw + ui; if (u >= NUNIT) break;
        const int n = u % NCH, bh = u / NCH, h = bh % GH, b = bh / GH;
        float cw[CONVK][3][2];
#pragma unroll
        for (int j = 0; j < CONVK; ++j)
#pragma unroll
            for (int wh = 0; wh < 3; ++wh) { const float* p = conv_w + j * 1536 + wh * 512 + h * GD + 2 * lane; cw[j][wh][0] = p[0]; cw[j][wh][1] = p[1]; }
        unsigned kt[2][4], vt[2][4];
#pragma unroll
        for (int run = 0; run < 2; ++run) {
            const int c0 = cbase + 16 * run, t0 = n * CHUNK + c0;
            unsigned xw[8][3];
#pragma unroll
            for (int rr = 0; rr < 8; ++rr) { const int t = t0 - 2 + rr; const bool ok = (t >= 0) && (t < SEQ);
                const GAS unsigned* rp = (const GAS unsigned*)(QKVG + (size_t)(b * SEQ + (ok ? t : 0)) * 1536 + h * GD + 2 * lane);
#pragma unroll
                for (int wh = 0; wh < 3; ++wh) { const unsigned v = rp[wh * 256]; xw[rr][wh] = ok ? v : 0u; } }
            float kv0[4], kv1[4], vv0[4], vv1[4];
#pragma unroll
            for (int i = 0; i < 4; ++i) {
                float y[3][2];
#pragma unroll
                for (int wh = 0; wh < 3; ++wh) { float a0 = 0.f, a1 = 0.f;
#pragma unroll
                    for (int j = 0; j < CONVK; ++j) { a0 += bf2f(xw[i + j][wh]) * cw[j][wh][0]; a1 += bf2f(xw[i + j][wh] >> 16) * cw[j][wh][1]; }
                    y[wh][0] = silu_f(a0); y[wh][1] = silu_f(a1); }
                const float sq = wave_sum(y[0][0] * y[0][0] + y[0][1] * y[0][1]), sk = wave_sum(y[1][0] * y[1][0] + y[1][1] * y[1][1]);
                const float rq = rsqrtf(sq + EPS) * 0.08838834764831845f, rk = rsqrtf(sk + EPS);
                const int c = c0 + i;
                const float k0 = y[1][0] * rk, k1 = y[1][1] * rk;
                *(GAS unsigned*)(QHAT + (size_t)u * BLOB + offA(c, 2 * lane)) = pk2(y[0][0] * rq, y[0][1] * rq);
                *(GAS unsigned*)(KHAT + (size_t)u * BLOB + offA(c, 2 * lane)) = pk2(k0, k1);
                kv0[i] = k0; kv1[i] = k1; vv0[i] = y[2][0]; vv1[i] = y[2][1];
            }
            kt[0][2 * run] = pk2(kv0[0], kv0[1]); kt[0][2 * run + 1] = pk2(kv0[2], kv0[3]);
            kt[1][2 * run] = pk2(kv1[0], kv1[1]); kt[1][2 * run + 1] = pk2(kv1[2], kv1[3]);
            vt[0][2 * run] = pk2(vv0[0], vv0[1]); vt[0][2 * run + 1] = pk2(vv0[2], vv0[3]);
            vt[1][2 * run] = pk2(vv1[0], vv1[1]); vt[1][2 * run + 1] = pk2(vv1[2], vv1[3]);
        }
        const int chunk = (P0 >> 3) ^ (lane & 7);
#pragma unroll
        for (int e = 0; e < 2; ++e) { const size_t off = (size_t)u * BLOB + (size_t)(2 * lane + e) * 64 + chunk * 8;
            *(GAS v4u*)(KHT + off) = (v4u){kt[e][0], kt[e][1], kt[e][2], kt[e][3]};
            *(GAS v4u*)(VHT + off) = (v4u){vt[e][0], vt[e][1], vt[e][2], vt[e][3]}; }
    }
    const int gw = F.vcu * NWAVES + F.wave, NGW = F.G * NWAVES;
    for (int it = gw; it < BATCH * AKVH * (SEQ / 64); it += NGW) {
        const int tb = it % (SEQ / 64), bk = it / (SEQ / 64), kvh = bk % AKVH, b = bk / AKVH;
        const GAS bf16_t* src = (const GAS bf16_t*)(KV + (size_t)(b * SEQ + tb * 64) * 256 + 128 + kvh * 64 + lane);
        unsigned pkd[32];
#pragma unroll
        for (int i = 0; i < 32; ++i) pkd[i] = 0u;
#pragma unroll
        for (int tt = 0; tt < 64; ++tt) { const unsigned v = src[(size_t)tt * 256]; const int pos = perm16(tt); pkd[pos >> 1] |= (pos & 1) ? (v << 16) : v; }
        GAS v4u* dst = (GAS v4u*)(VTP + ((size_t)(b * AKVH + kvh) * 64 + lane) * SEQ + tb * 64);
#pragma unroll
        for (int q = 0; q < 8; ++q) dst[q] = (v4u){pkd[4 * q], pkd[4 * q + 1], pkd[4 * q + 2], pkd[4 * q + 3]};
    }
}
__host__ __device__ constexpr int kpinv(int p) { return (p & ~31) | ((p & 4) << 2) | ((p & 24) >> 1) | (p & 3); }
__device__ __forceinline__ bf16x8 fragA_g(const bf16_t* blob, int rt, int s, int fr, int g) { const int row = 16 * rt + fr; return *(const GAS bf16x8*)(blob + row * 128 + (((4 * s + g) ^ fr) << 3)); }
__device__ __forceinline__ bf16x8 fragT_g(const bf16_t* blob, int rt, int s, int fr, int g) { const int row = 16 * rt + fr; return *(const GAS bf16x8*)(blob + row * 64 + (((4 * s + g) ^ ((row >> 1) & 7)) << 3)); }
__device__ __forceinline__ bf16x8 fragT_l(const LAS unsigned char* img, int rt, int s, int fr, int g) { const int row = 16 * rt + fr; return *(const LAS bf16x8*)(img + row * 128 + (((4 * s + g) ^ ((row >> 1) & 7)) << 4)); }

template <int DIR>
__device__ __forceinline__ void p2b_write_ts(LAS unsigned char* img, const float (&T)[64], const LAS float* sct, int c, float sign) {
#pragma unroll
    for (int q = 0; q < 8; ++q) {
        const f32x4 s0 = *(const LAS f32x4*)(sct + 8 * q), s1 = *(const LAS f32x4*)(sct + 8 * q + 4);
        float v[8];
#pragma unroll
        for (int i = 0; i < 8; ++i) { const int cp = kpinv(8 * q + i); const int j = DIR ? 63 - cp : cp; v[i] = T[j] * (i < 4 ? s0[i] : s1[i - 4]) * sign; }
        v4u pw; pw.x = pk2(v[0], v[1]); pw.y = pk2(v[2], v[3]); pw.z = pk2(v[4], v[5]); pw.w = pk2(v[6], v[7]);
        *(LAS v4u*)(img + c * 128 + ((q ^ ((c >> 1) & 7)) << 4)) = pw;
        asm volatile("" ::: "memory");
    }
}

__device__ __forceinline__ void p2b_task(LAS unsigned char* R, LAS float* sct, int ud, int lane, const bf16_t* QHAT, const bf16_t* KHAT, const bf16_t* KHT, const bf16_t* VHT, const float* GATES,
                                         const float* a_log, const float* dt_bias, bf16_t* Wb, bf16_t* Ub, bf16_t* QKb, float* TAB) {
    const int fr = lane & 15, g = lane >> 4;
    const int u = ud >> 1, dir = ud & 1, n = u % NCH, bh = u / NCH, h = bh % GH, b = bh / GH;
    const int c = dir ? 63 - lane : lane;
    float beta, gc, glast;
    {
        const size_t m = (size_t)b * SEQ + n * CHUNK + c;
        const float a = GATES[m * 16 + dir * 4 + h], bb = GATES[m * 16 + 8 + dir * 4 + h];
        const float z = a + dt_bias[dir * 4 + h];
        const float sp = (z > 20.f) ? z : log1pf(__expf(z));
        float s = -__expf(a_log[dir * 4 + h]) * sp; beta = 1.f / (1.f + __expf(-bb));
#pragma unroll
        for (int o = 1; o < 64; o <<= 1) { const float t = __shfl_up(s, o); if (lane >= o) s += t; }
        gc = s; glast = __shfl(gc, 63);
        TAB[(size_t)ud * TABW + c] = __expf(gc); TAB[(size_t)ud * TABW + 64 + c] = __expf(glast - gc);
        if (lane == 63) TAB[(size_t)ud * TABW + 128] = __expf(glast);
    }
    sct[kperm(c)] = beta * __expf(gc); sct[64 + kperm(c)] = beta;
    float gcr[4][4], ber[4][4], gcc[4];
#pragma unroll
    for (int t = 0; t < 4; ++t) {
        { const int cc = 16 * t + fr; const int pl = dir ? 63 - cc : cc; gcc[t] = __shfl(gc, pl); }
#pragma unroll
        for (int r = 0; r < 4; ++r) { const int cr = 16 * t + 4 * g + r; const int pl = dir ? 63 - cr : cr; gcr[t][r] = __shfl(gc, pl); ber[t][r] = __shfl(beta, pl); }
    }
    const bf16_t* kb = KHAT + (size_t)u * BLOB; const bf16_t* qb = QHAT + (size_t)u * BLOB;
    LAS float* AT = (LAS float*)R;
    {
        bf16x8 kf[4][4];
#pragma unroll
        for (int t = 0; t < 4; ++t)
#pragma unroll
            for (int s = 0; s < 4; ++s) kf[t][s] = fragA_g(kb, t, s, fr, g);
#pragma unroll
        for (int ta = 0; ta < 4; ++ta)
#pragma unroll
            for (int tb = 0; tb < 4; ++tb) {
                f32x4 acc = (f32x4){0.f, 0.f, 0.f, 0.f};
#pragma unroll
                for (int s = 0; s < 4; ++s) acc = __builtin_amdgcn_mfma_f32_16x16x32_bf16(kf[ta][s], kf[tb][s], acc, 0, 0, 0);
                const int ccol = 16 * tb + fr; int pc = dir ? 63 - ccol : ccol; asm volatile("" : "+v"(pc));
                f32x4 v;
#pragma unroll
                for (int r = 0; r < 4; ++r) { const int crow = 16 * ta + 4 * g + r, pr = dir ? 63 - crow : crow;
                    const float e = __expf(fminf(gcr[ta][r] - gcc[tb], 0.f)); v[r] = (pc < pr) ? ber[ta][r] * acc[r] * e : 0.f; }
                const int pr0 = dir ? 63 - (16 * ta + 4 * g + 3) : 16 * ta + 4 * g;
                if (dir) v = (f32x4){v[3], v[2], v[1], v[0]};
                *(LAS f32x4*)(AT + pc * 64 + (pr0 ^ (4 * (pc & 15)))) = v;
            }
#pragma unroll
        for (int tb = 0; tb < 4; ++tb) {
            const int cq = 16 * tb + fr; int pq = dir ? 63 - cq : cq; asm volatile("" : "+v"(pq));
            bf16x8 qf[4];
#pragma unroll
            for (int s = 0; s < 4; ++s) qf[s] = fragA_g(qb, tb, s, fr, g);
#pragma unroll
            for (int sg = 0; sg < 2; ++sg) {
                f32x4 a0 = (f32x4){0.f, 0.f, 0.f, 0.f}, a1 = a0;
#pragma unroll
                for (int s = 0; s < 4; ++s) { a0 = __builtin_amdgcn_mfma_f32_16x16x32_bf16(kf[2 * sg][s], qf[s], a0, 0, 0, 0); a1 = __builtin_amdgcn_mfma_f32_16x16x32_bf16(kf[2 * sg + 1][s], qf[s], a1, 0, 0, 0); }
                float v[8];
#pragma unroll
                for (int r = 0; r < 4; ++r) {
                    { const int ck = 16 * (2 * sg) + 4 * g + r, pk = dir ? 63 - ck : ck; v[r] = (pk <= pq) ? a0[r] * __expf(fminf(gcc[tb] - gcr[2 * sg][r], 0.f)) : 0.f; }
                    { const int ck = 16 * (2 * sg + 1) + 4 * g + r, pk = dir ? 63 - ck : ck; v[4 + r] = (pk <= pq) ? a1[r] * __expf(fminf(gcc[tb] - gcr[2 * sg + 1][r], 0.f)) : 0.f; }
                }
                v4u pw; pw.x = pk2(v[0], v[1]); pw.y = pk2(v[2], v[3]); pw.z = pk2(v[4], v[5]); pw.w = pk2(v[6], v[7]);
                *(GAS v4u*)(QKb + (size_t)ud * QKBLOB + cq * 64 + (((4 * sg + g) ^ ((cq >> 1) & 7)) << 3)) = pw;
            }
        }
    }
    LDS_WAIT(); asm volatile("" ::: "memory");
    float T[64];
#pragma unroll
    for (int j = 63; j >= 0; --j) {
        int lj = lane; asm volatile("" : "+v"(lj));
        float acc = (lj == j) ? 1.f : 0.f;
#pragma unroll
        for (int k4 = ((j + 1) & ~3); k4 < 64; k4 += 4) {
            const f32x4 a = *(const LAS f32x4*)(AT + j * 64 + (k4 ^ (4 * (j & 15))));
#pragma unroll
            for (int e = 0; e < 4; ++e) if (k4 + e > j) acc -= T[k4 + e] * a[e];
        }
        T[j] = acc;
        asm volatile("" ::: "memory");
    }
    asm volatile("" ::: "memory");
    LAS unsigned char* Tw = R; LAS unsigned char* Tu = R + 8192;
    if (dir) { p2b_write_ts<1>(Tw, T, sct, c, -1.f); p2b_write_ts<1>(Tu, T, sct + 64, c, 1.f); }
    else { p2b_write_ts<0>(Tw, T, sct, c, -1.f); p2b_write_ts<0>(Tu, T, sct + 64, c, 1.f); }
    LDS_WAIT(); asm volatile("" ::: "memory");
    int lane2 = lane; asm volatile("" : "+v"(lane2));
    const int fr_ = fr, g_ = g; (void)fr_; (void)g_;
    #define fr (lane2 & 15)
    #define g (lane2 >> 4)
    #define lane lane2
    const bf16_t* ktb = KHT + (size_t)u * BLOB; const bf16_t* vtb = VHT + (size_t)u * BLOB;
#pragma unroll
    for (int sg = 0; sg < 4; ++sg) {
        bf16x8 ka[2][2];
#pragma unroll
        for (int i = 0; i < 2; ++i)
#pragma unroll
            for (int s2 = 0; s2 < 2; ++s2) ka[i][s2] = fragT_g(ktb, 2 * sg + i, s2, fr, g);
#pragma unroll
        for (int ct = 0; ct < 4; ++ct) {
            f32x4 a0 = (f32x4){0.f, 0.f, 0.f, 0.f}, a1 = a0;
#pragma unroll
            for (int s2 = 0; s2 < 2; ++s2) { const bf16x8 tb_ = fragT_l(Tw, ct, s2, fr, g);
                a0 = __builtin_amdgcn_mfma_f32_16x16x32_bf16(ka[0][s2], tb_, a0, 0, 0, 0); a1 = __builtin_amdgcn_mfma_f32_16x16x32_bf16(ka[1][s2], tb_, a1, 0, 0, 0); }
            const int cc = 16 * ct + fr;
            v4u pw; pw.x = pk2(a0[0], a0[1]); pw.y = pk2(a0[2], a0[3]); pw.z = pk2(a1[0], a1[1]); pw.w = pk2(a1[2], a1[3]);
            *(GAS v4u*)(Wb + (size_t)ud * BLOB + cc * 128 + (((4 * sg + g) ^ fr) << 3)) = pw;
        }
    }
#pragma unroll
    for (int ct = 0; ct < 4; ++ct) {
        bf16x8 ta_[2];
#pragma unroll
        for (int s2 = 0; s2 < 2; ++s2) ta_[s2] = fragT_l(Tu, ct, s2, fr, g);
#pragma unroll
        for (int vt = 0; vt < 8; ++vt) {
            f32x4 a0 = (f32x4){0.f, 0.f, 0.f, 0.f};
#pragma unroll
            for (int s2 = 0; s2 < 2; ++s2) a0 = __builtin_amdgcn_mfma_f32_16x16x32_bf16(ta_[s2], fragT_g(vtb, vt, s2, fr, g), a0, 0, 0, 0);
            v2u pw; pw.x = pk2(a0[0], a0[1]); pw.y = pk2(a0[2], a0[3]);
            *(GAS v2u*)(Ub + (size_t)ud * BLOB + (size_t)((vt * 4 + ct) * 64 + lane) * 4) = pw;
        }
    }
    LDS_WAIT(); asm volatile("" ::: "memory");
    #undef fr
    #undef g
    #undef lane
}
__device__ __forceinline__ void phase_p2b(Frame& F, const bf16_t* QHAT, const bf16_t* KHAT, const bf16_t* KHT, const bf16_t* VHT, const float* GATES,
                                          const float* a_log, const float* dt_bias, bf16_t* Wb, bf16_t* Ub, bf16_t* QKb, float* TAB) {
    const int gw = F.vcu * NWAVES + F.wave, NGW = F.G * NWAVES;
    LAS unsigned char* R = F.lds + F.wave * 16384; LAS float* sct = (LAS float*)(F.lds + RING_BYTES + 1024 + F.wave * 512);
    for (int ud = gw; ud < NUNIT * 2; ud += NGW) p2b_task(R, sct, ud, F.lane, QHAT, KHAT, KHT, VHT, GATES, a_log, dt_bias, Wb, Ub, QKb, TAB);
}
#ifndef SCAN_SPLIT
#define SCAN_SPLIT 2
#endif
constexpr int SCAN_NCW = 8 / SCAN_SPLIT;
constexpr int SCAN_WGS = 16 * SCAN_SPLIT;
__device__ __forceinline__ bf16x8 pack8(f32x4 a, f32x4 b) {
    v4u r; r.x = pk2(a[0], a[1]); r.y = pk2(a[2], a[3]); r.z = pk2(b[0], b[1]); r.w = pk2(b[2], b[3]); return __builtin_bit_cast(bf16x8, r);
}
constexpr int SC_W = 0, SC_Q = 16384, SC_K = 32768, SC_QK = 49152, SC_TAB = 57344, SC_BUF = 58368;
struct ScanRegs { v2u ub[4]; };
__device__ __forceinline__ void glds16(const void* gsrc, unsigned lds_dst) {
    unsigned keep;
    asm volatile("s_mov_b32 %0, m0\n\ts_mov_b32 m0, %2\n\ts_nop 0\n\tglobal_load_lds_dwordx4 %1, off\n\ts_mov_b32 m0, %0" : "=&s"(keep) : "v"(gsrc), "s"(lds_dst) : "memory");
}
__device__ __forceinline__ void glds4(const void* gsrc, unsigned lds_dst) {
    unsigned keep;
    asm volatile("s_mov_b32 %0, m0\n\ts_mov_b32 m0, %2\n\ts_nop 0\n\tglobal_load_lds_dword %1, off\n\ts_mov_b32 m0, %0" : "=&s"(keep) : "v"(gsrc), "s"(lds_dst) : "memory");
}
struct ScanSrc { const char *pw, *pq, *pk, *pqk, *pt, *pu; };
template <int LW, int NLW>
__device__ __forceinline__ void scan_stage_t(unsigned ldsb, const ScanSrc& c, int lane) {
#pragma unroll
    for (int pc = LW; pc < 57; pc += NLW) {
        const char* src = (pc < 16) ? c.pw + pc * 1024 : (pc < 32) ? c.pq + (pc - 16) * 1024 : (pc < 48) ? c.pk + (pc - 32) * 1024 : (pc < 56) ? c.pqk + (pc - 48) * 1024 : c.pt;
        glds16(src + lane * 16, (unsigned)__builtin_amdgcn_readfirstlane(ldsb + pc * 1024));
    }
}
constexpr int SCAN_NPF = 3;
template <int LW>
__device__ __forceinline__ void scan_prefetch_t(unsigned dummy, const ScanSrc& c, int lane) {
    const char* b0 = (LW == 0) ? c.pw : (LW == 1) ? c.pq : (LW == 2) ? c.pk : c.pqk;
    glds4(b0 + lane * 128, dummy);
    if (LW < 3) { glds4(b0 + 8192 + lane * 128, dummy); glds4(b0 + (lane & 1) * 8192 + (lane >> 1) * 128 + 64, dummy); }
    else { glds4(c.pu + lane * 128, dummy); glds4(c.pt + (lane & 7) * 96, dummy); }
}
__device__ __forceinline__ void scan_loader(LAS unsigned char* buf, unsigned dummy, const ScanSrc& now, const ScanSrc& later, bool pf, int lw, int lane) {
    const unsigned ldsb = (unsigned)(uintptr_t)buf;
    switch (lw) { case 0: scan_stage_t<0, 4>(ldsb, now, lane); if (pf) scan_prefetch_t<0>(dummy, later, lane); break;
                  case 1: scan_stage_t<1, 4>(ldsb, now, lane); if (pf) scan_prefetch_t<1>(dummy, later, lane); break;
                  case 2: scan_stage_t<2, 4>(ldsb, now, lane); if (pf) scan_prefetch_t<2>(dummy, later, lane); break;
                  default: scan_stage_t<3, 4>(ldsb, now, lane); if (pf) scan_prefetch_t<3>(dummy, later, lane); break; }
    if (pf) asm volatile("s_waitcnt vmcnt(3)" ::: "memory"); else asm volatile("s_waitcnt vmcnt(0)" ::: "memory");
}
__device__ __forceinline__ void scan_load_regs(ScanRegs& R, const bf16_t* Ub, size_t ud, int sl, int lane) {
#pragma unroll
    for (int ct = 0; ct < 4; ++ct) R.ub[ct] = *(const GAS v2u*)(Ub + ud * BLOB + (size_t)((sl * 4 + ct) * 64 + lane) * 4);
}
#define SCAN_SB() __builtin_amdgcn_sched_barrier(0)
__device__ __forceinline__ void scan_compute(f32x4 (&S)[8], const LAS unsigned char* cur, const ScanRegs& R, v2u (&ow)[4], int lane) {
    const int fr = lane & 15, g = lane >> 4;
    const LAS float* tab = (const LAS float*)(cur + SC_TAB);
    const LAS unsigned char* pA = cur + fr * 256;
    const LAS unsigned char* pT = cur + fr * 128;
    const int sw = (fr >> 1) & 7;
    bf16x8 fa[8], fb[8];
#define LD_A(dst, base, c0) _Pragma("unroll") for (int i_ = 0; i_ < 8; ++i_) dst[i_] = *(const LAS bf16x8*)(pA + (base) + ((c0) + (i_ >> 2)) * 4096 + (((4 * (i_ & 3) + g) ^ fr) << 4))
#define LD_T(dst, base, t0) _Pragma("unroll") for (int i_ = 0; i_ < 8; ++i_) dst[i_] = *(const LAS bf16x8*)(pT + (base) + ((t0) + (i_ >> 1)) * 2048 + (((4 * (i_ & 1) + g) ^ sw) << 4))
    LD_A(fa, SC_W, 0); LD_A(fb, SC_W, 2);
    SCAN_SB();
    bf16x8 bS[4];
#pragma unroll
    for (int s = 0; s < 4; ++s) bS[s] = pack8(S[2 * s], S[2 * s + 1]);
    f32x4 vn[4], oa[4];
#pragma unroll
    for (int ct = 0; ct < 4; ++ct) vn[ct] = (f32x4){bf2f(R.ub[ct].x), bf2f(R.ub[ct].x >> 16), bf2f(R.ub[ct].y), bf2f(R.ub[ct].y >> 16)};
#pragma unroll
    for (int i = 0; i < 8; ++i) vn[i >> 2] = __builtin_amdgcn_mfma_f32_16x16x32_bf16(fa[i], bS[i & 3], vn[i >> 2], 0, 0, 0);
    SCAN_SB(); LD_A(fa, SC_Q, 0); SCAN_SB();
#pragma unroll
    for (int i = 0; i < 8; ++i) vn[2 + (i >> 2)] = __builtin_amdgcn_mfma_f32_16x16x32_bf16(fb[i], bS[i & 3], vn[2 + (i >> 2)], 0, 0, 0);
    SCAN_SB(); LD_A(fb, SC_Q, 2); SCAN_SB();
#pragma unroll
    for (int ct = 0; ct < 4; ++ct) oa[ct] = (f32x4){0.f, 0.f, 0.f, 0.f};
#pragma unroll
    for (int i = 0; i < 8; ++i) oa[i >> 2] = __builtin_amdgcn_mfma_f32_16x16x32_bf16(fa[i], bS[i & 3], oa[i >> 2], 0, 0, 0);
    bf16x8 bV[2], bK[2];
    { const f32x4 ek0 = *(const LAS f32x4*)(tab + 64 + 4 * g), ek1 = *(const LAS f32x4*)(tab + 80 + 4 * g), ek2 = *(const LAS f32x4*)(tab + 96 + 4 * g), ek3 = *(const LAS f32x4*)(tab + 112 + 4 * g);
      bV[0] = pack8(vn[0], vn[1]); bV[1] = pack8(vn[2], vn[3]);
      bK[0] = pack8(vn[0] * ek0, vn[1] * ek1); bK[1] = pack8(vn[2] * ek2, vn[3] * ek3); }
    SCAN_SB(); LD_T(fa, SC_K, 0); SCAN_SB();
#pragma unroll
    for (int i = 0; i < 8; ++i) oa[2 + (i >> 2)] = __builtin_amdgcn_mfma_f32_16x16x32_bf16(fb[i], bS[i & 3], oa[2 + (i >> 2)], 0, 0, 0);
    const float egl = tab[128];
    SCAN_SB(); LD_T(fb, SC_K, 4); SCAN_SB();
#pragma unroll
    for (int i = 0; i < 8; ++i) { if ((i & 1) == 0) S[i >> 1] = S[i >> 1] * egl; S[i >> 1] = __builtin_amdgcn_mfma_f32_16x16x32_bf16(fa[i], bK[i & 1], S[i >> 1], 0, 0, 0); }
    SCAN_SB(); LD_T(fa, SC_QK, 0); SCAN_SB();
#pragma unroll
    for (int i = 0; i < 8; ++i) { if ((i & 1) == 0) S[4 + (i >> 1)] = S[4 + (i >> 1)] * egl; S[4 + (i >> 1)] = __builtin_amdgcn_mfma_f32_16x16x32_bf16(fb[i], bK[i & 1], S[4 + (i >> 1)], 0, 0, 0); }
    { const f32x4 eg0 = *(const LAS f32x4*)(tab + 4 * g), eg1 = *(const LAS f32x4*)(tab + 16 + 4 * g), eg2 = *(const LAS f32x4*)(tab + 32 + 4 * g), eg3 = *(const LAS f32x4*)(tab + 48 + 4 * g);
      oa[0] = oa[0] * eg0; oa[1] = oa[1] * eg1; oa[2] = oa[2] * eg2; oa[3] = oa[3] * eg3; }
    SCAN_SB();
#pragma unroll
    for (int i = 0; i < 8; ++i) oa[i >> 1] = __builtin_amdgcn_mfma_f32_16x16x32_bf16(fa[i], bV[i & 1], oa[i >> 1], 0, 0, 0);
#pragma unroll
    for (int ct = 0; ct < 4; ++ct) { ow[ct].x = pk2(oa[ct][0], oa[ct][1]); ow[ct].y = pk2(oa[ct][2], oa[ct][3]); }
#undef LD_A
#undef LD_T
}
__device__ __forceinline__ void scan_store_o(const v2u (&ow)[4], bf16_t* obase, int lane) {
    const int fr = lane & 15, g = lane >> 4;
#pragma unroll
    for (int ct = 0; ct < 4; ++ct) { bf16_t* op = obase + (size_t)(16 * ct + 4 * g) * 512 + fr;
        op[0] = (bf16_t)(ow[ct].x & 0xffffu); op[512] = (bf16_t)(ow[ct].x >> 16); op[1024] = (bf16_t)(ow[ct].y & 0xffffu); op[1536] = (bf16_t)(ow[ct].y >> 16); }
}
__device__ __forceinline__ void phase_scan(Frame& F, int chain, int half, const bf16_t* QHAT, const bf16_t* KHT, const bf16_t* Wb, const bf16_t* Ub, const bf16_t* QKb, const float* TAB, bf16_t* ODIR) {
    static_assert(SCAN_SPLIT == 2, "scan: 4 compute waves + 4 loader waves per workgroup, two workgroups per chain");
    const int lane = F.lane, w = F.wave;
    const int dir = chain & 1, bh = chain >> 1, h = bh % GH, b = bh / GH;
    const bool compute = (w < 4);
    const int sl = half * 4 + (w & 3);
    const int lw = w - 4;
    const unsigned dummy = (unsigned)(uintptr_t)(F.lds + RING_BYTES + 1024);
    f32x4 S[8];
#pragma unroll
    for (int t = 0; t < 8; ++t) S[t] = (f32x4){0.f, 0.f, 0.f, 0.f};
    ScanRegs RA, RB; v2u ow[4];
    constexpr int PFD = 3;
#define SCAN_SRC(n_) [&]() { const size_t u_ = (size_t)bh * NCH + (n_), ud_ = u_ * 2 + dir; ScanSrc c_; c_.pw = (const char*)(Wb + ud_ * BLOB); c_.pq = (const char*)(QHAT + u_ * BLOB); c_.pk = (const char*)(KHT + u_ * BLOB); \
        c_.pqk = (const char*)(QKb + ud_ * QKBLOB); c_.pt = (const char*)(TAB + ud_ * TABW); c_.pu = (const char*)(Ub + ud_ * BLOB) + half * 8192; return c_; }()
#define SCAN_N(step_) (dir ? NCH - 1 - (step_) : (step_))
    if (!compute) { scan_loader(F.lds, dummy, SCAN_SRC(SCAN_N(0)), SCAN_SRC(SCAN_N(1)), true, lw, lane); }
    else scan_load_regs(RA, Ub, ((size_t)bh * NCH + SCAN_N(0)) * 2 + dir, sl, lane);
    VM_WAIT(); __syncthreads();
    bf16_t* const ocol = ODIR + ((size_t)dir * M + (size_t)b * SEQ) * 512 + h * GD + 16 * sl;
#define SCAN_STEP(step, RC, RN) do { \
        const int n = SCAN_N(step); \
        LAS unsigned char* cur = F.lds + ((step) & 1) * SC_BUF; LAS unsigned char* nxt = F.lds + (((step) + 1) & 1) * SC_BUF; \
        if (compute) { \
            if ((step) > 0) scan_store_o(ow, ocol + (size_t)SCAN_N((step) - 1) * CHUNK * 512, lane); \
            if ((step) + 1 < NCH) scan_load_regs(RN, Ub, ((size_t)bh * NCH + SCAN_N((step) + 1)) * 2 + dir, sl, lane); \
            scan_compute(S, cur, RC, ow, lane); VM_WAIT(); \
        } else if ((step) + 1 < NCH) { const bool pf = ((step) + PFD < NCH); scan_loader(nxt, dummy, SCAN_SRC(SCAN_N((step) + 1)), SCAN_SRC(SCAN_N(pf ? (step) + PFD : (step) + 1)), pf, lw, lane); } \
        (void)n; __syncthreads(); } while (0)
    for (int step = 0; step < NCH; step += 2) { SCAN_STEP(step, RA, RB); SCAN_STEP(step + 1, RB, RA); }
#undef SCAN_STEP
#undef SCAN_SRC
    if (compute) scan_store_o(ow, ocol + (size_t)SCAN_N(NCH - 1) * CHUNK * 512, lane);
#undef SCAN_N
}
typedef float f32x16 __attribute__((ext_vector_type(16)));
constexpr int AT_BTAB = 0;
constexpr int AT_WS = 8 * 260 * 4;
__device__ __forceinline__ void attn_tables(Frame& F, const float* rel_bias) {
    LAS float* bt = (LAS float*)(F.lds + AT_BTAB);
    for (int i = F.tid; i < 8 * 257; i += NWAVES * 64) { const int h = i / 257, r = i % 257; bt[h * 260 + r] = rel_bias[t5_bucket(r - 128) * AH + h]; }
    __syncthreads();
}
__device__ __forceinline__ void attn_task(Frame& F, int task, bf16_t* QC, const bf16_t* KV, const bf16_t* VTP, const float* sink) {
    const int lane = F.lane, q = lane & 31, hh = lane >> 5;
    const int gq = task & 3, qblk = (task >> 2) & 255, bk = task >> 10, kvh = bk & 1, b = bk >> 1, h = kvh * 4 + gq, q0 = qblk * 32;
    const LAS float* bt = (const LAS float*)(F.lds + AT_BTAB) + h * 260;
    LAS float* wsf = (LAS float*)(F.lds + AT_WS) + F.wave * 64;
    bf16x8 qf[4];
    { const bf16_t* qp = QC + (size_t)(b * SEQ + q0 + q) * 1024 + h * 64 + 8 * hh;
#pragma unroll
      for (int s = 0; s < 4; ++s) qf[s] = *(const GAS bf16x8*)(qp + 16 * s); }
    const int T0 = (qblk - 4 < 0) ? 0 : qblk - 4, T1 = (qblk + 4 > SEQ / 32 - 1) ? SEQ / 32 - 1 : qblk + 4;
    const bf16_t* kbase = KV + (size_t)(b * SEQ) * 256 + kvh * 64 + 8 * hh;
    const int qpos = q0 + q;
    float mx = sink[h];
    for (int T = T0; T <= T1; ++T) {
        f32x16 acc;
#pragma unroll
        for (int r = 0; r < 16; ++r) acc[r] = 0.f;
        const bf16_t* kp = kbase + (size_t)(32 * T + q) * 256;
#pragma unroll
        for (int s = 0; s < 4; ++s) { const bf16x8 kf = *(const GAS bf16x8*)(kp + 16 * s); acc = __builtin_amdgcn_mfma_f32_32x32x16_bf16(kf, qf[s], acc, 0, 0, 0); }
#pragma unroll
        for (int r = 0; r < 16; ++r) { const int key = 32 * T + (r & 3) + 8 * (r >> 2) + 4 * hh; const int rel = key - qpos;
            if (rel >= -WIN && rel <= WIN) mx = fmaxf(mx, acc[r] * 0.125f + bt[rel + 128]); }
    }
    mx = fmaxf(mx, __shfl_xor(mx, 32));
    f32x16 o0, o1;
#pragma unroll
    for (int r = 0; r < 16; ++r) { o0[r] = 0.f; o1[r] = 0.f; }
    float l = 0.f;
    const bf16_t* vbase = VTP + ((size_t)(b * AKVH + kvh) * 64 + q) * SEQ + 8 * hh;
    for (int T = T0; T <= T1; ++T) {
        f32x16 acc;
#pragma unroll
        for (int r = 0; r < 16; ++r) acc[r] = 0.f;
        const bf16_t* kp = kbase + (size_t)(32 * T + q) * 256;
#pragma unroll
        for (int s = 0; s < 4; ++s) { const bf16x8 kf = *(const GAS bf16x8*)(kp + 16 * s); acc = __builtin_amdgcn_mfma_f32_32x32x16_bf16(kf, qf[s], acc, 0, 0, 0); }
        float p[16];
#pragma unroll
        for (int r = 0; r < 16; ++r) { const int key = 32 * T + (r & 3) + 8 * (r >> 2) + 4 * hh; const int rel = key - qpos;
            const bool ok = (rel >= -WIN && rel <= WIN);
            const float sc = acc[r] * 0.125f + bt[ok ? rel + 128 : 128];
            p[r] = ok ? __expf(sc - mx) : 0.f; l += p[r]; }
#pragma unroll
        for (int s2 = 0; s2 < 2; ++s2) {
            v4u pw; pw.x = pk2(p[8 * s2], p[8 * s2 + 1]); pw.y = pk2(p[8 * s2 + 2], p[8 * s2 + 3]); pw.z = pk2(p[8 * s2 + 4], p[8 * s2 + 5]); pw.w = pk2(p[8 * s2 + 6], p[8 * s2 + 7]);
            const bf16x8 pa = __builtin_bit_cast(bf16x8, pw);
            const bf16x8 v0 = *(const GAS bf16x8*)(vbase + 32 * T + 16 * s2);
            const bf16x8 v1 = *(const GAS bf16x8*)(vbase + (size_t)32 * SEQ + 32 * T + 16 * s2);
            o0 = __builtin_amdgcn_mfma_f32_32x32x16_bf16(pa, v0, o0, 0, 0, 0);
            o1 = __builtin_amdgcn_mfma_f32_32x32x16_bf16(pa, v1, o1, 0, 0, 0);
        }
    }
    l += __shfl_xor(l, 32);
    l += __expf(sink[h] - mx);
    if (hh == 0) wsf[q] = 1.f / l;
    LDS_WAIT(); asm volatile("" ::: "memory");
    bf16_t* op = QC + (size_t)(b * SEQ + q0) * 1024 + h * 64 + q;
#pragma unroll
    for (int r = 0; r < 16; ++r) { const int qr = (r & 3) + 8 * (r >> 2) + 4 * hh; const float il = wsf[qr];
        op[(size_t)qr * 1024] = (bf16_t)f2bf(o0[r] * il); op[(size_t)qr * 1024 + 32] = (bf16_t)f2bf(o1[r] * il); }
    LDS_WAIT(); asm volatile("" ::: "memory");
}
__device__ __forceinline__ void phase_attn(Frame& F, int aw, int naw, bf16_t* QC, const bf16_t* KV, const bf16_t* VTP, const float* rel_bias, const float* sink) {
    attn_tables(F, rel_bias);
    for (int task = aw; task < BATCH * AKVH * 256 * 4; task += naw) attn_task(F, task, QC, KV, VTP, sink);
}
#define MIXER_PHASES \
    bf16_t* VTP = (bf16_t*)(ws + WS_VTP); (void)VTP; \
    if (IN(2)) { phase_p2a(F, QKVG, KV, conv_w, QHAT, KHAT, KHT, VHT, VTP); if (BOTH(2)) GRID_BAR(); } \
    if (IN(3)) { phase_p2b(F, QHAT, KHAT, KHT, VHT, GATES, a_log, dt_bias, Wb, Ub, QKb, TAB); if (BOTH(3)) GRID_BAR(); } \
    if (IN(4)) { if (blockIdx.x < SCAN_WGS) { const int bx_ = (int)blockIdx.x, slot_ = bx_ >> 3; phase_scan(F, (bx_ & 7) + 8 * (slot_ / SCAN_SPLIT), slot_ % SCAN_SPLIT, QHAT, KHT, Wb, Ub, QKb, TAB, ODIR); } \
                 else phase_attn(F, ((int)blockIdx.x - SCAN_WGS) * NWAVES + F.wave, (F.G - SCAN_WGS) * NWAVES, QC, KV, VTP, rel_bias, attn_sink); \
                 if (BOTH(4)) GRID_BAR(); }
#define HAVE_REF_MIXERS 1
#define REF_P2A k_p2a<<<dim3(M, GH), 128, 0, stream>>>((bf16_t*)(ws + WS_QKVG), (const float*)d_in[5], (bf16_t*)(ws + WS_QHAT), (bf16_t*)(ws + WS_KHAT), (bf16_t*)(ws + WS_KHT), (bf16_t*)(ws + WS_VHT));
#define REF_P2B k_p2b_ref<<<NUNIT * 2, 64, P2B_SMEM, stream>>>((bf16_t*)(ws + WS_QHAT), (bf16_t*)(ws + WS_KHAT), (bf16_t*)(ws + WS_VHT), (float*)(ws + WS_GATES), (const float*)d_in[6], (const float*)d_in[7], (bf16_t*)(ws + WS_W), (bf16_t*)(ws + WS_U), (bf16_t*)(ws + WS_QK), (float*)(ws + WS_TAB));
#define REF_SCAN k_scan_ref<<<16, 128, SCAN_SMEM, stream>>>((bf16_t*)(ws + WS_QHAT), (bf16_t*)(ws + WS_KHT), (bf16_t*)(ws + WS_W), (bf16_t*)(ws + WS_U), (bf16_t*)(ws + WS_QK), (float*)(ws + WS_TAB), (bf16_t*)(ws + WS_ODIR));
#define REF_ATTN k_attn_ref<<<dim3(M / 64, AH), 64, 0, stream>>>((bf16_t*)(ws + WS_QC), (bf16_t*)(ws + WS_KV), (const float*)d_in[3], (const float*)d_in[4]);
#define MEGA(lo, hi, idx) a.ph_lo = lo; a.ph_hi = hi; a.li = idx; hipLaunchKernelGGL(mega, dim3(grid), dim3(NWAVES * 64), LDS_BYTES, stream, a);
#define LAUNCH_PROGRAM { MEGA(0, 10, 0) }
struct Args { const float* in[14]; float* out; unsigned char* ws; int ph_lo, ph_hi, li, pad; };
__global__ void __launch_bounds__(NWAVES * 64, 2) mega(Args args) {
    extern __shared__ __attribute__((aligned(16))) unsigned char lds[];
    Frame F;
    F.lds = (LAS unsigned char*)lds; F.MISC = (volatile LAS unsigned*)(F.lds + MISC_OFF);
    F.tid = threadIdx.x; F.lane = F.tid & 63; F.wave = __builtin_amdgcn_readfirstlane(F.tid >> 6);
    F.G = gridDim.x; { const int bx = blockIdx.x; F.vcu = (F.G % 8 == 0) ? (bx % 8) * (F.G / 8) + bx / 8 : bx; }
    unsigned char* ws = args.ws; F.ctl = (gu32*)(ws + WS_CTL);
    const float* x = args.in[0]; const float* norm_mix_w = args.in[1]; const float* w_in = args.in[2];
    const float* rel_bias = args.in[3]; const float* attn_sink = args.in[4]; const float* conv_w = args.in[5];
    const float* a_log = args.in[6]; const float* dt_bias = args.in[7]; const float* gdn_norm_w = args.in[8];
    const float* w_out = args.in[9]; const float* norm_ffn_w = args.in[10]; const float* w_ffn_in = args.in[11];
    const float* w_ffn_out = args.in[12]; const float* norm_final_w = args.in[13]; float* out = args.out;
    bf16_t* WIN_T = (bf16_t*)(ws + WS_WIN); bf16_t* WOUT_T = (bf16_t*)(ws + WS_WOUT); bf16_t* W1_T = (bf16_t*)(ws + WS_W1); bf16_t* W2_T = (bf16_t*)(ws + WS_W2);
    float* GATES = (float*)(ws + WS_GATES); bf16_t* XN = (bf16_t*)(ws + WS_XN); bf16_t* QHAT = (bf16_t*)(ws + WS_QHAT); bf16_t* KHT = (bf16_t*)(ws + WS_KHT); bf16_t* HB = (bf16_t*)(ws + WS_HB);
    bf16_t* QC = (bf16_t*)(ws + WS_QC); bf16_t* KV = (bf16_t*)(ws + WS_KV); bf16_t* Z = (bf16_t*)(ws + WS_Z); bf16_t* QKVG = (bf16_t*)(ws + WS_QKVG);
    bf16_t* Wb = (bf16_t*)(ws + WS_W); bf16_t* QKb = (bf16_t*)(ws + WS_QK); bf16_t* KHAT = (bf16_t*)(ws + WS_KHAT); bf16_t* VHT = (bf16_t*)(ws + WS_VHT); bf16_t* ODIR = (bf16_t*)(ws + WS_ODIR);
    bf16_t* Ub = (bf16_t*)(ws + WS_U); float* TAB = (float*)(ws + WS_TAB); float* SSQ1 = (float*)(ws + WS_SSQ1); float* SSQ2 = (float*)(ws + WS_SSQ2); bf16_t* ACT = (bf16_t*)(ws + WS_ACT);
    (void)rel_bias; (void)attn_sink; (void)conv_w; (void)a_log; (void)dt_bias; (void)QHAT; (void)KHT; (void)QKVG; (void)Wb; (void)QKb; (void)KHAT; (void)VHT; (void)Ub; (void)TAB; (void)KV;
    for (int u = F.tid; u < (LDS_BYTES - LDSCTL_OFF) / 4; u += NWAVES * 64) ((LAS unsigned*)(F.lds + LDSCTL_OFF))[u] = 0u;
    __syncthreads();
    XcdBarrier bar = xcd_barrier_post((unsigned*)(F.ctl + CW_BAR) + args.li * XCD_BAR_WORDS, F.MISC + 8);
    const int lo = args.ph_lo, hi = args.ph_hi;
#define IN(k) (lo <= (k) && (k) < hi)
#define BOTH(k) (IN(k) && IN((k) + 1))
#define GRID_BAR() xcd_barrier(bar)
    if (IN(0)) { P0Args a{x, norm_mix_w, w_in, w_out, norm_ffn_w, w_ffn_in, w_ffn_out, WIN_T, WOUT_T, W1_T, W2_T, XN, GATES}; phase_p0(F, a); if (BOTH(0)) GRID_BAR(); }
    if (IN(1)) { pg8::Gemm g{XN, WIN_T, M, NPROJ, DM, 0}; pg8::StaticOrder S; S.init(M, NPROJ, F.G, (int)blockIdx.x); pg8::EpiProj E{QC, KV, QKVG, Z};
        pg8::gemm_phase<pg8::EpiProj, pg8::StaticOrder, true, true>(F.lds, g, S, E); if (BOTH(1)) GRID_BAR(); }
    MIXER_PHASES
    if (IN(5)) { phase_p4(F, ODIR, Z, gdn_norm_w, QC); if (BOTH(5)) GRID_BAR(); }
    if (IN(6)) { pg8::Gemm g{QC, WOUT_T, M, DM, DM, 0}; pg8::StaticOrder S; S.init(M, DM, F.G, (int)blockIdx.x); pg8::EpiRes E{x, out, HB, SSQ1};
        pg8::gemm_phase<pg8::EpiRes, pg8::StaticOrder, false, true>(F.lds, g, S, E); if (BOTH(6)) GRID_BAR(); }
    if (IN(7)) { pg8::Gemm g{HB, W1_T, M, DFF, DM, 0}; pg8::StaticOrder S; S.init(M, DFF, F.G, (int)blockIdx.x); pg8::EpiFfn1 E{ACT, SSQ1};
        pg8::gemm_phase<pg8::EpiFfn1, pg8::StaticOrder, true, true>(F.lds, g, S, E); if (BOTH(7)) GRID_BAR(); }
    if (IN(8)) { pg8::Gemm g{ACT, W2_T, M, DM, DFF, 0}; pg8::StaticOrder S; S.init(M, DM, F.G, (int)blockIdx.x); pg8::EpiRes E{out, out, nullptr, SSQ2};
        pg8::gemm_phase<pg8::EpiRes, pg8::StaticOrder, false, true>(F.lds, g, S, E); if (BOTH(8)) GRID_BAR(); }
    if (IN(9)) { phase_p8(F, out, SSQ2, norm_final_w); }
#undef IN
#undef BOTH
}
extern "C" void kernel_launch(void* const* d_in, const int* in_sizes, int n_in, void* d_out, int out_size, void* d_ws, size_t ws_size, hipStream_t stream) {
    static int grid = 0;
    constexpr int P2B_SMEM = (64 * 129 * 2 + 64 * 65 * 2 + 192) * 4, SCAN_SMEM = (128 * 128 + 64 * 128 * 2 + 64 * 64) * 4;
    if (grid == 0) {
        if (n_in != 14 || ws_size < WS_END) { fprintf(stderr, "kernel_launch: unexpected inputs (n_in %d, ws %zu)\n", n_in, ws_size); grid = -1; return; }
        int dev = 0, cus = 0, per_cu = 0;
        if (hipGetDevice(&dev) != hipSuccess || hipDeviceGetAttribute(&cus, hipDeviceAttributeMultiprocessorCount, dev) != hipSuccess) { grid = -1; return; }
        if (hipFuncSetAttribute((const void*)mega, hipFuncAttributeMaxDynamicSharedMemorySize, LDS_BYTES) != hipSuccess) { fprintf(stderr, "kernel_launch: hipFuncSetAttribute failed\n"); grid = -1; return; }
        if (hipOccupancyMaxActiveBlocksPerMultiprocessor(&per_cu, (const void*)mega, NWAVES * 64, LDS_BYTES) != hipSuccess || per_cu < 1) { fprintf(stderr, "kernel_launch: occupancy query says %d\n", per_cu); per_cu = 1; }
        (void)hipGetLastError();
        grid = cus * 1;
#ifdef HAVE_REF_MIXERS
        (void)hipFuncSetAttribute((const void*)k_p2b_ref, hipFuncAttributeMaxDynamicSharedMemorySize, P2B_SMEM);
        (void)hipFuncSetAttribute((const void*)k_scan_ref, hipFuncAttributeMaxDynamicSharedMemorySize, SCAN_SMEM);
#endif
    }
    if (grid < 0) return;
    if (hipMemsetAsync((char*)d_ws + WS_CTL, 0, CTL_ZERO_BYTES, stream) != hipSuccess) return;
    Args a{};
    for (int i = 0; i < 14; ++i) a.in[i] = (const float*)d_in[i];
    a.out = (float*)d_out; a.ws = (unsigned char*)d_ws;
    LAUNCH_PROGRAM
}
```

```cpp
#include <hip/hip_runtime.h>
#include <cstdio>
#include <cstdint>

constexpr int BATCH = 2, SEQ = 8192, DM = 1024, M = BATCH * SEQ;
constexpr int AH = 8, AKVH = 2, AHD = 64, WIN = 128;
constexpr int GH = 4, GD = 128, CONVK = 5, CHUNK = 64, NCH = SEQ / CHUNK;
constexpr int DFF = 4096, DIN = 2832, NPROJ = 2816;
constexpr float EPS = 1e-6f;
constexpr int NUNIT = BATCH * GH * NCH;

constexpr size_t MiB = 1u << 20;
constexpr size_t WS_CTL = 0, CTL_ZERO_BYTES = 1 * MiB;
constexpr size_t WS_WIN = 1 * MiB;
constexpr size_t WS_WOUT = 7 * MiB;
constexpr size_t WS_W1 = 9 * MiB;
constexpr size_t WS_W2 = 17 * MiB;
constexpr size_t WS_GATES = 25 * MiB;
constexpr size_t WS_XN = 26 * MiB;
constexpr size_t WS_QHAT = 26 * MiB, WS_KHT = 42 * MiB, WS_HB = 26 * MiB;
constexpr size_t WS_QC = 58 * MiB;
constexpr size_t WS_KV = 90 * MiB;
constexpr size_t WS_Z = 98 * MiB;
constexpr size_t WS_QKVG = 114 * MiB;
constexpr size_t WS_W = 114 * MiB, WS_QK = 146 * MiB;
constexpr size_t WS_TMP = 162 * MiB;
constexpr size_t WS_KHAT = 162 * MiB, WS_VHT = 178 * MiB, WS_ODIR = 162 * MiB;
constexpr size_t WS_U = 194 * MiB;
constexpr size_t WS_TAB = 226 * MiB;
constexpr size_t WS_SSQ1 = 228 * MiB;
constexpr size_t WS_SSQ2 = 229 * MiB;
constexpr size_t WS_ACT = 58 * MiB;
constexpr size_t WS_END = 256 * MiB;
static_assert(WS_ACT + (size_t)M * DFF * 2 <= WS_U && WS_SSQ2 + (size_t)M * 16 * 4 <= WS_END, "d_ws map");

typedef unsigned short bf16_t;
__host__ __device__ __forceinline__ unsigned f2bf(float f) { unsigned u = __builtin_bit_cast(unsigned, f); return (u + 0x7fffu + ((u >> 16) & 1u)) >> 16; }
__host__ __device__ __forceinline__ float bf2f(unsigned h) { return __builtin_bit_cast(float, (h & 0xffffu) << 16); }
__host__ __device__ __forceinline__ unsigned pk2(float lo, float hi) { return f2bf(lo) | (f2bf(hi) << 16); }

__host__ __device__ __forceinline__ int kperm(int a) { return (a & ~31) | ((a & 12) << 1) | ((a & 16) >> 2) | (a & 3); }
__host__ __device__ __forceinline__ int offA(int row, int col) { const int p = kperm(col); return row * 128 + ((((p >> 3) ^ (row & 15)) << 3) | (p & 7)); }
__host__ __device__ __forceinline__ int offT(int row, int col) { const int p = kperm(col); return row * 64 + ((((p >> 3) ^ ((row >> 1) & 7)) << 3) | (p & 7)); }
__host__ __device__ __forceinline__ int offU(int c, int dv) { return (((dv >> 4) * 4 + (c >> 4)) * 64 + ((c >> 2) & 3) * 16 + (dv & 15)) * 4 + (c & 3); }
constexpr int BLOB = 64 * 128;
constexpr int QKBLOB = 64 * 64;
constexpr int TABW = 192;
namespace pg8 {
#define PG8_LAS __attribute__((address_space(3)))
typedef unsigned short bf16_t;
typedef short bf16x8 __attribute__((ext_vector_type(8)));
typedef float f32x4 __attribute__((ext_vector_type(4)));
typedef unsigned u32x4 __attribute__((ext_vector_type(4)));
constexpr int BM = 256, BK = 64, HALF = 128, HTB = HALF * BK * 2  , STAGE_BYTES = 8 * HTB, NXCD = 8, WGM = 8;

__host__ __device__ __forceinline__ int lds_byte(int r, int c) { const int st = (r >> 4) * 2 + (c >> 5), rr = r & 15, cc = c & 31, ob = rr * 64 + cc * 2; return st * 1024 + (ob ^ (((ob >> 9) & 1) << 5)); }
__host__ __device__ __forceinline__ void stage_rc(int b, int& R, int& C) { const int st = b / 1024, sb = b % 1024, swz = sb ^ (((sb >> 9) & 1) << 5); R = (st >> 1) * 16 + swz / 64; C = (st & 1) * 32 + (swz % 64) / 2; }
__host__ __device__ __forceinline__ int perm32(int rho) { const int n = rho >> 4, i = rho & 15; return 8 * (i >> 2) + 4 * n + (i & 3); }

struct Unit { int pm, pn; };
struct Gemm { const bf16_t* A; const bf16_t* Bt; int M, N, K, pad; };

struct StaticOrder {
    int nM, nN, nwg, G, c;
    __host__ __device__ void init(int M, int N, int G_, int c_) { nM = M / BM; nN = N / BM; nwg = nM * nN; G = G_; c = c_; }
    __host__ __device__ bool next(int i, Unit& u) const {
        const long L = (long)i * G + c; if (L >= nwg) return false;
        int wgid = (int)L; { const int q = nwg / NXCD, r = nwg % NXCD, xcd = wgid % NXCD, off = wgid / NXCD; wgid = (xcd < r ? xcd * (q + 1) : r * (q + 1) + (xcd - r) * q) + off; }
        const int nig = WGM * nN, gid = wgid / nig, fm = gid * WGM, gsz = (nM - fm) < WGM ? (nM - fm) : WGM;
        u.pm = fm + ((wgid % nig) % gsz); u.pn = (wgid % nig) / gsz; return true;
    }
    __device__ __forceinline__ void a_ready(const Unit&) const {}
    __device__ __forceinline__ void done(const Unit&) const {}
};

__device__ __forceinline__ unsigned cvt_pk_bf16(float lo, float hi) { unsigned r; asm volatile("v_cvt_pk_bf16_f32 %0, %1, %2" : "=v"(r) : "v"(lo), "v"(hi)); return r; }
typedef float f32x2 __attribute__((ext_vector_type(2)));
__device__ __forceinline__ f32x2 gelu_pk(f32x2 v) {
    const f32x2 av = __builtin_elementwise_abs(v), d = av * 0.2316418882f + 1.0f;
    f32x2 t; t.x = __builtin_amdgcn_rcpf(d.x); t.y = __builtin_amdgcn_rcpf(d.y);
    f32x2 q = t * 0.5307027145f + (-0.7265760135f); q = q * t + 0.7107068705f; q = q * t + (-0.142248368f); q = q * t + 0.127414796f; q = q * t;
    const f32x2 s = (v * v) * (-0.72134752044f);
    f32x2 e; e.x = __builtin_amdgcn_exp2f(s.x); e.y = __builtin_amdgcn_exp2f(s.y);
    const f32x2 m = v * (q * e), r = v - m;
    f32x2 o; o.x = v.x < 0.f ? m.x : r.x; o.y = v.y < 0.f ? m.y : r.y; return o;
}

template <int ACT  > struct EpiBf16 {
    static constexpr bool PERM = true, AFTER_DRAIN = false; static_assert(ACT == 0 || ACT == 1, "EpiBf16: ACT is 0 (none) or 1 (gelu_pk)");
    bf16_t* O; int ldc; const float* bias; int split_cols; size_t split_stride; float scale0;
    __device__ __forceinline__ void operator()(const f32x4 (&acc)[2][2][4][2], const Unit& u, int wr, int wc, int fr, int fq) const {
        const int row0 = u.pm * BM + wr * 64 + fr; int colt = u.pn * BM; bf16_t* base = O;
        float sc = 1.f; if (split_cols) { const int t = colt / split_cols; base += (size_t)t * split_stride; colt -= t * split_cols; if (t == 0) sc = scale0; }
        const int col0 = colt + wc * 32 + 8 * fq, bcol0 = u.pn * BM + wc * 32 + 8 * fq;
        f32x4 bv[2][2];
#pragma unroll
        for (int bj = 0; bj < 2; ++bj)
#pragma unroll
            for (int n = 0; n < 2; ++n) bv[bj][n] = bias ? *(const f32x4*)(bias + bcol0 + bj * HALF + 4 * n) : (f32x4){0.f, 0.f, 0.f, 0.f};
#pragma unroll
        for (int ai = 0; ai < 2; ++ai)
#pragma unroll
            for (int m = 0; m < 4; ++m) { bf16_t* rowp = base + (size_t)(row0 + ai * HALF + m * 16) * ldc + col0;
#pragma unroll
                for (int bj = 0; bj < 2; ++bj) { f32x4 v0 = acc[ai][bj][m][0] + bv[bj][0], v1 = acc[ai][bj][m][1] + bv[bj][1];
                    if (ACT == 1) { f32x2 a = gelu_pk((f32x2){v0[0], v0[1]}), b = gelu_pk((f32x2){v0[2], v0[3]}), c = gelu_pk((f32x2){v1[0], v1[1]}), d = gelu_pk((f32x2){v1[2], v1[3]});
                        v0 = (f32x4){a.x, a.y, b.x, b.y}; v1 = (f32x4){c.x, c.y, d.x, d.y}; }
                    v0 = v0 * sc; v1 = v1 * sc; u32x4 w; w.x = cvt_pk_bf16(v0[0], v0[1]); w.y = cvt_pk_bf16(v0[2], v0[3]); w.z = cvt_pk_bf16(v1[0], v1[1]); w.w = cvt_pk_bf16(v1[2], v1[3]);
                    *(u32x4*)(rowp + bj * HALF) = w; } }
    }
};

struct PanelStats {
    unsigned* xbuf;
    unsigned* cnt;
    unsigned* tmo;
    int ntn; float eps;
    unsigned code;
    __device__ __forceinline__ bool run(const f32x4 (&v)[2][2][4][2], const Unit& u, int wr, int wc, int fr, int fq, PG8_LAS unsigned char* lds, int wid, int lane) const {
        typedef float f32x2v __attribute__((ext_vector_type(2)));
        PG8_LAS f32x2v* P = (PG8_LAS f32x2v*)lds;
        PG8_LAS f32x2v* S = (PG8_LAS f32x2v*)(lds + 8192);
        PG8_LAS unsigned* flag = (PG8_LAS unsigned*)(lds + 8192 + 2048);
#pragma unroll
        for (int ai = 0; ai < 2; ++ai)
#pragma unroll
            for (int m = 0; m < 4; ++m) {
                float s = 0.f;
#pragma unroll
                for (int bj = 0; bj < 2; ++bj)
#pragma unroll
                    for (int n = 0; n < 2; ++n) { const f32x4 x = v[ai][bj][m][n]; s += (x[0] + x[1]) + (x[2] + x[3]); }
                s += __shfl_xor(s, 16); s += __shfl_xor(s, 32);
                const float mw = s * (1.0f / 64.0f); float q = 0.f;
#pragma unroll
                for (int bj = 0; bj < 2; ++bj)
#pragma unroll
                    for (int n = 0; n < 2; ++n) { const f32x4 d = v[ai][bj][m][n] - mw; q += (d[0] * d[0] + d[1] * d[1]) + (d[2] * d[2] + d[3] * d[3]); }
                q += __shfl_xor(q, 16); q += __shfl_xor(q, 32);
                if (fq == 0) P[(ai * HALF + wr * 64 + m * 16 + fr) * 4 + wc] = (f32x2v){mw, q};
            }
        asm volatile("s_waitcnt lgkmcnt(0)" ::: "memory"); __builtin_amdgcn_s_barrier(); asm volatile("" ::: "memory");
#if defined(BROKEN_EXCHANGE_NO_WAIT)
#warning BROKEN CONTROL BUILD: the row-statistics exchange does not wait; results are wrong by design
        if (blockIdx.x >= 64) { const long long t0_ = clock64(); while (clock64() - t0_ < 60000) __builtin_amdgcn_s_sleep(8); }
#endif
        const int row = wid * 32 + (lane & 31);
        if (lane < 32) {
            const f32x2v a = P[row * 4 + 0], b = P[row * 4 + 1], c = P[row * 4 + 2], d = P[row * 4 + 3];
            const float mt = (a.x + b.x + c.x + d.x) * 0.25f;
            const float da = a.x - mt, db = b.x - mt, dc = c.x - mt, dd = d.x - mt;
            const float m2 = (a.y + b.y) + (c.y + d.y) + 64.0f * ((da * da + db * db) + (dc * dc + dd * dd));
            unsigned long long* slot = (unsigned long long*)xbuf + ((size_t)(u.pm * BM + row) * 4 + u.pn);
            __hip_atomic_store(slot, ((unsigned long long)__float_as_uint(m2) << 32) | __float_as_uint(mt), __ATOMIC_RELAXED, __HIP_MEMORY_SCOPE_AGENT);
        }
        asm volatile("s_waitcnt vmcnt(0)" ::: "memory");
        if (lane == 0) __hip_atomic_fetch_add(cnt + 64 * u.pm, 1u, __ATOMIC_RELAXED, __HIP_MEMORY_SCOPE_AGENT);
        if (wid == 0) {
            bool dead = false; const unsigned long long t0 = __builtin_amdgcn_s_memrealtime(); const unsigned want = 8u * (unsigned)ntn;
            for (;;) {
#if defined(BROKEN_EXCHANGE_NO_WAIT)
                break;
#endif
                if ((unsigned)__builtin_amdgcn_readfirstlane(__hip_atomic_load(cnt + 64 * u.pm, __ATOMIC_RELAXED, __HIP_MEMORY_SCOPE_AGENT)) >= want) break;
                if (__builtin_amdgcn_s_memrealtime() - t0 > 2000000ull) {
                    if (lane == 0) { unsigned expect = 0u; __hip_atomic_compare_exchange_strong(tmo + 1, &expect, code | (unsigned)(u.pm & 0xff), __ATOMIC_RELAXED, __ATOMIC_RELAXED, __HIP_MEMORY_SCOPE_AGENT);
                                     __hip_atomic_store(tmo, 1u, __ATOMIC_RELAXED, __HIP_MEMORY_SCOPE_AGENT); }
                    dead = true; break; }
                __builtin_amdgcn_s_sleep(2);
            }
            __builtin_amdgcn_fence(__ATOMIC_ACQUIRE, "agent");
            if (lane == 0) flag[0] = dead ? 1u : 0u;
        }
        asm volatile("s_waitcnt vmcnt(0) lgkmcnt(0)" ::: "memory"); __builtin_amdgcn_s_barrier(); asm volatile("" ::: "memory");
        const bool bad = flag[0] != 0u;
        if (lane < 32) {
            const unsigned long long* slot = (const unsigned long long*)xbuf + (size_t)(u.pm * BM + row) * 4; float mt[4], m2[4]; float ms = 0.f;
#pragma unroll
            for (int t = 0; t < 4; ++t) { if (t < ntn) { const unsigned long long w = __hip_atomic_load(slot + t, __ATOMIC_RELAXED, __HIP_MEMORY_SCOPE_AGENT); mt[t] = __uint_as_float((unsigned)w); m2[t] = __uint_as_float((unsigned)(w >> 32)); } else { mt[t] = 0.f; m2[t] = 0.f; } ms += mt[t]; }
            const float mean = ms / (float)ntn; float q = 0.f;
#pragma unroll
            for (int t = 0; t < 4; ++t) if (t < ntn) { const float dm = mt[t] - mean; q += m2[t] + 256.0f * dm * dm; }
            S[row] = (f32x2v){mean, 1.0f / sqrtf(q / (256.0f * (float)ntn) + eps)};
        }
        asm volatile("s_waitcnt lgkmcnt(0)" ::: "memory"); __builtin_amdgcn_s_barrier(); asm volatile("" ::: "memory");
        return bad;
    }
};
struct EpiLnRes {
    static constexpr bool PERM = false, AFTER_DRAIN = true;
    const float* base; float* out; int ldc; const float* bias; PanelStats st; unsigned poison;
    __device__ __forceinline__ void fused(f32x4 (&acc)[2][2][4][2], const Unit& u, int wr, int wc, int fr, int fq, PG8_LAS unsigned char* lds, int wid, int lane) const {
        typedef float f32x2v __attribute__((ext_vector_type(2)));
        const PG8_LAS f32x2v* S = (const PG8_LAS f32x2v*)(lds + 8192);
        const int col0 = u.pn * BM + wc * 32 + 4 * fq;
#pragma unroll
        for (int bj = 0; bj < 2; ++bj)
#pragma unroll
            for (int n = 0; n < 2; ++n) { const f32x4 bv = bias ? *(const f32x4*)(bias + col0 + bj * HALF + n * 16) : (f32x4){0.f, 0.f, 0.f, 0.f};
#pragma unroll
                for (int ai = 0; ai < 2; ++ai)
#pragma unroll
                    for (int m = 0; m < 4; ++m) acc[ai][bj][m][n] += bv; }
        f32x4 pre[4][2][2];
#pragma unroll
        for (int m = 0; m < 4; ++m) { const size_t off = (size_t)(u.pm * BM + wr * 64 + m * 16 + fr) * ldc + col0;
#pragma unroll
            for (int bj = 0; bj < 2; ++bj)
#pragma unroll
                for (int n = 0; n < 2; ++n) pre[m][bj][n] = *(const f32x4*)(base + off + bj * HALF + n * 16); }
        const bool bad = st.run(acc, u, wr, wc, fr, fq, lds, wid, lane) || poison != 0u;
        const float qnan = __builtin_nanf("");
#pragma unroll
        for (int ai = 0; ai < 2; ++ai)
#pragma unroll
            for (int m = 0; m < 4; ++m) { const int r = ai * HALF + wr * 64 + m * 16 + fr; const f32x2v sr = S[r]; const size_t off = (size_t)(u.pm * BM + r) * ldc + col0;
#pragma unroll
                for (int bj = 0; bj < 2; ++bj)
#pragma unroll
                    for (int n = 0; n < 2; ++n) { const f32x4 bs = ai == 0 ? pre[m][bj][n] : *(const f32x4*)(base + off + bj * HALF + n * 16); f32x4 o = bs + (acc[ai][bj][m][n] - sr.x) * sr.y;
                        if (bad) o = (f32x4){qnan, qnan, qnan, qnan}; *(f32x4*)(out + off + bj * HALF + n * 16) = o; }
                if (m & 1) asm volatile("" ::: "memory"); }
    }
};
struct EpiLnResLn {
    static constexpr bool PERM = false, AFTER_DRAIN = true;
    const float* base; float* out; bf16_t* xn; int ldc; const float* bias; PanelStats st1, st2; unsigned poison;
    __device__ __forceinline__ void fused(f32x4 (&acc)[2][2][4][2], const Unit& u, int wr, int wc, int fr, int fq, PG8_LAS unsigned char* lds, int wid, int lane) const {
        typedef float f32x2v __attribute__((ext_vector_type(2))); typedef unsigned u32x2v __attribute__((ext_vector_type(2)));
        const PG8_LAS f32x2v* S = (const PG8_LAS f32x2v*)(lds + 8192);
        const int col0 = u.pn * BM + wc * 32 + 4 * fq;
#pragma unroll
        for (int bj = 0; bj < 2; ++bj)
#pragma unroll
            for (int n = 0; n < 2; ++n) { const f32x4 bv = bias ? *(const f32x4*)(bias + col0 + bj * HALF + n * 16) : (f32x4){0.f, 0.f, 0.f, 0.f};
#pragma unroll
                for (int ai = 0; ai < 2; ++ai)
#pragma unroll
                    for (int m = 0; m < 4; ++m) acc[ai][bj][m][n] += bv; }
        bool bad = st1.run(acc, u, wr, wc, fr, fq, lds, wid, lane) || poison != 0u;
        const float qnan = __builtin_nanf("");
#pragma unroll
        for (int ai = 0; ai < 2; ++ai)
#pragma unroll
            for (int m = 0; m < 4; ++m) { const int r = ai * HALF + wr * 64 + m * 16 + fr; const f32x2v sr = S[r]; const size_t off = (size_t)(u.pm * BM + r) * ldc + col0;
#pragma unroll
                for (int bj = 0; bj < 2; ++bj)
#pragma unroll
                    for (int n = 0; n < 2; ++n) { const f32x4 bs = *(const f32x4*)(base + off + bj * HALF + n * 16); acc[ai][bj][m][n] = bs + (acc[ai][bj][m][n] - sr.x) * sr.y; }
                asm volatile("" : "+v"(acc[ai][0][m][0]), "+v"(acc[ai][0][m][1]), "+v"(acc[ai][1][m][0]), "+v"(acc[ai][1][m][1]));
                if (m & 1) asm volatile("" ::: "memory"); }
        const bool bad1 = bad;
        bad = st2.run(acc, u, wr, wc, fr, fq, lds, wid, lane) || bad;
#pragma unroll
        for (int ai = 0; ai < 2; ++ai)
#pragma unroll
            for (int m = 0; m < 4; ++m) { const int r = ai * HALF + wr * 64 + m * 16 + fr; const f32x2v sr = S[r]; const size_t off = (size_t)(u.pm * BM + r) * ldc + col0;
#pragma unroll
                for (int bj = 0; bj < 2; ++bj)
#pragma unroll
                    for (int n = 0; n < 2; ++n) { const f32x4 x1 = acc[ai][bj][m][n]; *(f32x4*)(out + off + bj * HALF + n * 16) = bad1 ? (f32x4){qnan, qnan, qnan, qnan} : x1;
                        const f32x4 o = (x1 - sr.x) * sr.y; u32x2v w; w.x = cvt_pk_bf16(o[0], o[1]); w.y = cvt_pk_bf16(o[2], o[3]);
                        if (bad) { w.x = 0x7fc07fc0u; w.y = 0x7fc07fc0u; } *(u32x2v*)(xn + off + bj * HALF + n * 16) = w; }
                asm volatile("" ::: "memory"); }
    }
};

template <class Epi, class Sched, bool ALIGN_EPI = false, bool SP2 = false>
__device__ __forceinline__ void gemm_phase(PG8_LAS unsigned char* lds, const Gemm g, const Sched& S, const Epi& E) {
    const int tid = threadIdx.x, wid = __builtin_amdgcn_readfirstlane(tid >> 6), lane = tid & 63, wr = wid >> 2, wc = wid & 3, fr = lane & 15, fq = lane >> 4;
    const int K = g.K, nt = K / BK;
    unsigned voffA[2], voffB[2];
#pragma unroll
    for (int i = 0; i < 2; ++i) { int R, C; stage_rc(tid * 16 + i * 8192, R, C); const int Rb = Epi::PERM ? ((R & ~31) + perm32(R & 31)) : R;
        voffA[i] = (unsigned)(R * K + C) * 2u; voffB[i] = (unsigned)(Rb * K + C) * 2u; }
    const size_t kstep = (size_t)(BK * 2);
    const size_t hstep = (size_t)HALF * K * 2;
    const size_t tstep = 2 * hstep;
    const unsigned ldsw = (unsigned)wid * 1024u;
    const int aoff = lds_byte(wr * 64 + fr, fq * 8), boff = lds_byte(wc * 32 + fr, fq * 8);
#define PG8_SA(b, h) (((b) * 2 + (h)) * HTB)
#define PG8_SB(b, h) ((4 + (b) * 2 + (h)) * HTB)
#define PG8_STAGE(bufoff, gbase, voff) do { _Pragma("unroll") for (int _i = 0; _i < 2; ++_i) \
        __builtin_amdgcn_global_load_lds((const unsigned*)((const char*)(gbase) + (voff)[_i]), (PG8_LAS unsigned*)(lds + (bufoff) + ldsw + _i * 8192), 16, 0, 0); } while (0)
#define PG8_LDA(dst, b, h) do { _Pragma("unroll") for (int m = 0; m < 4; ++m) _Pragma("unroll") for (int k = 0; k < 2; ++k) dst[m][k] = *(const PG8_LAS bf16x8*)(lds + PG8_SA(b, h) + aoff + m * 2048 + k * 1024); } while (0)
#define PG8_LDB(dst, b, h) do { _Pragma("unroll") for (int n = 0; n < 2; ++n) _Pragma("unroll") for (int k = 0; k < 2; ++k) dst[n][k] = *(const PG8_LAS bf16x8*)(lds + PG8_SB(b, h) + boff + n * 2048 + k * 1024); } while (0)
#define PG8_MMA(ai, bj, At, Bt) do { __builtin_amdgcn_s_setprio(1); _Pragma("unroll") for (int m = 0; m < 4; ++m) _Pragma("unroll") for (int n = 0; n < 2; ++n) _Pragma("unroll") for (int k = 0; k < 2; ++k) \
        acc[ai][bj][m][n] = __builtin_amdgcn_mfma_f32_16x16x32_bf16(Bt[n][k], At[m][k], acc[ai][bj][m][n], 0, 0, 0); __builtin_amdgcn_s_setprio(0); } while (0)
#define PG8_WAIT_V(n) asm volatile("s_waitcnt vmcnt(" #n ")" ::: "memory")
#define PG8_WAIT_L(n) asm volatile("s_waitcnt lgkmcnt(" #n ")" ::: "memory")
#define PG8_BAR __builtin_amdgcn_s_barrier()
#define PG8_SCHED __builtin_amdgcn_sched_barrier(0)
    Unit cur, nxt; int ui = 0;
    if (!S.next(0, cur)) return;
    f32x4 acc[2][2][4][2];
#pragma unroll
    for (int a = 0; a < 2; ++a)
#pragma unroll
        for (int b = 0; b < 2; ++b)
#pragma unroll
            for (int m = 0; m < 4; ++m)
#pragma unroll
                for (int n = 0; n < 2; ++n) acc[a][b][m][n] = (f32x4){0.f, 0.f, 0.f, 0.f};
    bf16x8 At[4][2], B0[2][2], B1[2][2];
    const char* cA = (const char*)g.A + (size_t)cur.pm * tstep; const char* cB = (const char*)g.Bt + (size_t)cur.pn * tstep;
    S.a_ready(cur);
    if constexpr (SP2) {
        PG8_STAGE(PG8_SB(0, 0), cB, voffB); PG8_STAGE(PG8_SB(0, 1), cB + hstep, voffB); PG8_STAGE(PG8_SA(0, 0), cA, voffA); PG8_STAGE(PG8_SA(0, 1), cA + hstep, voffA);
        if (wr == 1) PG8_BAR;
        PG8_WAIT_V(2); PG8_BAR;
        PG8_STAGE(PG8_SB(1, 0), cB + kstep, voffB); PG8_STAGE(PG8_SA(1, 0), cA + kstep, voffA); PG8_STAGE(PG8_SB(1, 1), cB + hstep + kstep, voffB);
        PG8_WAIT_V(6); PG8_BAR;
    } else {
        PG8_STAGE(PG8_SB(0, 0), cB, voffB); PG8_STAGE(PG8_SA(0, 0), cA, voffA); PG8_STAGE(PG8_SB(0, 1), cB + hstep, voffB); PG8_STAGE(PG8_SA(0, 1), cA + hstep, voffA);
        if (wr == 1) PG8_BAR;
        PG8_WAIT_V(4); PG8_BAR;
        PG8_STAGE(PG8_SB(1, 0), cB + kstep, voffB); PG8_STAGE(PG8_SA(1, 0), cA + kstep, voffA); PG8_STAGE(PG8_SB(1, 1), cB + hstep + kstep, voffB);
        PG8_WAIT_V(6); PG8_BAR;
    }
    for (;;) {
        const bool has_next = S.next(ui + 1, nxt);
        const char* nA = has_next ? (const char*)g.A + (size_t)nxt.pm * tstep : cA; const char* nB = has_next ? (const char*)g.Bt + (size_t)nxt.pn * tstep : cB;
        for (int t = 0; t < nt; t += 2) {
            const bool last = (t == nt - 2);
            const char* a1 = cA + (size_t)(t + 1) * kstep;
            const char* a2 = last ? nA : cA + (size_t)(t + 2) * kstep; const char* b2 = last ? nB : cB + (size_t)(t + 2) * kstep;
            const char* a3 = a2 + kstep; const char* b3 = b2 + kstep;
            if (last && has_next) S.a_ready(nxt);
            if constexpr (SP2) {
            PG8_LDB(B0, 0, 0); PG8_LDB(B1, 0, 1); PG8_SCHED; PG8_LDA(At, 0, 0); PG8_STAGE(PG8_SA(1, 1), a1 + hstep, voffA);
            PG8_WAIT_V(8); PG8_WAIT_L(0); PG8_BAR; PG8_MMA(0, 0, At, B0); PG8_MMA(0, 1, At, B1); PG8_BAR; PG8_SCHED;
            PG8_LDA(At, 0, 1); PG8_STAGE(PG8_SB(0, 0), b2, voffB); PG8_STAGE(PG8_SB(0, 1), b2 + hstep, voffB); PG8_STAGE(PG8_SA(0, 0), a2, voffA);
            PG8_WAIT_V(8); PG8_WAIT_L(0); PG8_BAR; PG8_MMA(1, 0, At, B0); PG8_MMA(1, 1, At, B1); PG8_BAR; PG8_SCHED;
            PG8_LDB(B0, 1, 0); PG8_LDB(B1, 1, 1); PG8_SCHED; PG8_LDA(At, 1, 0); PG8_STAGE(PG8_SA(0, 1), a2 + hstep, voffA);
            PG8_WAIT_V(8); PG8_WAIT_L(0); PG8_BAR; PG8_MMA(0, 0, At, B0); PG8_MMA(0, 1, At, B1); PG8_BAR; PG8_SCHED;
            PG8_LDA(At, 1, 1); PG8_STAGE(PG8_SB(1, 0), b3, voffB); PG8_STAGE(PG8_SB(1, 1), b3 + hstep, voffB); PG8_STAGE(PG8_SA(1, 0), a3, voffA);
            PG8_WAIT_V(8); PG8_WAIT_L(0); PG8_BAR; PG8_MMA(1, 0, At, B0); PG8_MMA(1, 1, At, B1); PG8_BAR; PG8_SCHED;
            } else {
            PG8_LDB(B0, 0, 0); PG8_SCHED; PG8_LDA(At, 0, 0); PG8_STAGE(PG8_SA(1, 1), a1 + hstep, voffA);
            PG8_WAIT_L(8); PG8_BAR; PG8_WAIT_L(0); PG8_MMA(0, 0, At, B0); PG8_BAR; PG8_SCHED;
            PG8_LDB(B1, 0, 1); PG8_STAGE(PG8_SB(0, 0), b2, voffB);
            PG8_BAR; PG8_WAIT_L(0); PG8_MMA(0, 1, At, B1); PG8_BAR;
            PG8_LDA(At, 0, 1); PG8_STAGE(PG8_SA(0, 0), a2, voffA);
            PG8_BAR; PG8_WAIT_L(0); PG8_MMA(1, 0, At, B0); PG8_BAR; PG8_SCHED;
            PG8_STAGE(PG8_SB(0, 1), b2 + hstep, voffB);
            PG8_WAIT_V(6); PG8_BAR; PG8_MMA(1, 1, At, B1); PG8_BAR;
            PG8_LDB(B0, 1, 0); PG8_SCHED; PG8_LDA(At, 1, 0); PG8_STAGE(PG8_SA(0, 1), a2 + hstep, voffA);
            PG8_WAIT_L(8); PG8_BAR; PG8_WAIT_L(0); PG8_MMA(0, 0, At, B0); PG8_BAR; PG8_SCHED;
            PG8_LDB(B1, 1, 1); PG8_STAGE(PG8_SB(1, 0), b3, voffB);
            PG8_BAR; PG8_WAIT_L(0); PG8_MMA(0, 1, At, B1); PG8_BAR;
            PG8_LDA(At, 1, 1); PG8_STAGE(PG8_SA(1, 0), a3, voffA);
            PG8_BAR; PG8_WAIT_L(0); PG8_MMA(1, 0, At, B0); PG8_BAR; PG8_SCHED;
            PG8_STAGE(PG8_SB(1, 1), b3 + hstep, voffB);
            PG8_WAIT_V(6); PG8_BAR; PG8_MMA(1, 1, At, B1); PG8_BAR;
            }
        }
        if constexpr (ALIGN_EPI) { if (wr == 0) PG8_BAR; }
        if constexpr (!Epi::AFTER_DRAIN) { E(acc, cur, wr, wc, fr, fq); S.done(cur); }
        if (!has_next) break;
#pragma unroll
        for (int a = 0; a < 2; ++a)
#pragma unroll
            for (int b = 0; b < 2; ++b)
#pragma unroll
                for (int m = 0; m < 4; ++m)
#pragma unroll
                    for (int n = 0; n < 2; ++n) acc[a][b][m][n] = (f32x4){0.f, 0.f, 0.f, 0.f};
        cur = nxt; cA = nA; cB = nB; ++ui;
        if constexpr (ALIGN_EPI) { if (wr == 1) PG8_BAR; }
    }
    PG8_WAIT_V(0);
    if constexpr (!ALIGN_EPI) { if (wr == 0) PG8_BAR; }
    PG8_BAR;
    if constexpr (Epi::AFTER_DRAIN) { E.fused(acc, cur, wr, wc, fr, fq, lds, wid, lane); S.done(cur); }
#undef PG8_SA
#undef PG8_SB
#undef PG8_STAGE
#undef PG8_LDA
#undef PG8_LDB
#undef PG8_MMA
#undef PG8_WAIT_V
#undef PG8_WAIT_L
#undef PG8_BAR
#undef PG8_SCHED
}
}
namespace pg8 {
struct EpiProj {
    static constexpr bool PERM = true, AFTER_DRAIN = false;
    bf16_t *QC, *KV, *QKVG, *Z;
    __device__ __forceinline__ void operator()(const f32x4 (&acc)[2][2][4][2], const Unit& u, int wr, int wc, int fr, int fq) const {
        const int pn = u.pn; bf16_t* base; int ldc, colt;
        if (pn < 2) { base = QC; ldc = 1024; colt = pn * 256; }
        else if (pn == 2) { base = KV; ldc = 256; colt = 0; }
        else if (pn < 9) { base = QKVG; ldc = 1536; colt = (pn - 3) * 256; }
        else { base = Z; ldc = 512; colt = (pn - 9) * 256; }
        const int row0 = u.pm * BM + wr * 64 + fr, col0 = colt + wc * 32 + 8 * fq;
#pragma unroll
        for (int ai = 0; ai < 2; ++ai)
#pragma unroll
            for (int m = 0; m < 4; ++m) { bf16_t* rowp = base + (size_t)(row0 + ai * HALF + m * 16) * ldc + col0;
#pragma unroll
                for (int bj = 0; bj < 2; ++bj) { const f32x4 v0 = acc[ai][bj][m][0], v1 = acc[ai][bj][m][1];
                    u32x4 w; w.x = cvt_pk_bf16(v0[0], v0[1]); w.y = cvt_pk_bf16(v0[2], v0[3]); w.z = cvt_pk_bf16(v1[0], v1[1]); w.w = cvt_pk_bf16(v1[2], v1[3]);
                    *(u32x4*)(rowp + bj * HALF) = w; } }
    }
};
struct EpiRes {
    static constexpr bool PERM = false, AFTER_DRAIN = false;
    const float* base; float* H; bf16_t* HB; float* SSQ;
    __device__ __forceinline__ void operator()(const f32x4 (&acc)[2][2][4][2], const Unit& u, int wr, int wc, int fr, int fq) const {
        typedef unsigned u32x2v __attribute__((ext_vector_type(2)));
        const int col0 = u.pn * BM + wc * 32 + 4 * fq;
#pragma unroll
        for (int ai = 0; ai < 2; ++ai)
#pragma unroll
            for (int m = 0; m < 4; ++m) { const int row = u.pm * BM + ai * HALF + wr * 64 + m * 16 + fr; const size_t off = (size_t)row * 1024 + col0; float ss = 0.f;
#pragma unroll
                for (int bj = 0; bj < 2; ++bj)
#pragma unroll
                    for (int n = 0; n < 2; ++n) { const f32x4 bs = *(const f32x4*)(base + off + bj * HALF + n * 16); const f32x4 hv = bs + acc[ai][bj][m][n];
                        *(f32x4*)(H + off + bj * HALF + n * 16) = hv; ss += (hv[0] * hv[0] + hv[1] * hv[1]) + (hv[2] * hv[2] + hv[3] * hv[3]);
                        if (HB) { u32x2v w; w.x = cvt_pk_bf16(hv[0], hv[1]); w.y = cvt_pk_bf16(hv[2], hv[3]); *(u32x2v*)(HB + off + bj * HALF + n * 16) = w; } }
                ss += __shfl_xor(ss, 16); ss += __shfl_xor(ss, 32);
                if (fq == 0) SSQ[(size_t)row * 16 + u.pn * 4 + wc] = ss; }
    }
};
struct EpiFfn1 {
    static constexpr bool PERM = true, AFTER_DRAIN = false;
    bf16_t* ACT; const float* SSQ;
    __device__ __forceinline__ void operator()(const f32x4 (&acc)[2][2][4][2], const Unit& u, int wr, int wc, int fr, int fq) const {
        const int row0 = u.pm * BM + wr * 64 + fr, col0 = u.pn * BM + wc * 32 + 8 * fq;
#pragma unroll
        for (int ai = 0; ai < 2; ++ai)
#pragma unroll
            for (int m = 0; m < 4; ++m) { const int row = row0 + ai * HALF + m * 16; const f32x4* sp = (const f32x4*)(SSQ + (size_t)row * 16);
                const f32x4 s0 = sp[0], s1 = sp[1], s2 = sp[2], s3 = sp[3]; const f32x4 st = (s0 + s1) + (s2 + s3);
                const float r = rsqrtf(((st[0] + st[1]) + (st[2] + st[3])) * (1.f / 1024.f) + 1e-6f);
                bf16_t* rowp = ACT + (size_t)row * 4096 + col0;
#pragma unroll
                for (int bj = 0; bj < 2; ++bj) { f32x4 v0 = acc[ai][bj][m][0] * r, v1 = acc[ai][bj][m][1] * r;
#pragma unroll
                    for (int e = 0; e < 4; ++e) { const float a = fmaxf(v0[e], 0.f), b = fmaxf(v1[e], 0.f); v0[e] = a * a; v1[e] = b * b; }
                    u32x4 w; w.x = cvt_pk_bf16(v0[0], v0[1]); w.y = cvt_pk_bf16(v0[2], v0[3]); w.z = cvt_pk_bf16(v1[0], v1[1]); w.w = cvt_pk_bf16(v1[2], v1[3]);
                    *(u32x4*)(rowp + bj * HALF) = w; } }
    }
};
}

constexpr int GEMM_LDS = 131072;
template <class Epi, bool ALIGN>
__global__ void __launch_bounds__(512, 2) k_gemm(pg8::Gemm g, Epi e) {
    extern __shared__ __attribute__((aligned(16))) unsigned char lds_g[];
    pg8::StaticOrder S; S.init(g.M, g.N, (int)gridDim.x, (int)blockIdx.x);
    pg8::gemm_phase<Epi, pg8::StaticOrder, ALIGN, true>((PG8_LAS unsigned char*)lds_g, g, S, e);
}
#define GAS __attribute__((address_space(1)))
typedef float f32x4 __attribute__((ext_vector_type(4)));

__global__ void k_wt(const float* __restrict__ W, int K, int ldw, int col0, int N, const float* __restrict__ kscale, bf16_t* __restrict__ WT) {
    __shared__ float tile[32][33];
    const int n0 = blockIdx.x * 32, k0 = blockIdx.y * 32, tx = threadIdx.x & 31, ty = threadIdx.x >> 5;
    for (int i = ty; i < 32; i += 8) { const int k = k0 + i; float v = W[(size_t)k * ldw + col0 + n0 + tx]; if (kscale) v *= kscale[k]; tile[i][tx] = v; }
    __syncthreads();
    for (int i = ty; i < 32; i += 8) WT[(size_t)(n0 + i) * K + k0 + tx] = (bf16_t)f2bf(tile[tx][i]);
}

__global__ void k_p0_rows(const float* __restrict__ x, const float* __restrict__ nw, const float* __restrict__ w_in, bf16_t* __restrict__ XN, float* __restrict__ GATES) {
    __shared__ float xs[DM]; __shared__ float red[256];
    const int m = blockIdx.x, t = threadIdx.x;
    float v[4], ss = 0.f;
    for (int i = 0; i < 4; ++i) { v[i] = x[(size_t)m * DM + t + 256 * i]; ss += v[i] * v[i]; }
    red[t] = ss; __syncthreads();
    for (int s = 128; s > 0; s >>= 1) { if (t < s) red[t] += red[t + s]; __syncthreads(); }
    const float r = rsqrtf(red[0] * (1.f / DM) + EPS);
    for (int i = 0; i < 4; ++i) { const int k = t + 256 * i; const float xn = v[i] * r * nw[k]; xs[k] = xn; XN[(size_t)m * DM + k] = (bf16_t)f2bf(xn); }
    __syncthreads();
    const int j = t >> 4, l = t & 15; float acc = 0.f;
    for (int k = l; k < DM; k += 16) acc += xs[k] * w_in[(size_t)k * DIN + NPROJ + j];
    for (int o = 8; o > 0; o >>= 1) acc += __shfl_xor(acc, o);
    if (l == 0) GATES[(size_t)m * 16 + j] = acc;
}

__global__ void k_p2a(const bf16_t* __restrict__ QKVG, const float* __restrict__ conv_w, bf16_t* __restrict__ QHAT, bf16_t* __restrict__ KHAT, bf16_t* __restrict__ KHT, bf16_t* __restrict__ VHT) {
    __shared__ float red[128];
    const int m = blockIdx.x, h = blockIdx.y, d = threadIdx.x, b = m / SEQ, t = m % SEQ, n = t / CHUNK, c = t % CHUNK;
    const size_t u = (size_t)((b * GH + h) * NCH + n);
    float s[3];
    for (int which = 0; which < 3; ++which) {
        const int ch = which * 512 + h * GD + d; float y = 0.f;
        for (int j = 0; j < CONVK; ++j) { const int tt = t - 2 + j; if (tt >= 0 && tt < SEQ) y += bf2f(QKVG[(size_t)(b * SEQ + tt) * 1536 + ch]) * conv_w[j * 1536 + ch]; }
        s[which] = y / (1.f + __expf(-y));
    }
    for (int which = 0; which < 2; ++which) {
        red[d] = s[which] * s[which]; __syncthreads();
        for (int st = 64; st > 0; st >>= 1) { if (d < st) red[d] += red[d + st]; __syncthreads(); }
        const float r = rsqrtf(red[0] + EPS); __syncthreads();
        s[which] *= r;
    }
    s[0] *= 0.08838834764831845f;
    QHAT[u * BLOB + offA(c, d)] = (bf16_t)f2bf(s[0]);
    KHAT[u * BLOB + offA(c, d)] = (bf16_t)f2bf(s[1]);
    KHT[u * BLOB + offT(d, c)] = (bf16_t)f2bf(s[1]);
    VHT[u * BLOB + offT(d, c)] = (bf16_t)f2bf(s[2]);
}

__global__ void k_p2b_ref(const bf16_t* __restrict__ QHAT, const bf16_t* __restrict__ KHAT, const bf16_t* __restrict__ VHT, const float* __restrict__ GATES,
                          const float* __restrict__ a_log, const float* __restrict__ dt_bias, bf16_t* __restrict__ Wb, bf16_t* __restrict__ Ub, bf16_t* __restrict__ QKb, float* __restrict__ TAB) {
    extern __shared__ float sm[];
    float* kf = sm;
    float* xf = kf + 64 * 129;
    float* A = xf + 64 * 129;
    float* T = A + 64 * 65;
    float* gc = T + 64 * 65;
    float* bet = gc + 64;
    float* gg = bet + 64;
    const int ud = blockIdx.x, u = ud >> 1, dir = ud & 1, p = threadIdx.x, c = dir ? 63 - p : p;
    const int n = u % NCH, bh = u / NCH, h = bh % GH, b = bh / GH;
    const int m = b * SEQ + n * CHUNK + c;
    {
        const float a = GATES[(size_t)m * 16 + dir * 4 + h], bb = GATES[(size_t)m * 16 + 8 + dir * 4 + h];
        const float z = a + dt_bias[dir * 4 + h];
        const float sp = (z > 20.f) ? z : log1pf(__expf(z));
        gg[p] = -__expf(a_log[dir * 4 + h]) * sp; bet[p] = 1.f / (1.f + __expf(-bb));
    }
    for (int d = 0; d < GD; ++d) kf[p * 129 + d] = bf2f(KHAT[(size_t)u * BLOB + offA(c, d)]);
    __syncthreads();
    { float s = 0.f; for (int j = 0; j <= p; ++j) s += gg[j]; gc[p] = s; }
    __syncthreads();
    for (int j = 0; j < 64; ++j) {
        float v = 0.f;
        if (j < p) { float dd = 0.f; for (int d = 0; d < GD; ++d) dd += kf[p * 129 + d] * kf[j * 129 + d]; v = bet[p] * dd * __expf(gc[p] - gc[j]); }
        A[p * 65 + j] = v;
    }
    __syncthreads();
    for (int j = 63; j >= 0; --j) {
        float acc = (j == p) ? 1.f : 0.f;
        if (j <= p) { for (int k = j + 1; k <= p; ++k) acc -= T[p * 65 + k] * A[k * 65 + j]; } else acc = 0.f;
        T[p * 65 + j] = acc;
    }
    for (int d = 0; d < GD; ++d) {
        float acc = 0.f;
        for (int j = 0; j <= p; ++j) acc += T[p * 65 + j] * bet[j] * __expf(gc[j]) * kf[j * 129 + d];
        Wb[(size_t)ud * BLOB + offA(c, d)] = (bf16_t)f2bf(-acc);
    }
    for (int d = 0; d < GD; ++d) xf[p * 129 + d] = bf2f(VHT[(size_t)u * BLOB + offT(d, c)]);
    __syncthreads();
    for (int d = 0; d < GD; ++d) {
        float acc = 0.f;
        for (int j = 0; j <= p; ++j) acc += T[p * 65 + j] * bet[j] * xf[j * 129 + d];
        Ub[(size_t)ud * BLOB + offU(c, d)] = (bf16_t)f2bf(acc);
    }
    __syncthreads();
    for (int d = 0; d < GD; ++d) xf[p * 129 + d] = bf2f(QHAT[(size_t)u * BLOB + offA(c, d)]);
    __syncthreads();
    for (int j = 0; j < 64; ++j) {
        float v = 0.f;
        if (j <= p) { float dd = 0.f; for (int d = 0; d < GD; ++d) dd += xf[p * 129 + d] * kf[j * 129 + d]; v = dd * __expf(gc[p] - gc[j]); }
        const int cj = dir ? 63 - j : j;
        QKb[(size_t)ud * QKBLOB + offT(c, cj)] = (bf16_t)f2bf(v);
    }
    TAB[(size_t)ud * TABW + c] = __expf(gc[p]);
    TAB[(size_t)ud * TABW + 64 + c] = __expf(gc[63] - gc[p]);
    if (p == 63) TAB[(size_t)ud * TABW + 128] = __expf(gc[63]);
}

__global__ void k_scan_ref(const bf16_t* __restrict__ QHAT, const bf16_t* __restrict__ KHT, const bf16_t* __restrict__ Wb, const bf16_t* __restrict__ Ub, const bf16_t* __restrict__ QKb,
                           const float* __restrict__ TAB, bf16_t* __restrict__ ODIR) {
    extern __shared__ float sm[];
    float* S = sm;
    float* vn = S + 128 * 128;
    float* Wl = vn + 64 * 128;
    float* Ql = Wl + 64 * 128;
    const int chain = blockIdx.x, dir = chain & 1, bh = chain >> 1, h = bh % GH, b = bh / GH, dv = threadIdx.x;
    for (int d = 0; d < 128; ++d) S[d * 128 + dv] = 0.f;
    for (int step = 0; step < NCH; ++step) {
        const int n = dir ? NCH - 1 - step : step; const size_t u = (size_t)bh * NCH + n, ud = u * 2 + dir;
        const float* tab = TAB + ud * TABW;
        __syncthreads();
        for (int i = dv; i < 64 * 128; i += 128) { const int c = i >> 7, d = i & 127; Wl[i] = bf2f(Wb[ud * BLOB + offA(c, d)]); }
        __syncthreads();
        for (int c = 0; c < 64; ++c) { float acc = bf2f(Ub[ud * BLOB + offU(c, dv)]); for (int d = 0; d < 128; ++d) acc += Wl[c * 128 + d] * S[d * 128 + dv]; vn[c * 128 + dv] = acc; }
        __syncthreads();
        for (int i = dv; i < 64 * 128; i += 128) { const int c = i >> 7, d = i & 127; Wl[i] = bf2f(QHAT[u * BLOB + offA(c, d)]); }
        for (int i = dv; i < 64 * 64; i += 128) { const int c = i >> 6, c2 = i & 63; Ql[i] = bf2f(QKb[ud * QKBLOB + offT(c, c2)]); }
        __syncthreads();
        for (int c = 0; c < 64; ++c) {
            float acc = 0.f; for (int d = 0; d < 128; ++d) acc += Wl[c * 128 + d] * S[d * 128 + dv];
            acc *= tab[c];
            for (int c2 = 0; c2 < 64; ++c2) acc += Ql[c * 64 + c2] * vn[c2 * 128 + dv];
            ODIR[((size_t)dir * M + (size_t)b * SEQ + n * CHUNK + c) * 512 + h * GD + dv] = (bf16_t)f2bf(acc);
        }
        __syncthreads();
        for (int i = dv; i < 64 * 128; i += 128) { const int c = i >> 7, d = i & 127; Wl[i] = bf2f(KHT[u * BLOB + offT(d, c)]); }
        __syncthreads();
        const float egl = tab[128];
        for (int d = 0; d < 128; ++d) { float acc = S[d * 128 + dv] * egl; for (int c = 0; c < 64; ++c) acc += Wl[c * 128 + d] * tab[64 + c] * vn[c * 128 + dv]; S[d * 128 + dv] = acc; }
    }
}

__host__ __device__ __forceinline__ int t5_bucket(int rel) {
    const int base = rel > 0 ? 16 : 0; const int n = rel < 0 ? -rel : rel;
    if (n < 8) return base + n;
    int k = (n >= 12) + (n >= 16) + (n >= 23) + (n >= 32) + (n >= 46) + (n >= 64) + (n >= 91) + (n >= 128);
    int large = 8 + k; if (large > 15) large = 15;
    return base + large;
}

__global__ void __launch_bounds__(64) k_attn_ref(bf16_t* QC, const bf16_t* __restrict__ KV, const float* __restrict__ rel_bias, const float* __restrict__ sink) {
    __shared__ float btab[257];
    const int h = blockIdx.y, m = blockIdx.x * 64 + threadIdx.x, b = m / SEQ, t = m % SEQ, kvh = h >> 2;
    for (int i = threadIdx.x; i < 257; i += 64) btab[i] = rel_bias[t5_bucket(i - 128) * AH + h];
    __syncthreads();
    float q[64], acc[64];
#pragma unroll
    for (int d = 0; d < 64; ++d) { q[d] = bf2f(QC[(size_t)m * 1024 + h * 64 + d]); acc[d] = 0.f; }
    float mx = -1e30f, l = 0.f;
    const int lo = t - WIN < 0 ? 0 : t - WIN, hi = t + WIN > SEQ - 1 ? SEQ - 1 : t + WIN;
    for (int kp = lo; kp <= hi; ++kp) {
        const bf16_t* kr = KV + (size_t)(b * SEQ + kp) * 256 + kvh * 64; const bf16_t* vr = kr + 128;
        float s = 0.f;
#pragma unroll
        for (int d = 0; d < 64; ++d) s += q[d] * bf2f(kr[d]);
        s = s * 0.125f + btab[kp - t + 128];
        const float mn = fmaxf(mx, s), f = __expf(mx - mn), pe = __expf(s - mn);
        l = l * f + pe; mx = mn;
#pragma unroll
        for (int d = 0; d < 64; ++d) acc[d] = acc[d] * f + pe * bf2f(vr[d]);
    }
    { const float s = sink[h]; const float mn = fmaxf(mx, s), f = __expf(mx - mn); l = l * f + __expf(s - mn);
#pragma unroll
      for (int d = 0; d < 64; ++d) acc[d] *= f; }
    const float il = 1.f / l;
#pragma unroll
    for (int d = 0; d < 64; ++d) QC[(size_t)m * 1024 + h * 64 + d] = (bf16_t)f2bf(acc[d] * il);
}

__global__ void k_p4(const bf16_t* __restrict__ ODIR, const bf16_t* __restrict__ Z, const float* __restrict__ gnw, bf16_t* __restrict__ QC) {
    __shared__ float red[128];
    const int m = blockIdx.x, h = blockIdx.y, d = threadIdx.x;
    const float o = bf2f(ODIR[(size_t)m * 512 + h * GD + d]) + bf2f(ODIR[((size_t)M + m) * 512 + h * GD + d]);
    red[d] = o * o; __syncthreads();
    for (int st = 64; st > 0; st >>= 1) { if (d < st) red[d] += red[d + st]; __syncthreads(); }
    const float r = rsqrtf(red[0] * (1.f / GD) + EPS);
    const float z = bf2f(Z[(size_t)m * 512 + h * GD + d]);
    QC[(size_t)m * 1024 + 512 + h * GD + d] = (bf16_t)f2bf(o * r * gnw[d] * (z / (1.f + __expf(-z))));
}

__global__ void k_final(float* __restrict__ out, const float* __restrict__ SSQ2, const float* __restrict__ nfw) {
    const int m = blockIdx.x, t = threadIdx.x;
    float ss = 0.f; for (int i = 0; i < 16; ++i) ss += SSQ2[(size_t)m * 16 + i];
    const float r = rsqrtf(ss * (1.f / DM) + EPS);
    for (int i = 0; i < 4; ++i) { const int k = t + 256 * i; out[(size_t)m * DM + k] = out[(size_t)m * DM + k] * r * nfw[k]; }
}
constexpr int NWAVES = 8;
constexpr int RING_BYTES = 131072;
constexpr int LDSCTL_OFF = RING_BYTES, MISC_OFF = LDSCTL_OFF + 320;
constexpr int LDS_BYTES = 147456;
constexpr int CW_TMO = 0, CW_CODE = 1, CW_BAR = 4096;
#define LAS __attribute__((address_space(3)))
typedef unsigned v4u __attribute__((ext_vector_type(4)));
typedef unsigned v2u __attribute__((ext_vector_type(2)));
typedef short bf16x8 __attribute__((ext_vector_type(8)));
typedef GAS unsigned gu32;
#define RLX_AGENT __ATOMIC_RELAXED, __HIP_MEMORY_SCOPE_AGENT
#define LDS_WAIT() asm volatile("s_waitcnt lgkmcnt(0)" ::: "memory")
#define VM_WAIT() asm volatile("s_waitcnt vmcnt(0)" ::: "memory")
typedef float f32x2_t __attribute__((ext_vector_type(2))); typedef __bf16 bf16x2_t __attribute__((ext_vector_type(2)));
__device__ __forceinline__ unsigned pk2f(float lo, float hi) { f32x2_t v = {lo, hi}; bf16x2_t b = __builtin_convertvector(v, bf16x2_t); return __builtin_bit_cast(unsigned, b); }
#define XB_TMO      128
#define XB_XCNT(j)  (256  + 64 * (j))
#define XB_XSUB(j)  (1280 + 64 * (j))
#define XB_XGEN(j)  (2304 + 64 * (j))
#define XB_TOP      3328
#define XB_TOPGEN   3392
#define XCD_BAR_WORDS 3456
#define XB_SPIN_CAP (1u << 18)

__device__ __forceinline__ unsigned xb_ld(unsigned* p)              { return __hip_atomic_load(p, __ATOMIC_RELAXED, __HIP_MEMORY_SCOPE_AGENT); }
__device__ __forceinline__ unsigned xb_add(unsigned* p, unsigned v) { return __hip_atomic_fetch_add(p, v, __ATOMIC_RELAXED, __HIP_MEMORY_SCOPE_AGENT); }
__device__ __forceinline__ unsigned xb_xcc_id() { return (unsigned)__builtin_amdgcn_s_getreg((3 << 11) | 20) & 0xFu; }
#define XB_SPIN(cond, bar) do { unsigned _sp = 0; while (cond) { __builtin_amdgcn_s_sleep(1); \
    if ((++_sp & 255u) == 0u) { if (xb_ld(&(bar)[XB_TMO])) break; if (_sp > XB_SPIN_CAP) { atomicAdd(&(bar)[XB_TMO], 1u); break; } } } } while (0)

struct XcdBarrier {
    unsigned* bar; unsigned x;
    volatile LAS unsigned* st;
};

__device__ __forceinline__ XcdBarrier xcd_barrier_post(unsigned* bar, volatile LAS unsigned* st) {
    XcdBarrier b; b.bar = bar; b.x = xb_xcc_id(); b.st = st;
    if (threadIdx.x == 0) (void)xb_add(&bar[XB_XCNT(b.x)], 1u);
    return b;
}
__device__ __forceinline__ void xcd_barrier_complete(unsigned* bar, unsigned x, unsigned& nloc, unsigned& nx) {
    const unsigned G = gridDim.x * gridDim.y * gridDim.z;
    unsigned sum, cnt, mine, sp = 0u;
    for (;;) {
        sum = 0u; cnt = 0u; mine = 0u;
#pragma unroll
        for (unsigned j = 0; j < 16; ++j) { const unsigned c = xb_ld(&bar[XB_XCNT(j)]); sum += c; cnt += (c > 0u) ? 1u : 0u; mine = (j == x) ? c : mine; }
        if (sum == G) break;
        __builtin_amdgcn_s_sleep(1);
        if ((++sp & 255u) == 0u) { if (xb_ld(&bar[XB_TMO])) break; if (sp > XB_SPIN_CAP) { atomicAdd(&bar[XB_TMO], 1u); break; } }
    }
    nloc = mine > 0u ? mine : 1u; nx = cnt > 0u ? cnt : 1u;
}

__device__ __forceinline__ void xcd_barrier(const XcdBarrier& b) {
    asm volatile("s_waitcnt vmcnt(0)" ::: "memory");
    __syncthreads();
    if (threadIdx.x == 0) {
        unsigned* bar = b.bar;
        __builtin_amdgcn_s_waitcnt(0);
        unsigned nloc = b.st[0], nx = b.st[1];
        if (nloc == 0u) { xcd_barrier_complete(bar, b.x, nloc, nx); b.st[0] = nloc; b.st[1] = nx; }
        const unsigned old = xb_add(&bar[XB_XSUB(b.x)], 1u);
        const unsigned gen = old / nloc;
        if (old + 1u == (gen + 1u) * nloc) {
            __builtin_amdgcn_fence(__ATOMIC_RELEASE, "agent");
            asm volatile("s_waitcnt vmcnt(0)" ::: "memory");
            const unsigned og = xb_add(&bar[XB_TOP], 1u);
            const unsigned tg = og / nx;
            if (og + 1u == (tg + 1u) * nx) xb_add(&bar[XB_TOPGEN], 1u);
            else XB_SPIN(xb_ld(&bar[XB_TOPGEN]) == tg, bar);
            __builtin_amdgcn_fence(__ATOMIC_ACQUIRE, "agent");
            xb_add(&bar[XB_XGEN(b.x)], 1u);
            asm volatile("s_waitcnt vmcnt(0)" ::: "memory");
        } else {
            XB_SPIN(xb_ld(&bar[XB_XGEN(b.x)]) == gen, bar);
            __builtin_amdgcn_fence(__ATOMIC_ACQUIRE, "agent");
            asm volatile("s_waitcnt vmcnt(0)" ::: "memory");
        }
    }
    __syncthreads();
}
struct Frame {
    LAS unsigned char* lds; volatile LAS unsigned* MISC; gu32* ctl;
    int tid, lane, wave, vcu, G;
};
__device__ __forceinline__ float wave_sum(float v) {
#pragma unroll
    for (int o = 1; o < 64; o <<= 1) v += __shfl_xor(v, o);
    return v;
}
__device__ __forceinline__ void p0_transpose_item(const float* W, int K, int ldw, int N, const float* ksc, bf16_t* WT, LAS float* scr, int item, int lane) {
    const int nblk = N / 32, kb = item / nblk, nb = item % nblk, k0 = 64 * kb, n0 = 32 * nb;
#pragma unroll 8
    for (int i = 0; i < 32; ++i) { const int kk = 2 * i + (lane >> 5); float v = W[(size_t)(k0 + kk) * ldw + n0 + (lane & 31)]; if (ksc) v *= ksc[k0 + kk]; scr[kk * 33 + (lane & 31)] = v; }
    LDS_WAIT(); asm volatile("" ::: "memory");
    const int c = lane & 7;
#pragma unroll
    for (int j = 0; j < 4; ++j) { const int n = (lane >> 3) + 8 * j; const LAS float* s = scr + (8 * c) * 33 + n;
        v4u o; o.x = pk2f(s[0 * 33], s[1 * 33]); o.y = pk2f(s[2 * 33], s[3 * 33]); o.z = pk2f(s[4 * 33], s[5 * 33]); o.w = pk2f(s[6 * 33], s[7 * 33]);
        *(GAS v4u*)(WT + (size_t)(n0 + n) * K + k0 + 8 * c) = o; }
    LDS_WAIT(); asm volatile("" ::: "memory");
}
struct P0Args { const float *x, *nmw, *w_in, *w_out, *nfw, *w1, *w2; bf16_t *WIN_T, *WOUT_T, *W1_T, *W2_T, *XN; float* GATES; };
__device__ __forceinline__ void phase_p0(Frame& F, const P0Args& a) {
    LAS float* scr = (LAS float*)(F.lds + F.wave * 16384);
    const int gw = F.vcu * NWAVES + F.wave, NGW = F.G * NWAVES, lane = F.lane;
    constexpr int I_IN = (DM / 64) * (NPROJ / 32), I_O = (DM / 64) * (DM / 32), I_1 = (DM / 64) * (DFF / 32), I_2 = (DFF / 64) * (DM / 32);
    constexpr int NITEMS = I_IN + I_O + I_1 + I_2;
    for (int it = gw; it < NITEMS; it += NGW) {
        int r = it;
        if (r < I_IN) { p0_transpose_item(a.w_in, DM, DIN, NPROJ, nullptr, a.WIN_T, scr, r, lane); continue; } r -= I_IN;
        if (r < I_O) { p0_transpose_item(a.w_out, DM, DM, DM, nullptr, a.WOUT_T, scr, r, lane); continue; } r -= I_O;
        if (r < I_1) { p0_transpose_item(a.w1, DM, DFF, DFF, a.nfw, a.W1_T, scr, r, lane); continue; } r -= I_1;
        p0_transpose_item(a.w2, DFF, DM, DM, nullptr, a.W2_T, scr, r, lane);
    }
    __syncthreads();
    LAS float* GW = (LAS float*)F.lds;
    for (int k = F.tid; k < DM; k += NWAVES * 64) {
        const f32x4* src = (const f32x4*)(a.w_in + (size_t)k * DIN + NPROJ); const int kg = k >> 2, e = k & 3;
#pragma unroll
        for (int q = 0; q < 4; ++q) { const f32x4 w = src[q];
#pragma unroll
            for (int t = 0; t < 4; ++t) { const int i = q * 4 + t; GW[kg * 64 + ((i ^ (kg & 15)) << 2) + e] = w[t]; } }
    }
    __syncthreads();
    f32x4 nwv[4];
#pragma unroll
    for (int j = 0; j < 4; ++j) nwv[j] = *(const f32x4*)(a.nmw + 256 * j + 4 * lane);
    for (int m = gw; m < M; m += NGW) {
        const GAS f32x4* xr = (const GAS f32x4*)(a.x + (size_t)m * DM) + lane;
        f32x4 v[4]; float s = 0.f;
#pragma unroll
        for (int j = 0; j < 4; ++j) { v[j] = xr[64 * j]; s += (v[j].x * v[j].x + v[j].y * v[j].y) + (v[j].z * v[j].z + v[j].w * v[j].w); }
        const float r = rsqrtf(wave_sum(s) * (1.f / DM) + EPS);
        GAS unsigned long long* o8 = (GAS unsigned long long*)(a.XN + (size_t)m * DM) + lane;
        float acc[16];
#pragma unroll
        for (int i = 0; i < 16; ++i) acc[i] = 0.f;
#pragma unroll
        for (int j = 0; j < 4; ++j) {
            v[j] = v[j] * r * nwv[j];
            o8[64 * j] = (unsigned long long)pk2f(v[j].x, v[j].y) | ((unsigned long long)pk2f(v[j].z, v[j].w) << 32);
            const LAS float* base = GW + (64 * j + lane) * 64;
#pragma unroll
            for (int i = 0; i < 16; ++i) { const f32x4 w = *(const LAS f32x4*)(base + ((i ^ (lane & 15)) << 2)); acc[i] += (v[j].x * w.x + v[j].y * w.y) + (v[j].z * w.z + v[j].w * w.w);
                if ((i & 7) == 7) asm volatile("" ::: "memory"); }
        }
        float a8[8], a4[4], a2[2], a1;
        { const bool hb = (lane >> 5) & 1;
#pragma unroll
          for (int i = 0; i < 8; ++i) { const float send = hb ? acc[i] : acc[i + 8]; const float recv = __shfl_xor(send, 32); a8[i] = (hb ? acc[i + 8] : acc[i]) + recv; } }
        { const bool hb = (lane >> 4) & 1;
#pragma unroll
          for (int i = 0; i < 4; ++i) { const float send = hb ? a8[i] : a8[i + 4]; const float recv = __shfl_xor(send, 16); a4[i] = (hb ? a8[i + 4] : a8[i]) + recv; } }
        { const bool hb = (lane >> 3) & 1;
#pragma unroll
          for (int i = 0; i < 2; ++i) { const float send = hb ? a4[i] : a4[i + 2]; const float recv = __shfl_xor(send, 8); a2[i] = (hb ? a4[i + 2] : a4[i]) + recv; } }
        { const bool hb = (lane >> 2) & 1; const float send = hb ? a2[0] : a2[1]; const float recv = __shfl_xor(send, 4); a1 = (hb ? a2[1] : a2[0]) + recv; }
        a1 += __shfl_xor(a1, 2); a1 += __shfl_xor(a1, 1);
        if ((lane & 3) == 0) a.GATES[(size_t)m * 16 + (lane >> 2)] = a1;
    }
}
__device__ __forceinline__ void phase_p4(Frame& F, const bf16_t* ODIR, const bf16_t* Z, const float* gnw, bf16_t* QC) {
    const int gw = F.vcu * NWAVES + F.wave, NGW = F.G * NWAVES, lane = F.lane;
    const float g0 = gnw[2 * lane], g1 = gnw[2 * lane + 1];
    for (int idx = gw; idx < M * GH; idx += NGW) {
        const int m = idx >> 2, h = idx & 3;
        const unsigned of = *(const GAS unsigned*)(ODIR + (size_t)m * 512 + h * GD + 2 * lane), ob = *(const GAS unsigned*)(ODIR + ((size_t)M + m) * 512 + h * GD + 2 * lane);
        const unsigned zz = *(const GAS unsigned*)(Z + (size_t)m * 512 + h * GD + 2 * lane);
        const float o0 = bf2f(of) + bf2f(ob), o1 = bf2f(of >> 16) + bf2f(ob >> 16);
        const float r = rsqrtf(wave_sum(o0 * o0 + o1 * o1) * (1.f / GD) + EPS);
        const float z0 = bf2f(zz), z1 = bf2f(zz >> 16);
        *(GAS unsigned*)(QC + (size_t)m * 1024 + 512 + h * GD + 2 * lane) = pk2f(o0 * r * g0 * (z0 / (1.f + __expf(-z0))), o1 * r * g1 * (z1 / (1.f + __expf(-z1))));
    }
}
__device__ __forceinline__ void phase_p8(Frame& F, float* out, const float* SSQ2, const float* nfw) {
    const int gw = F.vcu * NWAVES + F.wave, NGW = F.G * NWAVES, lane = F.lane;
    f32x4 wv[4];
#pragma unroll
    for (int j = 0; j < 4; ++j) wv[j] = *(const f32x4*)(nfw + 256 * j + 4 * lane);
    for (int m = gw; m < M; m += NGW) {
        const GAS f32x4* sp = (const GAS f32x4*)(SSQ2 + (size_t)m * 16);
        const f32x4 st = (sp[0] + sp[1]) + (sp[2] + sp[3]);
        const float r = rsqrtf(((st[0] + st[1]) + (st[2] + st[3])) * (1.f / DM) + EPS);
        GAS f32x4* xr = (GAS f32x4*)(out + (size_t)m * DM) + lane;
#pragma unroll
        for (int j = 0; j < 4; ++j) xr[64 * j] = xr[64 * j] * r * wv[j];
    }
}
constexpr size_t WS_VTP = 232 * MiB;
__host__ __device__ __forceinline__ int perm16(int a) { return (a & ~12) | ((a & 4) << 1) | ((a & 8) >> 1); }
__device__ __forceinline__ float silu_f(float y) { return y / (1.f + __expf(-y)); }
__device__ __forceinline__ void phase_p2a(Frame& F, const bf16_t* QKVG, const bf16_t* KV, const float* conv_w, bf16_t* QHAT, bf16_t* KHAT, bf16_t* KHT, bf16_t* VHT, bf16_t* VTP) {
    const int lane = F.lane, w = F.wave;
    const int upw = (NUNIT + F.G - 1) / F.G;
    const int cbase = 32 * (w >> 2) + 8 * ((w >> 1) & 1) + 4 * (w & 1);
    const int P0 = (cbase & 32) | ((cbase & 12) << 1);
    for (int ui = 0; ui < upw; ++ui) {
        const int u = F.vcu * upw + ui; if (u >= NUNIT) break;
        const int n = u % NCH, bh = u / NCH, h = bh % GH, b = bh / GH;
        float cw[CONVK][3][2];
#pragma unroll
        for (int j = 0; j < CONVK; ++j)
#pragma unroll
            for (int wh = 0; wh < 3; ++wh) { const float* p = conv_w + j * 1536 + wh * 512 + h * GD + 2 * lane; cw[j][wh][0] = p[0]; cw[j][wh][1] = p[1]; }
        unsigned kt[2][4], vt[2][4];
#pragma unroll
        for (int run = 0; run < 2; ++run) {
            const int c0 = cbase + 16 * run, t0 = n * CHUNK + c0;
            unsigned xw[8][3];
#pragma unroll
            for (int rr = 0; rr < 8; ++rr) { const int t = t0 - 2 + rr; const bool ok = (t >= 0) && (t < SEQ);
                const GAS unsigned* rp = (const GAS unsigned*)(QKVG + (size_t)(b * SEQ + (ok ? t : 0)) * 1536 + h * GD + 2 * lane);
#pragma unroll
                for (int wh = 0; wh < 3; ++wh) { const unsigned v = rp[wh * 256]; xw[rr][wh] = ok ? v : 0u; } }
            float kv0[4], kv1[4], vv0[4], vv1[4];
#pragma unroll
            for (int i = 0; i < 4; ++i) {
                float y[3][2];
#pragma unroll
                for (int wh = 0; wh < 3; ++wh) { float a0 = 0.f, a1 = 0.f;
#pragma unroll
                    for (int j = 0; j < CONVK; ++j) { a0 += bf2f(xw[i + j][wh]) * cw[j][wh][0]; a1 += bf2f(xw[i + j][wh] >> 16) * cw[j][wh][1]; }
                    y[wh][0] = silu_f(a0); y[wh][1] = silu_f(a1); }
                const float sq = wave_sum(y[0][0] * y[0][0] + y[0][1] * y[0][1]), sk = wave_sum(y[1][0] * y[1][0] + y[1][1] * y[1][1]);
                const float rq = rsqrtf(sq + EPS) * 0.08838834764831845f, rk = rsqrtf(sk + EPS);
                const int c = c0 + i;
                const float k0 = y[1][0] * rk, k1 = y[1][1] * rk;
                *(GAS unsigned*)(QHAT + (size_t)u * BLOB + offA(c, 2 * lane)) = pk2f(y[0][0] * rq, y[0][1] * rq);
                *(GAS unsigned*)(KHAT + (size_t)u * BLOB + offA(c, 2 * lane)) = pk2f(k0, k1);
                kv0[i] = k0; kv1[i] = k1; vv0[i] = y[2][0]; vv1[i] = y[2][1];
            }
            kt[0][2 * run] = pk2f(kv0[0], kv0[1]); kt[0][2 * run + 1] = pk2f(kv0[2], kv0[3]);
            kt[1][2 * run] = pk2f(kv1[0], kv1[1]); kt[1][2 * run + 1] = pk2f(kv1[2], kv1[3]);
            vt[0][2 * run] = pk2f(vv0[0], vv0[1]); vt[0][2 * run + 1] = pk2f(vv0[2], vv0[3]);
            vt[1][2 * run] = pk2f(vv1[0], vv1[1]); vt[1][2 * run + 1] = pk2f(vv1[2], vv1[3]);
        }
        const int chunk = (P0 >> 3) ^ (lane & 7);
#pragma unroll
        for (int e = 0; e < 2; ++e) { const size_t off = (size_t)u * BLOB + (size_t)(2 * lane + e) * 64 + chunk * 8;
            *(GAS v4u*)(KHT + off) = (v4u){kt[e][0], kt[e][1], kt[e][2], kt[e][3]};
            *(GAS v4u*)(VHT + off) = (v4u){vt[e][0], vt[e][1], vt[e][2], vt[e][3]}; }
    }
    const int gw = F.vcu * NWAVES + F.wave, NGW = F.G * NWAVES;
    for (int it = gw; it < BATCH * AKVH * (SEQ / 64); it += NGW) {
        const int tb = it % (SEQ / 64), bk = it / (SEQ / 64), kvh = bk % AKVH, b = bk / AKVH;
        const GAS bf16_t* src = (const GAS bf16_t*)(KV + (size_t)(b * SEQ + tb * 64) * 256 + 128 + kvh * 64 + lane);
        unsigned pkd[32];
#pragma unroll
        for (int i = 0; i < 32; ++i) pkd[i] = 0u;
#pragma unroll
        for (int tt = 0; tt < 64; ++tt) { const unsigned v = src[(size_t)tt * 256]; const int pos = perm16(tt); pkd[pos >> 1] |= (pos & 1) ? (v << 16) : v; }
        GAS v4u* dst = (GAS v4u*)(VTP + ((size_t)(b * AKVH + kvh) * 64 + lane) * SEQ + tb * 64);
#pragma unroll
        for (int q = 0; q < 8; ++q) dst[q] = (v4u){pkd[4 * q], pkd[4 * q + 1], pkd[4 * q + 2], pkd[4 * q + 3]};
    }
}
__host__ __device__ constexpr int kpinv(int p) { return (p & ~31) | ((p & 4) << 2) | ((p & 24) >> 1) | (p & 3); }
__device__ __forceinline__ bf16x8 fragA_g(const bf16_t* blob, int rt, int s, int fr, int g) { const int row = 16 * rt + fr; return *(const GAS bf16x8*)(blob + row * 128 + (((4 * s + g) ^ fr) << 3)); }
__device__ __forceinline__ bf16x8 fragT_g(const bf16_t* blob, int rt, int s, int fr, int g) { const int row = 16 * rt + fr; return *(const GAS bf16x8*)(blob + row * 64 + (((4 * s + g) ^ ((row >> 1) & 7)) << 3)); }
__device__ __forceinline__ bf16x8 fragT_l(const LAS unsigned char* img, int rt, int s, int fr, int g) { const int row = 16 * rt + fr; return *(const LAS bf16x8*)(img + row * 128 + (((4 * s + g) ^ ((row >> 1) & 7)) << 4)); }

template <int DIR>
__device__ __forceinline__ void p2b_write_ts(LAS unsigned char* img, const float (&T)[64], const LAS float* sct, int c, float sign) {
#pragma unroll
    for (int q = 0; q < 8; ++q) {
        const f32x4 s0 = *(const LAS f32x4*)(sct + 8 * q), s1 = *(const LAS f32x4*)(sct + 8 * q + 4);
        float v[8];
#pragma unroll
        for (int i = 0; i < 8; ++i) { const int cp = kpinv(8 * q + i); const int j = DIR ? 63 - cp : cp; v[i] = T[j] * (i < 4 ? s0[i] : s1[i - 4]) * sign; }
        v4u pw; pw.x = pk2f(v[0], v[1]); pw.y = pk2f(v[2], v[3]); pw.z = pk2f(v[4], v[5]); pw.w = pk2f(v[6], v[7]);
        *(LAS v4u*)(img + c * 128 + ((q ^ ((c >> 1) & 7)) << 4)) = pw;
        asm volatile("" ::: "memory");
    }
}

__device__ __forceinline__ void p2b_task(LAS unsigned char* R, LAS float* sct, int ud, int lane, const bf16_t* QHAT, const bf16_t* KHAT, const bf16_t* KHT, const bf16_t* VHT, const float* GATES,
                                         const float* a_log, const float* dt_bias, bf16_t* Wb, bf16_t* Ub, bf16_t* QKb, float* TAB) {
    const int fr = lane & 15, g = lane >> 4;
    const int u = ud >> 1, dir = ud & 1, n = u % NCH, bh = u / NCH, h = bh % GH, b = bh / GH;
    const int c = dir ? 63 - lane : lane;
    float beta, gc, glast;
    {
        const size_t m = (size_t)b * SEQ + n * CHUNK + c;
        const float a = GATES[m * 16 + dir * 4 + h], bb = GATES[m * 16 + 8 + dir * 4 + h];
        const float z = a + dt_bias[dir * 4 + h];
        const float sp = (z > 20.f) ? z : log1pf(__expf(z));
        float s = -__expf(a_log[dir * 4 + h]) * sp; beta = 1.f / (1.f + __expf(-bb));
#pragma unroll
        for (int o = 1; o < 64; o <<= 1) { const float t = __shfl_up(s, o); if (lane >= o) s += t; }
        gc = s; glast = __shfl(gc, 63);
        TAB[(size_t)ud * TABW + c] = __expf(gc); TAB[(size_t)ud * TABW + 64 + c] = __expf(glast - gc);
        if (lane == 63) TAB[(size_t)ud * TABW + 128] = __expf(glast);
    }
    sct[kperm(c)] = beta * __expf(gc); sct[64 + kperm(c)] = beta;
    float gcr[4][4], ber[4][4], gcc[4];
#pragma unroll
    for (int t = 0; t < 4; ++t) {
        { const int cc = 16 * t + fr; const int pl = dir ? 63 - cc : cc; gcc[t] = __shfl(gc, pl); }
#pragma unroll
        for (int r = 0; r < 4; ++r) { const int cr = 16 * t + 4 * g + r; const int pl = dir ? 63 - cr : cr; gcr[t][r] = __shfl(gc, pl); ber[t][r] = __shfl(beta, pl); }
    }
    const bf16_t* kb = KHAT + (size_t)u * BLOB; const bf16_t* qb = QHAT + (size_t)u * BLOB;
    LAS float* AT = (LAS float*)R;
    {
        bf16x8 kf[4][4], qfa[2][4];
#pragma unroll
        for (int t = 0; t < 4; ++t)
#pragma unroll
            for (int s = 0; s < 4; ++s) kf[t][s] = fragA_g(kb, t, s, fr, g);
#pragma unroll
        for (int s = 0; s < 4; ++s) qfa[0][s] = fragA_g(qb, 0, s, fr, g);
#pragma unroll
        for (int ta = 0; ta < 4; ++ta)
#pragma unroll
            for (int tb = 0; tb < 4; ++tb) {
                f32x4 acc = (f32x4){0.f, 0.f, 0.f, 0.f};
#pragma unroll
                for (int s = 0; s < 4; ++s) acc = __builtin_amdgcn_mfma_f32_16x16x32_bf16(kf[ta][s], kf[tb][s], acc, 0, 0, 0);
                const int ccol = 16 * tb + fr; int pc = dir ? 63 - ccol : ccol; asm volatile("" : "+v"(pc));
                f32x4 v;
#pragma unroll
                for (int r = 0; r < 4; ++r) { const int crow = 16 * ta + 4 * g + r, pr = dir ? 63 - crow : crow;
                    const float e = __expf(fminf(gcr[ta][r] - gcc[tb], 0.f)); v[r] = (pc < pr) ? ber[ta][r] * acc[r] * e : 0.f; }
                const int pr0 = dir ? 63 - (16 * ta + 4 * g + 3) : 16 * ta + 4 * g;
                if (dir) v = (f32x4){v[3], v[2], v[1], v[0]};
                *(LAS f32x4*)(AT + pc * 64 + (pr0 ^ (4 * (pc & 15)))) = v;
            }
#pragma unroll
        for (int tb = 0; tb < 4; ++tb) {
            const int cq = 16 * tb + fr; int pq = dir ? 63 - cq : cq; asm volatile("" : "+v"(pq));
            const bf16x8 (&qf)[4] = qfa[tb & 1];
            if (tb < 3) {
#pragma unroll
                for (int s = 0; s < 4; ++s) qfa[(tb + 1) & 1][s] = fragA_g(qb, tb + 1, s, fr, g); }
#pragma unroll
            for (int sg = 0; sg < 2; ++sg) {
                f32x4 a0 = (f32x4){0.f, 0.f, 0.f, 0.f}, a1 = a0;
#pragma unroll
                for (int s = 0; s < 4; ++s) { a0 = __builtin_amdgcn_mfma_f32_16x16x32_bf16(kf[2 * sg][s], qf[s], a0, 0, 0, 0); a1 = __builtin_amdgcn_mfma_f32_16x16x32_bf16(kf[2 * sg + 1][s], qf[s], a1, 0, 0, 0); }
                float v[8];
#pragma unroll
                for (int r = 0; r < 4; ++r) {
                    { const int ck = 16 * (2 * sg) + 4 * g + r, pk = dir ? 63 - ck : ck; v[r] = (pk <= pq) ? a0[r] * __expf(fminf(gcc[tb] - gcr[2 * sg][r], 0.f)) : 0.f; }
                    { const int ck = 16 * (2 * sg + 1) + 4 * g + r, pk = dir ? 63 - ck : ck; v[4 + r] = (pk <= pq) ? a1[r] * __expf(fminf(gcc[tb] - gcr[2 * sg + 1][r], 0.f)) : 0.f; }
                }
                v4u pw; pw.x = pk2f(v[0], v[1]); pw.y = pk2f(v[2], v[3]); pw.z = pk2f(v[4], v[5]); pw.w = pk2f(v[6], v[7]);
                *(GAS v4u*)(QKb + (size_t)ud * QKBLOB + cq * 64 + (((4 * sg + g) ^ ((cq >> 1) & 7)) << 3)) = pw;
            }
        }
    }
    const bf16_t* ktb = KHT + (size_t)u * BLOB; const bf16_t* vtb = VHT + (size_t)u * BLOB;
    bf16x8 kta[8][2], vta[8][2];
    { int lane1 = lane; asm volatile("" : "+v"(lane1));
      const int fr1 = lane1 & 15, g1 = lane1 >> 4;
#pragma unroll
      for (int t = 0; t < 8; ++t)
#pragma unroll
          for (int s2 = 0; s2 < 2; ++s2) kta[t][s2] = fragT_g(ktb, t, s2, fr1, g1); }
    LDS_WAIT(); asm volatile("" ::: "memory");
    float T[64];
#pragma unroll
    for (int j = 63; j >= 0; --j) {
        int lj = lane; asm volatile("" : "+v"(lj));
        float acc = (lj == j) ? 1.f : 0.f;
#pragma unroll
        for (int k4 = ((j + 1) & ~3); k4 < 64; k4 += 4) {
            const f32x4 a = *(const LAS f32x4*)(AT + j * 64 + (k4 ^ (4 * (j & 15))));
#pragma unroll
            for (int e = 0; e < 4; ++e) if (k4 + e > j) acc -= T[k4 + e] * a[e];
            if ((k4 & 28) == 28) asm volatile("" ::: "memory");
        }
        T[j] = acc;
        asm volatile("" ::: "memory");
    }
    asm volatile("" ::: "memory");
    LAS unsigned char* Tw = R; LAS unsigned char* Tu = R + 8192;
    if (dir) { p2b_write_ts<1>(Tw, T, sct, c, -1.f); p2b_write_ts<1>(Tu, T, sct + 64, c, 1.f); }
    else { p2b_write_ts<0>(Tw, T, sct, c, -1.f); p2b_write_ts<0>(Tu, T, sct + 64, c, 1.f); }
    { int lane1 = lane; asm volatile("" : "+v"(lane1)); const int fr1 = lane1 & 15, g1 = lane1 >> 4;
#pragma unroll
      for (int t = 0; t < 8; ++t)
#pragma unroll
          for (int s2 = 0; s2 < 2; ++s2) vta[t][s2] = fragT_g(vtb, t, s2, fr1, g1); }
    LDS_WAIT(); asm volatile("" ::: "memory");
    int lane2 = lane; asm volatile("" : "+v"(lane2));
    const int fr_ = fr, g_ = g; (void)fr_; (void)g_;
    #define fr (lane2 & 15)
    #define g (lane2 >> 4)
    #define lane lane2
#pragma unroll
    for (int sg = 0; sg < 4; ++sg) {
        const bf16x8 (&ka)[2][2] = *(const bf16x8 (*)[2][2])&kta[2 * sg];
#pragma unroll
        for (int ct = 0; ct < 4; ++ct) {
            f32x4 a0 = (f32x4){0.f, 0.f, 0.f, 0.f}, a1 = a0;
#pragma unroll
            for (int s2 = 0; s2 < 2; ++s2) { const bf16x8 tb_ = fragT_l(Tw, ct, s2, fr, g);
                a0 = __builtin_amdgcn_mfma_f32_16x16x32_bf16(ka[0][s2], tb_, a0, 0, 0, 0); a1 = __builtin_amdgcn_mfma_f32_16x16x32_bf16(ka[1][s2], tb_, a1, 0, 0, 0); }
            const int cc = 16 * ct + fr;
            v4u pw; pw.x = pk2f(a0[0], a0[1]); pw.y = pk2f(a0[2], a0[3]); pw.z = pk2f(a1[0], a1[1]); pw.w = pk2f(a1[2], a1[3]);
            *(GAS v4u*)(Wb + (size_t)ud * BLOB + cc * 128 + (((4 * sg + g) ^ fr) << 3)) = pw;
        }
    }
#pragma unroll
    for (int ct = 0; ct < 4; ++ct) {
        bf16x8 ta_[2];
#pragma unroll
        for (int s2 = 0; s2 < 2; ++s2) ta_[s2] = fragT_l(Tu, ct, s2, fr, g);
#pragma unroll
        for (int vt = 0; vt < 8; ++vt) {
            f32x4 a0 = (f32x4){0.f, 0.f, 0.f, 0.f};
#pragma unroll
            for (int s2 = 0; s2 < 2; ++s2) a0 = __builtin_amdgcn_mfma_f32_16x16x32_bf16(ta_[s2], vta[vt][s2], a0, 0, 0, 0);
            v2u pw; pw.x = pk2f(a0[0], a0[1]); pw.y = pk2f(a0[2], a0[3]);
            *(GAS v2u*)(Ub + (size_t)ud * BLOB + (size_t)((vt * 4 + ct) * 64 + lane) * 4) = pw;
        }
    }
    LDS_WAIT(); asm volatile("" ::: "memory");
    #undef fr
    #undef g
    #undef lane
}
__device__ __forceinline__ void phase_p2b(Frame& F, const bf16_t* QHAT, const bf16_t* KHAT, const bf16_t* KHT, const bf16_t* VHT, const float* GATES,
                                          const float* a_log, const float* dt_bias, bf16_t* Wb, bf16_t* Ub, bf16_t* QKb, float* TAB) {
    const int gw = F.vcu * NWAVES + F.wave, NGW = F.G * NWAVES;
    LAS unsigned char* R = F.lds + F.wave * 16384; LAS float* sct = (LAS float*)(F.lds + RING_BYTES + 1024 + F.wave * 512);
    for (int ud = gw; ud < NUNIT * 2; ud += NGW) { int ln = F.lane; asm volatile("" : "+v"(ln));
        p2b_task(R, sct, ud, ln, QHAT, KHAT, KHT, VHT, GATES, a_log, dt_bias, Wb, Ub, QKb, TAB); }
}
#ifndef SCAN_SPLIT
#define SCAN_SPLIT 2
#endif
constexpr int SCAN_NCW = 8 / SCAN_SPLIT;
constexpr int SCAN_WGS = 16 * SCAN_SPLIT;
__device__ __forceinline__ bf16x8 pack8(f32x4 a, f32x4 b) {
    v4u r; r.x = pk2f(a[0], a[1]); r.y = pk2f(a[2], a[3]); r.z = pk2f(b[0], b[1]); r.w = pk2f(b[2], b[3]); return __builtin_bit_cast(bf16x8, r);
}
constexpr int SC_W = 0, SC_Q = 16384, SC_K = 32768, SC_QK = 49152, SC_TAB = 57344, SC_BUF = 58368;
struct ScanRegs { v2u ub[4]; };
__device__ __forceinline__ void glds16(const void* gsrc, unsigned lds_dst) {
    unsigned keep;
    asm volatile("s_mov_b32 %0, m0\n\ts_mov_b32 m0, %2\n\ts_nop 0\n\tglobal_load_lds_dwordx4 %1, off\n\ts_mov_b32 m0, %0" : "=&s"(keep) : "v"(gsrc), "s"(lds_dst) : "memory");
}
__device__ __forceinline__ void glds4(const void* gsrc, unsigned lds_dst) {
    unsigned keep;
    asm volatile("s_mov_b32 %0, m0\n\ts_mov_b32 m0, %2\n\ts_nop 0\n\tglobal_load_lds_dword %1, off\n\ts_mov_b32 m0, %0" : "=&s"(keep) : "v"(gsrc), "s"(lds_dst) : "memory");
}
struct ScanSrc { const char *pw, *pq, *pk, *pqk, *pt, *pu; };
template <int LW, int NLW>
__device__ __forceinline__ void scan_stage_t(unsigned ldsb, const ScanSrc& c, int lane) {
#pragma unroll
    for (int pc = LW; pc < 57; pc += NLW) {
        const char* src = (pc < 16) ? c.pw + pc * 1024 : (pc < 32) ? c.pq + (pc - 16) * 1024 : (pc < 48) ? c.pk + (pc - 32) * 1024 : (pc < 56) ? c.pqk + (pc - 48) * 1024 : c.pt;
        glds16(src + lane * 16, (unsigned)__builtin_amdgcn_readfirstlane(ldsb + pc * 1024));
    }
}
constexpr int SCAN_NPF = 3;
template <int LW>
__device__ __forceinline__ void scan_prefetch_t(unsigned dummy, const ScanSrc& c, int lane) {
    const char* b0 = (LW == 0) ? c.pw : (LW == 1) ? c.pq : (LW == 2) ? c.pk : c.pqk;
    glds4(b0 + lane * 128, dummy);
    if (LW < 3) { glds4(b0 + 8192 + lane * 128, dummy); glds4(b0 + (lane & 1) * 8192 + (lane >> 1) * 128 + 64, dummy); }
    else { glds4(c.pu + lane * 128, dummy); glds4(c.pt + (lane & 7) * 96, dummy); }
}
__device__ __forceinline__ void scan_loader(LAS unsigned char* buf, unsigned dummy, const ScanSrc& now, const ScanSrc& later, bool pf, int lw, int lane) {
    const unsigned ldsb = (unsigned)(uintptr_t)buf;
    switch (lw) { case 0: scan_stage_t<0, 4>(ldsb, now, lane); if (pf) scan_prefetch_t<0>(dummy, later, lane); break;
                  case 1: scan_stage_t<1, 4>(ldsb, now, lane); if (pf) scan_prefetch_t<1>(dummy, later, lane); break;
                  case 2: scan_stage_t<2, 4>(ldsb, now, lane); if (pf) scan_prefetch_t<2>(dummy, later, lane); break;
                  default: scan_stage_t<3, 4>(ldsb, now, lane); if (pf) scan_prefetch_t<3>(dummy, later, lane); break; }
    if (pf) asm volatile("s_waitcnt vmcnt(3)" ::: "memory"); else asm volatile("s_waitcnt vmcnt(0)" ::: "memory");
}
__device__ __forceinline__ void scan_load_regs(ScanRegs& R, const bf16_t* Ub, size_t ud, int sl, int lane) {
#pragma unroll
    for (int ct = 0; ct < 4; ++ct) R.ub[ct] = *(const GAS v2u*)(Ub + ud * BLOB + (size_t)((sl * 4 + ct) * 64 + lane) * 4);
}
#define SCAN_SB() __builtin_amdgcn_sched_barrier(0)
__device__ __forceinline__ void scan_compute(f32x4 (&S)[8], const LAS unsigned char* cur, const ScanRegs& R, v2u (&ow)[4], int lane) {
    const int fr = lane & 15, g = lane >> 4;
    const LAS float* tab = (const LAS float*)(cur + SC_TAB);
    const LAS unsigned char* pA = cur + fr * 256;
    const LAS unsigned char* pT = cur + fr * 128;
    const int sw = (fr >> 1) & 7;
    bf16x8 fa[8], fb[8];
#define LD_A(dst, base, c0) _Pragma("unroll") for (int i_ = 0; i_ < 8; ++i_) dst[i_] = *(const LAS bf16x8*)(pA + (base) + ((c0) + (i_ >> 2)) * 4096 + (((4 * (i_ & 3) + g) ^ fr) << 4))
#define LD_T(dst, base, t0) _Pragma("unroll") for (int i_ = 0; i_ < 8; ++i_) dst[i_] = *(const LAS bf16x8*)(pT + (base) + ((t0) + (i_ >> 1)) * 2048 + (((4 * (i_ & 1) + g) ^ sw) << 4))
    LD_A(fa, SC_W, 0); LD_A(fb, SC_W, 2);
    SCAN_SB();
    bf16x8 bS[4];
#pragma unroll
    for (int s = 0; s < 4; ++s) bS[s] = pack8(S[2 * s], S[2 * s + 1]);
    f32x4 vn[4], oa[4];
#pragma unroll
    for (int ct = 0; ct < 4; ++ct) vn[ct] = (f32x4){bf2f(R.ub[ct].x), bf2f(R.ub[ct].x >> 16), bf2f(R.ub[ct].y), bf2f(R.ub[ct].y >> 16)};
#pragma unroll
    for (int i = 0; i < 8; ++i) vn[i >> 2] = __builtin_amdgcn_mfma_f32_16x16x32_bf16(fa[i], bS[i & 3], vn[i >> 2], 0, 0, 0);
    SCAN_SB(); LD_A(fa, SC_Q, 0); SCAN_SB();
#pragma unroll
    for (int i = 0; i < 8; ++i) vn[2 + (i >> 2)] = __builtin_amdgcn_mfma_f32_16x16x32_bf16(fb[i], bS[i & 3], vn[2 + (i >> 2)], 0, 0, 0);
    SCAN_SB(); LD_A(fb, SC_Q, 2); SCAN_SB();
#pragma unroll
    for (int ct = 0; ct < 4; ++ct) oa[ct] = (f32x4){0.f, 0.f, 0.f, 0.f};
#pragma unroll
    for (int i = 0; i < 8; ++i) oa[i >> 2] = __builtin_amdgcn_mfma_f32_16x16x32_bf16(fa[i], bS[i & 3], oa[i >> 2], 0, 0, 0);
    bf16x8 bV[2], bK[2];
    { const f32x4 ek0 = *(const LAS f32x4*)(tab + 64 + 4 * g), ek1 = *(const LAS f32x4*)(tab + 80 + 4 * g), ek2 = *(const LAS f32x4*)(tab + 96 + 4 * g), ek3 = *(const LAS f32x4*)(tab + 112 + 4 * g);
      bV[0] = pack8(vn[0], vn[1]); bV[1] = pack8(vn[2], vn[3]);
      bK[0] = pack8(vn[0] * ek0, vn[1] * ek1); bK[1] = pack8(vn[2] * ek2, vn[3] * ek3); }
    SCAN_SB(); LD_T(fa, SC_K, 0); SCAN_SB();
#pragma unroll
    for (int i = 0; i < 8; ++i) oa[2 + (i >> 2)] = __builtin_amdgcn_mfma_f32_16x16x32_bf16(fb[i], bS[i & 3], oa[2 + (i >> 2)], 0, 0, 0);
    const float egl = tab[128];
    SCAN_SB(); LD_T(fb, SC_K, 4); SCAN_SB();
#pragma unroll
    for (int i = 0; i < 8; ++i) { if ((i & 1) == 0) S[i >> 1] = S[i >> 1] * egl; S[i >> 1] = __builtin_amdgcn_mfma_f32_16x16x32_bf16(fa[i], bK[i & 1], S[i >> 1], 0, 0, 0); }
    SCAN_SB(); LD_T(fa, SC_QK, 0); SCAN_SB();
#pragma unroll
    for (int i = 0; i < 8; ++i) { if ((i & 1) == 0) S[4 + (i >> 1)] = S[4 + (i >> 1)] * egl; S[4 + (i >> 1)] = __builtin_amdgcn_mfma_f32_16x16x32_bf16(fb[i], bK[i & 1], S[4 + (i >> 1)], 0, 0, 0); }
    { const f32x4 eg0 = *(const LAS f32x4*)(tab + 4 * g), eg1 = *(const LAS f32x4*)(tab + 16 + 4 * g), eg2 = *(const LAS f32x4*)(tab + 32 + 4 * g), eg3 = *(const LAS f32x4*)(tab + 48 + 4 * g);
      oa[0] = oa[0] * eg0; oa[1] = oa[1] * eg1; oa[2] = oa[2] * eg2; oa[3] = oa[3] * eg3; }
    SCAN_SB();
#pragma unroll
    for (int i = 0; i < 8; ++i) oa[i >> 1] = __builtin_amdgcn_mfma_f32_16x16x32_bf16(fa[i], bV[i & 1], oa[i >> 1], 0, 0, 0);
#pragma unroll
    for (int ct = 0; ct < 4; ++ct) { ow[ct].x = pk2f(oa[ct][0], oa[ct][1]); ow[ct].y = pk2f(oa[ct][2], oa[ct][3]); }
#undef LD_A
#undef LD_T
}
__device__ __forceinline__ void scan_store_o(const v2u (&ow)[4], bf16_t* obase, int lane) {
    const int fr = lane & 15, g = lane >> 4;
#pragma unroll
    for (int ct = 0; ct < 4; ++ct) { bf16_t* op = obase + (size_t)(16 * ct + 4 * g) * 512 + fr;
        op[0] = (bf16_t)(ow[ct].x & 0xffffu); op[512] = (bf16_t)(ow[ct].x >> 16); op[1024] = (bf16_t)(ow[ct].y & 0xffffu); op[1536] = (bf16_t)(ow[ct].y >> 16); }
}
__device__ __forceinline__ void phase_scan(Frame& F, int chain, int half, const bf16_t* QHAT, const bf16_t* KHT, const bf16_t* Wb, const bf16_t* Ub, const bf16_t* QKb, const float* TAB, bf16_t* ODIR) {
    static_assert(SCAN_SPLIT == 2, "scan: 4 compute waves + 4 loader waves per workgroup, two workgroups per chain");
    const int lane = F.lane, w = F.wave;
    const int dir = chain & 1, bh = chain >> 1, h = bh % GH, b = bh / GH;
    const bool compute = (w < 4);
    const int sl = half * 4 + (w & 3);
    const int lw = w - 4;
    const unsigned dummy = (unsigned)(uintptr_t)(F.lds + RING_BYTES + 1024);
    f32x4 S[8];
#pragma unroll
    for (int t = 0; t < 8; ++t) S[t] = (f32x4){0.f, 0.f, 0.f, 0.f};
    ScanRegs RA, RB; v2u ow[4];
    constexpr int PFD = 3;
#define SCAN_SRC(n_) [&]() { const size_t u_ = (size_t)bh * NCH + (n_), ud_ = u_ * 2 + dir; ScanSrc c_; c_.pw = (const char*)(Wb + ud_ * BLOB); c_.pq = (const char*)(QHAT + u_ * BLOB); c_.pk = (const char*)(KHT + u_ * BLOB); \
        c_.pqk = (const char*)(QKb + ud_ * QKBLOB); c_.pt = (const char*)(TAB + ud_ * TABW); c_.pu = (const char*)(Ub + ud_ * BLOB) + half * 8192; return c_; }()
#define SCAN_N(step_) (dir ? NCH - 1 - (step_) : (step_))
    if (!compute) { scan_loader(F.lds, dummy, SCAN_SRC(SCAN_N(0)), SCAN_SRC(SCAN_N(1)), true, lw, lane); }
    else scan_load_regs(RA, Ub, ((size_t)bh * NCH + SCAN_N(0)) * 2 + dir, sl, lane);
    VM_WAIT(); __syncthreads();
    bf16_t* const ocol = ODIR + ((size_t)dir * M + (size_t)b * SEQ) * 512 + h * GD + 16 * sl;
#define SCAN_STEP(step, RC, RN) do { \
        const int n = SCAN_N(step); \
        LAS unsigned char* cur = F.lds + ((step) & 1) * SC_BUF; LAS unsigned char* nxt = F.lds + (((step) + 1) & 1) * SC_BUF; \
        if (compute) { \
            if ((step) > 0) scan_store_o(ow, ocol + (size_t)SCAN_N((step) - 1) * CHUNK * 512, lane); \
            if ((step) + 1 < NCH) scan_load_regs(RN, Ub, ((size_t)bh * NCH + SCAN_N((step) + 1)) * 2 + dir, sl, lane); \
            scan_compute(S, cur, RC, ow, lane); VM_WAIT(); \
        } else if ((step) + 1 < NCH) { const bool pf = ((step) + PFD < NCH); scan_loader(nxt, dummy, SCAN_SRC(SCAN_N((step) + 1)), SCAN_SRC(SCAN_N(pf ? (step) + PFD : (step) + 1)), pf, lw, lane); } \
        (void)n; __syncthreads(); } while (0)
    for (int step = 0; step < NCH; step += 2) { SCAN_STEP(step, RA, RB); SCAN_STEP(step + 1, RB, RA); }
#undef SCAN_STEP
#undef SCAN_SRC
    if (compute) scan_store_o(ow, ocol + (size_t)SCAN_N(NCH - 1) * CHUNK * 512, lane);
#undef SCAN_N
}
typedef float f32x16 __attribute__((ext_vector_type(16)));
constexpr int AT_BTAB = 0;
constexpr int AT_WS = 8 * 260 * 4;
__device__ __forceinline__ void attn_tables(Frame& F, const float* rel_bias) {
    LAS float* bt = (LAS float*)(F.lds + AT_BTAB);
    for (int i = F.tid; i < 8 * 257; i += NWAVES * 64) { const int h = i / 257, r = i % 257; bt[h * 260 + r] = rel_bias[t5_bucket(r - 128) * AH + h]; }
    __syncthreads();
}
__device__ __forceinline__ void attn_task(Frame& F, int task, bf16_t* QC, const bf16_t* KV, const bf16_t* VTP, const float* sink) {
    const int lane = F.lane, q = lane & 31, hh = lane >> 5;
    const int gq = task & 3, qblk = (task >> 2) & 255, bk = task >> 10, kvh = bk & 1, b = bk >> 1, h = kvh * 4 + gq, q0 = qblk * 32;
    const LAS float* bt = (const LAS float*)(F.lds + AT_BTAB) + h * 260;
    LAS float* wsf = (LAS float*)(F.lds + AT_WS) + F.wave * 64;
    bf16x8 qf[4];
    { const bf16_t* qp = QC + (size_t)(b * SEQ + q0 + q) * 1024 + h * 64 + 8 * hh;
#pragma unroll
      for (int s = 0; s < 4; ++s) qf[s] = *(const GAS bf16x8*)(qp + 16 * s); }
    const int T0 = (qblk - 4 < 0) ? 0 : qblk - 4, T1 = (qblk + 4 > SEQ / 32 - 1) ? SEQ / 32 - 1 : qblk + 4;
    const bf16_t* kbase = KV + (size_t)(b * SEQ) * 256 + kvh * 64 + 8 * hh;
    const int qpos = q0 + q;
    float mx = sink[h];
    for (int T = T0; T <= T1; ++T) {
        f32x16 acc;
#pragma unroll
        for (int r = 0; r < 16; ++r) acc[r] = 0.f;
        const bf16_t* kp = kbase + (size_t)(32 * T + q) * 256;
#pragma unroll
        for (int s = 0; s < 4; ++s) { const bf16x8 kf = *(const GAS bf16x8*)(kp + 16 * s); acc = __builtin_amdgcn_mfma_f32_32x32x16_bf16(kf, qf[s], acc, 0, 0, 0); }
#pragma unroll
        for (int r = 0; r < 16; ++r) { const int key = 32 * T + (r & 3) + 8 * (r >> 2) + 4 * hh; const int rel = key - qpos;
            if (rel >= -WIN && rel <= WIN) mx = fmaxf(mx, acc[r] * 0.125f + bt[rel + 128]); }
    }
    mx = fmaxf(mx, __shfl_xor(mx, 32));
    f32x16 o0, o1;
#pragma unroll
    for (int r = 0; r < 16; ++r) { o0[r] = 0.f; o1[r] = 0.f; }
    float l = 0.f;
    const bf16_t* vbase = VTP + ((size_t)(b * AKVH + kvh) * 64 + q) * SEQ + 8 * hh;
    for (int T = T0; T <= T1; ++T) {
        f32x16 acc;
#pragma unroll
        for (int r = 0; r < 16; ++r) acc[r] = 0.f;
        const bf16_t* kp = kbase + (size_t)(32 * T + q) * 256;
#pragma unroll
        for (int s = 0; s < 4; ++s) { const bf16x8 kf = *(const GAS bf16x8*)(kp + 16 * s); acc = __builtin_amdgcn_mfma_f32_32x32x16_bf16(kf, qf[s], acc, 0, 0, 0); }
        float p[16];
#pragma unroll
        for (int r = 0; r < 16; ++r) { const int key = 32 * T + (r & 3) + 8 * (r >> 2) + 4 * hh; const int rel = key - qpos;
            const bool ok = (rel >= -WIN && rel <= WIN);
            const float sc = acc[r] * 0.125f + bt[ok ? rel + 128 : 128];
            p[r] = ok ? __expf(sc - mx) : 0.f; l += p[r]; }
#pragma unroll
        for (int s2 = 0; s2 < 2; ++s2) {
            v4u pw; pw.x = pk2f(p[8 * s2], p[8 * s2 + 1]); pw.y = pk2f(p[8 * s2 + 2], p[8 * s2 + 3]); pw.z = pk2f(p[8 * s2 + 4], p[8 * s2 + 5]); pw.w = pk2f(p[8 * s2 + 6], p[8 * s2 + 7]);
            const bf16x8 pa = __builtin_bit_cast(bf16x8, pw);
            const bf16x8 v0 = *(const GAS bf16x8*)(vbase + 32 * T + 16 * s2);
            const bf16x8 v1 = *(const GAS bf16x8*)(vbase + (size_t)32 * SEQ + 32 * T + 16 * s2);
            o0 = __builtin_amdgcn_mfma_f32_32x32x16_bf16(pa, v0, o0, 0, 0, 0);
            o1 = __builtin_amdgcn_mfma_f32_32x32x16_bf16(pa, v1, o1, 0, 0, 0);
        }
    }
    l += __shfl_xor(l, 32);
    l += __expf(sink[h] - mx);
    if (hh == 0) wsf[q] = 1.f / l;
    LDS_WAIT(); asm volatile("" ::: "memory");
    bf16_t* op = QC + (size_t)(b * SEQ + q0) * 1024 + h * 64 + q;
#pragma unroll
    for (int r = 0; r < 16; ++r) { const int qr = (r & 3) + 8 * (r >> 2) + 4 * hh; const float il = wsf[qr];
        op[(size_t)qr * 1024] = (bf16_t)f2bf(o0[r] * il); op[(size_t)qr * 1024 + 32] = (bf16_t)f2bf(o1[r] * il); }
    LDS_WAIT(); asm volatile("" ::: "memory");
}
__device__ __forceinline__ void phase_attn(Frame& F, int aw, int naw, bf16_t* QC, const bf16_t* KV, const bf16_t* VTP, const float* rel_bias, const float* sink) {
    attn_tables(F, rel_bias);
    for (int task = aw; task < BATCH * AKVH * 256 * 4; task += naw) attn_task(F, task, QC, KV, VTP, sink);
}
#define MIXER_PHASES \
    bf16_t* VTP = (bf16_t*)(ws + WS_VTP); (void)VTP; \
    if (IN(2)) { phase_p2a(F, QKVG, KV, conv_w, QHAT, KHAT, KHT, VHT, VTP); if (BOTH(2)) { VM_WAIT(); __syncthreads(); } }     \
    if (IN(3)) { phase_p2b(F, QHAT, KHAT, KHT, VHT, GATES, a_log, dt_bias, Wb, Ub, QKb, TAB); if (BOTH(3)) GRID_BAR(); } \
    if (IN(4)) { if (blockIdx.x < SCAN_WGS) { const int bx_ = (int)blockIdx.x, slot_ = bx_ >> 3; phase_scan(F, (bx_ & 7) + 8 * (slot_ / SCAN_SPLIT), slot_ % SCAN_SPLIT, QHAT, KHT, Wb, Ub, QKb, TAB, ODIR); } \
                 else phase_attn(F, ((int)blockIdx.x - SCAN_WGS) * NWAVES + F.wave, (F.G - SCAN_WGS) * NWAVES, QC, KV, VTP, rel_bias, attn_sink); \
                 if (BOTH(4)) GRID_BAR(); }
#define HAVE_REF_MIXERS 1
#define REF_P2A k_p2a<<<dim3(M, GH), 128, 0, stream>>>((bf16_t*)(ws + WS_QKVG), (const float*)d_in[5], (bf16_t*)(ws + WS_QHAT), (bf16_t*)(ws + WS_KHAT), (bf16_t*)(ws + WS_KHT), (bf16_t*)(ws + WS_VHT));
#define REF_P2B k_p2b_ref<<<NUNIT * 2, 64, P2B_SMEM, stream>>>((bf16_t*)(ws + WS_QHAT), (bf16_t*)(ws + WS_KHAT), (bf16_t*)(ws + WS_VHT), (float*)(ws + WS_GATES), (const float*)d_in[6], (const float*)d_in[7], (bf16_t*)(ws + WS_W), (bf16_t*)(ws + WS_U), (bf16_t*)(ws + WS_QK), (float*)(ws + WS_TAB));
#define REF_SCAN k_scan_ref<<<16, 128, SCAN_SMEM, stream>>>((bf16_t*)(ws + WS_QHAT), (bf16_t*)(ws + WS_KHT), (bf16_t*)(ws + WS_W), (bf16_t*)(ws + WS_U), (bf16_t*)(ws + WS_QK), (float*)(ws + WS_TAB), (bf16_t*)(ws + WS_ODIR));
#define REF_ATTN k_attn_ref<<<dim3(M / 64, AH), 64, 0, stream>>>((bf16_t*)(ws + WS_QC), (bf16_t*)(ws + WS_KV), (const float*)d_in[3], (const float*)d_in[4]);
#define MEGA(lo, hi, idx) a.ph_lo = lo; a.ph_hi = hi; a.li = idx; hipLaunchKernelGGL(mega, dim3(grid), dim3(NWAVES * 64), LDS_BYTES, stream, a);
#define LAUNCH_PROGRAM { MEGA(0, 10, 0) }
struct Args { const float* in[14]; float* out; unsigned char* ws; int ph_lo, ph_hi, li, pad; };
__global__ void __launch_bounds__(NWAVES * 64, 2) mega(Args args) {
    extern __shared__ __attribute__((aligned(16))) unsigned char lds[];
    Frame F;
    F.lds = (LAS unsigned char*)lds; F.MISC = (volatile LAS unsigned*)(F.lds + MISC_OFF);
    F.tid = threadIdx.x; F.lane = F.tid & 63; F.wave = __builtin_amdgcn_readfirstlane(F.tid >> 6);
    F.G = gridDim.x; { const int bx = blockIdx.x; F.vcu = (F.G % 8 == 0) ? (bx % 8) * (F.G / 8) + bx / 8 : bx; }
    unsigned char* ws = args.ws; F.ctl = (gu32*)(ws + WS_CTL);
    const float* x = args.in[0]; const float* norm_mix_w = args.in[1]; const float* w_in = args.in[2];
    const float* rel_bias = args.in[3]; const float* attn_sink = args.in[4]; const float* conv_w = args.in[5];
    const float* a_log = args.in[6]; const float* dt_bias = args.in[7]; const float* gdn_norm_w = args.in[8];
    const float* w_out = args.in[9]; const float* norm_ffn_w = args.in[10]; const float* w_ffn_in = args.in[11];
    const float* w_ffn_out = args.in[12]; const float* norm_final_w = args.in[13]; float* out = args.out;
    bf16_t* WIN_T = (bf16_t*)(ws + WS_WIN); bf16_t* WOUT_T = (bf16_t*)(ws + WS_WOUT); bf16_t* W1_T = (bf16_t*)(ws + WS_W1); bf16_t* W2_T = (bf16_t*)(ws + WS_W2);
    float* GATES = (float*)(ws + WS_GATES); bf16_t* XN = (bf16_t*)(ws + WS_XN); bf16_t* QHAT = (bf16_t*)(ws + WS_QHAT); bf16_t* KHT = (bf16_t*)(ws + WS_KHT); bf16_t* HB = (bf16_t*)(ws + WS_HB);
    bf16_t* QC = (bf16_t*)(ws + WS_QC); bf16_t* KV = (bf16_t*)(ws + WS_KV); bf16_t* Z = (bf16_t*)(ws + WS_Z); bf16_t* QKVG = (bf16_t*)(ws + WS_QKVG);
    bf16_t* Wb = (bf16_t*)(ws + WS_W); bf16_t* QKb = (bf16_t*)(ws + WS_QK); bf16_t* KHAT = (bf16_t*)(ws + WS_KHAT); bf16_t* VHT = (bf16_t*)(ws + WS_VHT); bf16_t* ODIR = (bf16_t*)(ws + WS_ODIR);
    bf16_t* Ub = (bf16_t*)(ws + WS_U); float* TAB = (float*)(ws + WS_TAB); float* SSQ1 = (float*)(ws + WS_SSQ1); float* SSQ2 = (float*)(ws + WS_SSQ2); bf16_t* ACT = (bf16_t*)(ws + WS_ACT);
    (void)rel_bias; (void)attn_sink; (void)conv_w; (void)a_log; (void)dt_bias; (void)QHAT; (void)KHT; (void)QKVG; (void)Wb; (void)QKb; (void)KHAT; (void)VHT; (void)Ub; (void)TAB; (void)KV;
    for (int u = F.tid; u < (LDS_BYTES - LDSCTL_OFF) / 4; u += NWAVES * 64) ((LAS unsigned*)(F.lds + LDSCTL_OFF))[u] = 0u;
    __syncthreads();
    XcdBarrier bar = xcd_barrier_post((unsigned*)(F.ctl + CW_BAR) + args.li * XCD_BAR_WORDS, F.MISC + 8);
    const int lo = args.ph_lo, hi = args.ph_hi;
#define IN(k) (lo <= (k) && (k) < hi)
#define BOTH(k) (IN(k) && IN((k) + 1))
#define GRID_BAR() xcd_barrier(bar)
    if (IN(0)) { P0Args a{x, norm_mix_w, w_in, w_out, norm_ffn_w, w_ffn_in, w_ffn_out, WIN_T, WOUT_T, W1_T, W2_T, XN, GATES}; phase_p0(F, a); if (BOTH(0)) GRID_BAR(); }
    if (IN(1)) { pg8::Gemm g{XN, WIN_T, M, NPROJ, DM, 0}; pg8::StaticOrder S; S.init(M, NPROJ, F.G, (int)blockIdx.x); pg8::EpiProj E{QC, KV, QKVG, Z};
        pg8::gemm_phase<pg8::EpiProj, pg8::StaticOrder, true, true>(F.lds, g, S, E); if (BOTH(1)) GRID_BAR(); }
    MIXER_PHASES
    if (IN(5)) { phase_p4(F, ODIR, Z, gdn_norm_w, QC); if (BOTH(5)) GRID_BAR(); }
    if (IN(6)) { pg8::Gemm g{QC, WOUT_T, M, DM, DM, 0}; pg8::StaticOrder S; S.init(M, DM, F.G, (int)blockIdx.x); pg8::EpiRes E{x, out, HB, SSQ1};
        pg8::gemm_phase<pg8::EpiRes, pg8::StaticOrder, false, true>(F.lds, g, S, E); if (BOTH(6)) GRID_BAR(); }
    if (IN(7)) { pg8::Gemm g{HB, W1_T, M, DFF, DM, 0}; pg8::StaticOrder S; S.init(M, DFF, F.G, (int)blockIdx.x); pg8::EpiFfn1 E{ACT, SSQ1};
        pg8::gemm_phase<pg8::EpiFfn1, pg8::StaticOrder, true, true>(F.lds, g, S, E); if (BOTH(7)) GRID_BAR(); }
    if (IN(8)) { pg8::Gemm g{ACT, W2_T, M, DM, DFF, 0}; pg8::StaticOrder S; S.init(M, DM, F.G, (int)blockIdx.x); pg8::EpiRes E{out, out, nullptr, SSQ2};
        pg8::gemm_phase<pg8::EpiRes, pg8::StaticOrder, false, true>(F.lds, g, S, E); if (BOTH(8)) GRID_BAR(); }
    if (IN(9)) { phase_p8(F, out, SSQ2, norm_final_w); }
#undef IN
#undef BOTH
}
extern "C" void kernel_launch(void* const* d_in, const int* in_sizes, int n_in, void* d_out, int out_size, void* d_ws, size_t ws_size, hipStream_t stream) {
    static int grid = 0;
    constexpr int P2B_SMEM = (64 * 129 * 2 + 64 * 65 * 2 + 192) * 4, SCAN_SMEM = (128 * 128 + 64 * 128 * 2 + 64 * 64) * 4;
    if (grid == 0) {
        if (n_in != 14 || ws_size < WS_END) { fprintf(stderr, "kernel_launch: unexpected inputs (n_in %d, ws %zu)\n", n_in, ws_size); grid = -1; return; }
        int dev = 0, cus = 0, per_cu = 0;
        if (hipGetDevice(&dev) != hipSuccess || hipDeviceGetAttribute(&cus, hipDeviceAttributeMultiprocessorCount, dev) != hipSuccess) { grid = -1; return; }
        if (hipFuncSetAttribute((const void*)mega, hipFuncAttributeMaxDynamicSharedMemorySize, LDS_BYTES) != hipSuccess) { fprintf(stderr, "kernel_launch: hipFuncSetAttribute failed\n"); grid = -1; return; }
        if (hipOccupancyMaxActiveBlocksPerMultiprocessor(&per_cu, (const void*)mega, NWAVES * 64, LDS_BYTES) != hipSuccess || per_cu < 1) { fprintf(stderr, "kernel_launch: occupancy query says %d\n", per_cu); per_cu = 1; }
        (void)hipGetLastError();
        grid = cus * 1;
#ifdef HAVE_REF_MIXERS
        (void)hipFuncSetAttribute((const void*)k_p2b_ref, hipFuncAttributeMaxDynamicSharedMemorySize, P2B_SMEM);
        (void)hipFuncSetAttribute((const void*)k_scan_ref, hipFuncAttributeMaxDynamicSharedMemorySize, SCAN_SMEM);
#endif
    }
    if (grid < 0) return;
    if (hipMemsetAsync((char*)d_ws + WS_CTL, 0, CTL_ZERO_BYTES, stream) != hipSuccess) return;
    Args a{};
    for (int i = 0; i < 14; ++i) a.in[i] = (const float*)d_in[i];
    a.out = (float*)d_out; a.ws = (unsigned char*)d_ws;
    LAUNCH_PROGRAM
}
```

```cpp
#include <hip/hip_runtime.h>
#include <cstdio>
#include <cstdint>

constexpr int BATCH = 2, SEQ = 8192, DM = 1024, M = BATCH * SEQ;
constexpr int AH = 8, AKVH = 2, AHD = 64, WIN = 128;
constexpr int GH = 4, GD = 128, CONVK = 5, CHUNK = 64, NCH = SEQ / CHUNK;
constexpr int DFF = 4096, DIN = 2832, NPROJ = 2816;
constexpr float EPS = 1e-6f;
constexpr int NUNIT = BATCH * GH * NCH;

constexpr size_t MiB = 1u << 20;
constexpr size_t WS_CTL = 0, CTL_ZERO_BYTES = 1 * MiB;
constexpr size_t WS_WIN = 1 * MiB;
constexpr size_t WS_WOUT = 7 * MiB;
constexpr size_t WS_W1 = 9 * MiB;
constexpr size_t WS_W2 = 17 * MiB;
constexpr size_t WS_GATES = 25 * MiB;
constexpr size_t WS_XN = 26 * MiB;
constexpr size_t WS_QHAT = 26 * MiB, WS_KHT = 42 * MiB, WS_HB = 26 * MiB;
constexpr size_t WS_QC = 58 * MiB;
constexpr size_t WS_KV = 90 * MiB;
constexpr size_t WS_Z = 98 * MiB;
constexpr size_t WS_QKVG = 114 * MiB;
constexpr size_t WS_W = 114 * MiB, WS_QK = 146 * MiB;
constexpr size_t WS_TMP = 162 * MiB;
constexpr size_t WS_KHAT = 162 * MiB, WS_VHT = 178 * MiB, WS_ODIR = 162 * MiB;
constexpr size_t WS_U = 194 * MiB;
constexpr size_t WS_TAB = 226 * MiB;
constexpr size_t WS_SSQ1 = 228 * MiB;
constexpr size_t WS_SSQ2 = 229 * MiB;
constexpr size_t WS_ACT = 58 * MiB;
constexpr size_t WS_END = 256 * MiB;
static_assert(WS_ACT + (size_t)M * DFF * 2 <= WS_U && WS_SSQ2 + (size_t)M * 16 * 4 <= WS_END, "d_ws map");

typedef unsigned short bf16_t;
__host__ __device__ __forceinline__ unsigned f2bf(float f) { unsigned u = __builtin_bit_cast(unsigned, f); return (u + 0x7fffu + ((u >> 16) & 1u)) >> 16; }
__host__ __device__ __forceinline__ float bf2f(unsigned h) { return __builtin_bit_cast(float, (h & 0xffffu) << 16); }
__host__ __device__ __forceinline__ unsigned pk2(float lo, float hi) { return f2bf(lo) | (f2bf(hi) << 16); }

__host__ __device__ __forceinline__ int kperm(int a) { return (a & ~31) | ((a & 12) << 1) | ((a & 16) >> 2) | (a & 3); }
__host__ __device__ __forceinline__ int offA(int row, int col) { const int p = kperm(col); return row * 128 + ((((p >> 3) ^ (row & 15)) << 3) | (p & 7)); }
__host__ __device__ __forceinline__ int offT(int row, int col) { const int p = kperm(col); return row * 64 + ((((p >> 3) ^ ((row >> 1) & 7)) << 3) | (p & 7)); }
__host__ __device__ __forceinline__ int offU(int c, int dv) { return (((dv >> 4) * 4 + (c >> 4)) * 64 + ((c >> 2) & 3) * 16 + (dv & 15)) * 4 + (c & 3); }
constexpr int BLOB = 64 * 128;
constexpr int QKBLOB = 64 * 64;
constexpr int TABW = 192;
namespace pg8 {
#define PG8_LAS __attribute__((address_space(3)))
typedef unsigned short bf16_t;
typedef short bf16x8 __attribute__((ext_vector_type(8)));
typedef float f32x4 __attribute__((ext_vector_type(4)));
typedef unsigned u32x4 __attribute__((ext_vector_type(4)));
constexpr int BM = 256, BK = 64, HALF = 128, HTB = HALF * BK * 2  , STAGE_BYTES = 8 * HTB, NXCD = 8, WGM = 8;

__host__ __device__ __forceinline__ int lds_byte(int r, int c) { const int st = (r >> 4) * 2 + (c >> 5), rr = r & 15, cc = c & 31, ob = rr * 64 + cc * 2; return st * 1024 + (ob ^ (((ob >> 9) & 1) << 5)); }
__host__ __device__ __forceinline__ void stage_rc(int b, int& R, int& C) { const int st = b / 1024, sb = b % 1024, swz = sb ^ (((sb >> 9) & 1) << 5); R = (st >> 1) * 16 + swz / 64; C = (st & 1) * 32 + (swz % 64) / 2; }
__host__ __device__ __forceinline__ int perm32(int rho) { const int n = rho >> 4, i = rho & 15; return 8 * (i >> 2) + 4 * n + (i & 3); }

struct Unit { int pm, pn; };
struct Gemm { const bf16_t* A; const bf16_t* Bt; int M, N, K, pad; };

struct StaticOrder {
    int nM, nN, nwg, G, c;
    __host__ __device__ void init(int M, int N, int G_, int c_) { nM = M / BM; nN = N / BM; nwg = nM * nN; G = G_; c = c_; }
    __host__ __device__ bool next(int i, Unit& u) const {
        const long L = (long)i * G + c; if (L >= nwg) return false;
        int wgid = (int)L; { const int q = nwg / NXCD, r = nwg % NXCD, xcd = wgid % NXCD, off = wgid / NXCD; wgid = (xcd < r ? xcd * (q + 1) : r * (q + 1) + (xcd - r) * q) + off; }
        const int nig = WGM * nN, gid = wgid / nig, fm = gid * WGM, gsz = (nM - fm) < WGM ? (nM - fm) : WGM;
        u.pm = fm + ((wgid % nig) % gsz); u.pn = (wgid % nig) / gsz; return true;
    }
    __device__ __forceinline__ void a_ready(const Unit&) const {}
    __device__ __forceinline__ void done(const Unit&) const {}
};

__device__ __forceinline__ unsigned cvt_pk_bf16(float lo, float hi) { unsigned r; asm volatile("v_cvt_pk_bf16_f32 %0, %1, %2" : "=v"(r) : "v"(lo), "v"(hi)); return r; }
typedef float f32x2 __attribute__((ext_vector_type(2)));
__device__ __forceinline__ f32x2 gelu_pk(f32x2 v) {
    const f32x2 av = __builtin_elementwise_abs(v), d = av * 0.2316418882f + 1.0f;
    f32x2 t; t.x = __builtin_amdgcn_rcpf(d.x); t.y = __builtin_amdgcn_rcpf(d.y);
    f32x2 q = t * 0.5307027145f + (-0.7265760135f); q = q * t + 0.7107068705f; q = q * t + (-0.142248368f); q = q * t + 0.127414796f; q = q * t;
    const f32x2 s = (v * v) * (-0.72134752044f);
    f32x2 e; e.x = __builtin_amdgcn_exp2f(s.x); e.y = __builtin_amdgcn_exp2f(s.y);
    const f32x2 m = v * (q * e), r = v - m;
    f32x2 o; o.x = v.x < 0.f ? m.x : r.x; o.y = v.y < 0.f ? m.y : r.y; return o;
}

template <int ACT  > struct EpiBf16 {
    static constexpr bool PERM = true, AFTER_DRAIN = false; static_assert(ACT == 0 || ACT == 1, "EpiBf16: ACT is 0 (none) or 1 (gelu_pk)");
    bf16_t* O; int ldc; const float* bias; int split_cols; size_t split_stride; float scale0;
    __device__ __forceinline__ void operator()(const f32x4 (&acc)[2][2][4][2], const Unit& u, int wr, int wc, int fr, int fq) const {
        const int row0 = u.pm * BM + wr * 64 + fr; int colt = u.pn * BM; bf16_t* base = O;
        float sc = 1.f; if (split_cols) { const int t = colt / split_cols; base += (size_t)t * split_stride; colt -= t * split_cols; if (t == 0) sc = scale0; }
        const int col0 = colt + wc * 32 + 8 * fq, bcol0 = u.pn * BM + wc * 32 + 8 * fq;
        f32x4 bv[2][2];
#pragma unroll
        for (int bj = 0; bj < 2; ++bj)
#pragma unroll
            for (int n = 0; n < 2; ++n) bv[bj][n] = bias ? *(const f32x4*)(bias + bcol0 + bj * HALF + 4 * n) : (f32x4){0.f, 0.f, 0.f, 0.f};
#pragma unroll
        for (int ai = 0; ai < 2; ++ai)
#pragma unroll
            for (int m = 0; m < 4; ++m) { bf16_t* rowp = base + (size_t)(row0 + ai * HALF + m * 16) * ldc + col0;
#pragma unroll
                for (int bj = 0; bj < 2; ++bj) { f32x4 v0 = acc[ai][bj][m][0] + bv[bj][0], v1 = acc[ai][bj][m][1] + bv[bj][1];
                    if (ACT == 1) { f32x2 a = gelu_pk((f32x2){v0[0], v0[1]}), b = gelu_pk((f32x2){v0[2], v0[3]}), c = gelu_pk((f32x2){v1[0], v1[1]}), d = gelu_pk((f32x2){v1[2], v1[3]});
                        v0 = (f32x4){a.x, a.y, b.x, b.y}; v1 = (f32x4){c.x, c.y, d.x, d.y}; }
                    v0 = v0 * sc; v1 = v1 * sc; u32x4 w; w.x = cvt_pk_bf16(v0[0], v0[1]); w.y = cvt_pk_bf16(v0[2], v0[3]); w.z = cvt_pk_bf16(v1[0], v1[1]); w.w = cvt_pk_bf16(v1[2], v1[3]);
                    *(u32x4*)(rowp + bj * HALF) = w; } }
    }
};

struct PanelStats {
    unsigned* xbuf;
    unsigned* cnt;
    unsigned* tmo;
    int ntn; float eps;
    unsigned code;
    __device__ __forceinline__ bool run(const f32x4 (&v)[2][2][4][2], const Unit& u, int wr, int wc, int fr, int fq, PG8_LAS unsigned char* lds, int wid, int lane) const {
        typedef float f32x2v __attribute__((ext_vector_type(2)));
        PG8_LAS f32x2v* P = (PG8_LAS f32x2v*)lds;
        PG8_LAS f32x2v* S = (PG8_LAS f32x2v*)(lds + 8192);
        PG8_LAS unsigned* flag = (PG8_LAS unsigned*)(lds + 8192 + 2048);
#pragma unroll
        for (int ai = 0; ai < 2; ++ai)
#pragma unroll
            for (int m = 0; m < 4; ++m) {
                float s = 0.f;
#pragma unroll
                for (int bj = 0; bj < 2; ++bj)
#pragma unroll
                    for (int n = 0; n < 2; ++n) { const f32x4 x = v[ai][bj][m][n]; s += (x[0] + x[1]) + (x[2] + x[3]); }
                s += __shfl_xor(s, 16); s += __shfl_xor(s, 32);
                const float mw = s * (1.0f / 64.0f); float q = 0.f;
#pragma unroll
                for (int bj = 0; bj < 2; ++bj)
#pragma unroll
                    for (int n = 0; n < 2; ++n) { const f32x4 d = v[ai][bj][m][n] - mw; q += (d[0] * d[0] + d[1] * d[1]) + (d[2] * d[2] + d[3] * d[3]); }
                q += __shfl_xor(q, 16); q += __shfl_xor(q, 32);
                if (fq == 0) P[(ai * HALF + wr * 64 + m * 16 + fr) * 4 + wc] = (f32x2v){mw, q};
            }
        asm volatile("s_waitcnt lgkmcnt(0)" ::: "memory"); __builtin_amdgcn_s_barrier(); asm volatile("" ::: "memory");
#if defined(BROKEN_EXCHANGE_NO_WAIT)
#warning BROKEN CONTROL BUILD: the row-statistics exchange does not wait; results are wrong by design
        if (blockIdx.x >= 64) { const long long t0_ = clock64(); while (clock64() - t0_ < 60000) __builtin_amdgcn_s_sleep(8); }
#endif
        const int row = wid * 32 + (lane & 31);
        if (lane < 32) {
            const f32x2v a = P[row * 4 + 0], b = P[row * 4 + 1], c = P[row * 4 + 2], d = P[row * 4 + 3];
            const float mt = (a.x + b.x + c.x + d.x) * 0.25f;
            const float da = a.x - mt, db = b.x - mt, dc = c.x - mt, dd = d.x - mt;
            const float m2 = (a.y + b.y) + (c.y + d.y) + 64.0f * ((da * da + db * db) + (dc * dc + dd * dd));
            unsigned long long* slot = (unsigned long long*)xbuf + ((size_t)(u.pm * BM + row) * 4 + u.pn);
            __hip_atomic_store(slot, ((unsigned long long)__float_as_uint(m2) << 32) | __float_as_uint(mt), __ATOMIC_RELAXED, __HIP_MEMORY_SCOPE_AGENT);
        }
        asm volatile("s_waitcnt vmcnt(0)" ::: "memory");
        if (lane == 0) __hip_atomic_fetch_add(cnt + 64 * u.pm, 1u, __ATOMIC_RELAXED, __HIP_MEMORY_SCOPE_AGENT);
        if (wid == 0) {
            bool dead = false; const unsigned long long t0 = __builtin_amdgcn_s_memrealtime(); const unsigned want = 8u * (unsigned)ntn;
            for (;;) {
#if defined(BROKEN_EXCHANGE_NO_WAIT)
                break;
#endif
                if ((unsigned)__builtin_amdgcn_readfirstlane(__hip_atomic_load(cnt + 64 * u.pm, __ATOMIC_RELAXED, __HIP_MEMORY_SCOPE_AGENT)) >= want) break;
                if (__builtin_amdgcn_s_memrealtime() - t0 > 2000000ull) {
                    if (lane == 0) { unsigned expect = 0u; __hip_atomic_compare_exchange_strong(tmo + 1, &expect, code | (unsigned)(u.pm & 0xff), __ATOMIC_RELAXED, __ATOMIC_RELAXED, __HIP_MEMORY_SCOPE_AGENT);
                                     __hip_atomic_store(tmo, 1u, __ATOMIC_RELAXED, __HIP_MEMORY_SCOPE_AGENT); }
                    dead = true; break; }
                __builtin_amdgcn_s_sleep(2);
            }
            __builtin_amdgcn_fence(__ATOMIC_ACQUIRE, "agent");
            if (lane == 0) flag[0] = dead ? 1u : 0u;
        }
        asm volatile("s_waitcnt vmcnt(0) lgkmcnt(0)" ::: "memory"); __builtin_amdgcn_s_barrier(); asm volatile("" ::: "memory");
        const bool bad = flag[0] != 0u;
        if (lane < 32) {
            const unsigned long long* slot = (const unsigned long long*)xbuf + (size_t)(u.pm * BM + row) * 4; float mt[4], m2[4]; float ms = 0.f;
#pragma unroll
            for (int t = 0; t < 4; ++t) { if (t < ntn) { const unsigned long long w = __hip_atomic_load(slot + t, __ATOMIC_RELAXED, __HIP_MEMORY_SCOPE_AGENT); mt[t] = __uint_as_float((unsigned)w); m2[t] = __uint_as_float((unsigned)(w >> 32)); } else { mt[t] = 0.f; m2[t] = 0.f; } ms += mt[t]; }
            const float mean = ms / (float)ntn; float q = 0.f;
#pragma unroll
            for (int t = 0; t < 4; ++t) if (t < ntn) { const float dm = mt[t] - mean; q += m2[t] + 256.0f * dm * dm; }
            S[row] = (f32x2v){mean, 1.0f / sqrtf(q / (256.0f * (float)ntn) + eps)};
        }
        asm volatile("s_waitcnt lgkmcnt(0)" ::: "memory"); __builtin_amdgcn_s_barrier(); asm volatile("" ::: "memory");
        return bad;
    }
};
struct EpiLnRes {
    static constexpr bool PERM = false, AFTER_DRAIN = true;
    const float* base; float* out; int ldc; const float* bias; PanelStats st; unsigned poison;
    __device__ __forceinline__ void fused(f32x4 (&acc)[2][2][4][2], const Unit& u, int wr, int wc, int fr, int fq, PG8_LAS unsigned char* lds, int wid, int lane) const {
        typedef float f32x2v __attribute__((ext_vector_type(2)));
        const PG8_LAS f32x2v* S = (const PG8_LAS f32x2v*)(lds + 8192);
        const int col0 = u.pn * BM + wc * 32 + 4 * fq;
#pragma unroll
        for (int bj = 0; bj < 2; ++bj)
#pragma unroll
            for (int n = 0; n < 2; ++n) { const f32x4 bv = bias ? *(const f32x4*)(bias + col0 + bj * HALF + n * 16) : (f32x4){0.f, 0.f, 0.f, 0.f};
#pragma unroll
                for (int ai = 0; ai < 2; ++ai)
#pragma unroll
                    for (int m = 0; m < 4; ++m) acc[ai][bj][m][n] += bv; }
        f32x4 pre[4][2][2];
#pragma unroll
        for (int m = 0; m < 4; ++m) { const size_t off = (size_t)(u.pm * BM + wr * 64 + m * 16 + fr) * ldc + col0;
#pragma unroll
            for (int bj = 0; bj < 2; ++bj)
#pragma unroll
                for (int n = 0; n < 2; ++n) pre[m][bj][n] = *(const f32x4*)(base + off + bj * HALF + n * 16); }
        const bool bad = st.run(acc, u, wr, wc, fr, fq, lds, wid, lane) || poison != 0u;
        const float qnan = __builtin_nanf("");
#pragma unroll
        for (int ai = 0; ai < 2; ++ai)
#pragma unroll
            for (int m = 0; m < 4; ++m) { const int r = ai * HALF + wr * 64 + m * 16 + fr; const f32x2v sr = S[r]; const size_t off = (size_t)(u.pm * BM + r) * ldc + col0;
#pragma unroll
                for (int bj = 0; bj < 2; ++bj)
#pragma unroll
                    for (int n = 0; n < 2; ++n) { const f32x4 bs = ai == 0 ? pre[m][bj][n] : *(const f32x4*)(base + off + bj * HALF + n * 16); f32x4 o = bs + (acc[ai][bj][m][n] - sr.x) * sr.y;
                        if (bad) o = (f32x4){qnan, qnan, qnan, qnan}; *(f32x4*)(out + off + bj * HALF + n * 16) = o; }
                if (m & 1) asm volatile("" ::: "memory"); }
    }
};
struct EpiLnResLn {
    static constexpr bool PERM = false, AFTER_DRAIN = true;
    const float* base; float* out; bf16_t* xn; int ldc; const float* bias; PanelStats st1, st2; unsigned poison;
    __device__ __forceinline__ void fused(f32x4 (&acc)[2][2][4][2], const Unit& u, int wr, int wc, int fr, int fq, PG8_LAS unsigned char* lds, int wid, int lane) const {
        typedef float f32x2v __attribute__((ext_vector_type(2))); typedef unsigned u32x2v __attribute__((ext_vector_type(2)));
        const PG8_LAS f32x2v* S = (const PG8_LAS f32x2v*)(lds + 8192);
        const int col0 = u.pn * BM + wc * 32 + 4 * fq;
#pragma unroll
        for (int bj = 0; bj < 2; ++bj)
#pragma unroll
            for (int n = 0; n < 2; ++n) { const f32x4 bv = bias ? *(const f32x4*)(bias + col0 + bj * HALF + n * 16) : (f32x4){0.f, 0.f, 0.f, 0.f};
#pragma unroll
                for (int ai = 0; ai < 2; ++ai)
#pragma unroll
                    for (int m = 0; m < 4; ++m) acc[ai][bj][m][n] += bv; }
        bool bad = st1.run(acc, u, wr, wc, fr, fq, lds, wid, lane) || poison != 0u;
        const float qnan = __builtin_nanf("");
#pragma unroll
        for (int ai = 0; ai < 2; ++ai)
#pragma unroll
            for (int m = 0; m < 4; ++m) { const int r = ai * HALF + wr * 64 + m * 16 + fr; const f32x2v sr = S[r]; const size_t off = (size_t)(u.pm * BM + r) * ldc + col0;
#pragma unroll
                for (int bj = 0; bj < 2; ++bj)
#pragma unroll
                    for (int n = 0; n < 2; ++n) { const f32x4 bs = *(const f32x4*)(base + off + bj * HALF + n * 16); acc[ai][bj][m][n] = bs + (acc[ai][bj][m][n] - sr.x) * sr.y; }
                asm volatile("" : "+v"(acc[ai][0][m][0]), "+v"(acc[ai][0][m][1]), "+v"(acc[ai][1][m][0]), "+v"(acc[ai][1][m][1]));
                if (m & 1) asm volatile("" ::: "memory"); }
        const bool bad1 = bad;
        bad = st2.run(acc, u, wr, wc, fr, fq, lds, wid, lane) || bad;
#pragma unroll
        for (int ai = 0; ai < 2; ++ai)
#pragma unroll
            for (int m = 0; m < 4; ++m) { const int r = ai * HALF + wr * 64 + m * 16 + fr; const f32x2v sr = S[r]; const size_t off = (size_t)(u.pm * BM + r) * ldc + col0;
#pragma unroll
                for (int bj = 0; bj < 2; ++bj)
#pragma unroll
                    for (int n = 0; n < 2; ++n) { const f32x4 x1 = acc[ai][bj][m][n]; *(f32x4*)(out + off + bj * HALF + n * 16) = bad1 ? (f32x4){qnan, qnan, qnan, qnan} : x1;
                        const f32x4 o = (x1 - sr.x) * sr.y; u32x2v w; w.x = cvt_pk_bf16(o[0], o[1]); w.y = cvt_pk_bf16(o[2], o[3]);
                        if (bad) { w.x = 0x7fc07fc0u; w.y = 0x7fc07fc0u; } *(u32x2v*)(xn + off + bj * HALF + n * 16) = w; }
                asm volatile("" ::: "memory"); }
    }
};

template <class Epi, class Sched, bool ALIGN_EPI = false, bool SP2 = false>
__device__ __forceinline__ void gemm_phase(PG8_LAS unsigned char* lds, const Gemm g, const Sched& S, const Epi& E) {
    const int tid = threadIdx.x, wid = __builtin_amdgcn_readfirstlane(tid >> 6), lane = tid & 63, wr = wid >> 2, wc = wid & 3, fr = lane & 15, fq = lane >> 4;
    const int K = g.K, nt = K / BK;
    unsigned voffA[2], voffB[2];
#pragma unroll
    for (int i = 0; i < 2; ++i) { int R, C; stage_rc(tid * 16 + i * 8192, R, C); const int Rb = Epi::PERM ? ((R & ~31) + perm32(R & 31)) : R;
        voffA[i] = (unsigned)(R * K + C) * 2u; voffB[i] = (unsigned)(Rb * K + C) * 2u; }
    const size_t kstep = (size_t)(BK * 2);
    const size_t hstep = (size_t)HALF * K * 2;
    const size_t tstep = 2 * hstep;
    const unsigned ldsw = (unsigned)wid * 1024u;
    const int aoff = lds_byte(wr * 64 + fr, fq * 8), boff = lds_byte(wc * 32 + fr, fq * 8);
#define PG8_SA(b, h) (((b) * 2 + (h)) * HTB)
#define PG8_SB(b, h) ((4 + (b) * 2 + (h)) * HTB)
#define PG8_STAGE(bufoff, gbase, voff) do { _Pragma("unroll") for (int _i = 0; _i < 2; ++_i) \
        __builtin_amdgcn_global_load_lds((const unsigned*)((const char*)(gbase) + (voff)[_i]), (PG8_LAS unsigned*)(lds + (bufoff) + ldsw + _i * 8192), 16, 0, 0); } while (0)
#define PG8_LDA(dst, b, h) do { _Pragma("unroll") for (int m = 0; m < 4; ++m) _Pragma("unroll") for (int k = 0; k < 2; ++k) dst[m][k] = *(const PG8_LAS bf16x8*)(lds + PG8_SA(b, h) + aoff + m * 2048 + k * 1024); } while (0)
#define PG8_LDB(dst, b, h) do { _Pragma("unroll") for (int n = 0; n < 2; ++n) _Pragma("unroll") for (int k = 0; k < 2; ++k) dst[n][k] = *(const PG8_LAS bf16x8*)(lds + PG8_SB(b, h) + boff + n * 2048 + k * 1024); } while (0)
#define PG8_MMA(ai, bj, At, Bt) do { __builtin_amdgcn_s_setprio(1); _Pragma("unroll") for (int m = 0; m < 4; ++m) _Pragma("unroll") for (int n = 0; n < 2; ++n) _Pragma("unroll") for (int k = 0; k < 2; ++k) \
        acc[ai][bj][m][n] = __builtin_amdgcn_mfma_f32_16x16x32_bf16(Bt[n][k], At[m][k], acc[ai][bj][m][n], 0, 0, 0); __builtin_amdgcn_s_setprio(0); } while (0)
#define PG8_WAIT_V(n) asm volatile("s_waitcnt vmcnt(" #n ")" ::: "memory")
#define PG8_WAIT_L(n) asm volatile("s_waitcnt lgkmcnt(" #n ")" ::: "memory")
#define PG8_BAR __builtin_amdgcn_s_barrier()
#define PG8_SCHED __builtin_amdgcn_sched_barrier(0)
    Unit cur, nxt; int ui = 0;
    if (!S.next(0, cur)) return;
    f32x4 acc[2][2][4][2];
#pragma unroll
    for (int a = 0; a < 2; ++a)
#pragma unroll
        for (int b = 0; b < 2; ++b)
#pragma unroll
            for (int m = 0; m < 4; ++m)
#pragma unroll
                for (int n = 0; n < 2; ++n) acc[a][b][m][n] = (f32x4){0.f, 0.f, 0.f, 0.f};
    bf16x8 At[4][2], B0[2][2], B1[2][2];
    const char* cA = (const char*)g.A + (size_t)cur.pm * tstep; const char* cB = (const char*)g.Bt + (size_t)cur.pn * tstep;
    S.a_ready(cur);
    if constexpr (SP2) {
        PG8_STAGE(PG8_SB(0, 0), cB, voffB); PG8_STAGE(PG8_SB(0, 1), cB + hstep, voffB); PG8_STAGE(PG8_SA(0, 0), cA, voffA); PG8_STAGE(PG8_SA(0, 1), cA + hstep, voffA);
        if (wr == 1) PG8_BAR;
        PG8_WAIT_V(2); PG8_BAR;
        PG8_STAGE(PG8_SB(1, 0), cB + kstep, voffB); PG8_STAGE(PG8_SA(1, 0), cA + kstep, voffA); PG8_STAGE(PG8_SB(1, 1), cB + hstep + kstep, voffB);
        PG8_WAIT_V(6); PG8_BAR;
    } else {
        PG8_STAGE(PG8_SB(0, 0), cB, voffB); PG8_STAGE(PG8_SA(0, 0), cA, voffA); PG8_STAGE(PG8_SB(0, 1), cB + hstep, voffB); PG8_STAGE(PG8_SA(0, 1), cA + hstep, voffA);
        if (wr == 1) PG8_BAR;
        PG8_WAIT_V(4); PG8_BAR;
        PG8_STAGE(PG8_SB(1, 0), cB + kstep, voffB); PG8_STAGE(PG8_SA(1, 0), cA + kstep, voffA); PG8_STAGE(PG8_SB(1, 1), cB + hstep + kstep, voffB);
        PG8_WAIT_V(6); PG8_BAR;
    }
    for (;;) {
        const bool has_next = S.next(ui + 1, nxt);
        const char* nA = has_next ? (const char*)g.A + (size_t)nxt.pm * tstep : cA; const char* nB = has_next ? (const char*)g.Bt + (size_t)nxt.pn * tstep : cB;
        for (int t = 0; t < nt; t += 2) {
            const bool last = (t == nt - 2);
            const char* a1 = cA + (size_t)(t + 1) * kstep;
            const char* a2 = last ? nA : cA + (size_t)(t + 2) * kstep; const char* b2 = last ? nB : cB + (size_t)(t + 2) * kstep;
            const char* a3 = a2 + kstep; const char* b3 = b2 + kstep;
            if (last && has_next) S.a_ready(nxt);
            if constexpr (SP2) {
            PG8_LDB(B0, 0, 0); PG8_LDB(B1, 0, 1); PG8_SCHED; PG8_LDA(At, 0, 0); PG8_STAGE(PG8_SA(1, 1), a1 + hstep, voffA);
            PG8_WAIT_V(8); PG8_WAIT_L(0); PG8_BAR; PG8_MMA(0, 0, At, B0); PG8_MMA(0, 1, At, B1); PG8_BAR; PG8_SCHED;
            PG8_LDA(At, 0, 1); PG8_STAGE(PG8_SB(0, 0), b2, voffB); PG8_STAGE(PG8_SB(0, 1), b2 + hstep, voffB); PG8_STAGE(PG8_SA(0, 0), a2, voffA);
            PG8_WAIT_V(8); PG8_WAIT_L(0); PG8_BAR; PG8_MMA(1, 0, At, B0); PG8_MMA(1, 1, At, B1); PG8_BAR; PG8_SCHED;
            PG8_LDB(B0, 1, 0); PG8_LDB(B1, 1, 1); PG8_SCHED; PG8_LDA(At, 1, 0); PG8_STAGE(PG8_SA(0, 1), a2 + hstep, voffA);
            PG8_WAIT_V(8); PG8_WAIT_L(0); PG8_BAR; PG8_MMA(0, 0, At, B0); PG8_MMA(0, 1, At, B1); PG8_BAR; PG8_SCHED;
            PG8_LDA(At, 1, 1); PG8_STAGE(PG8_SB(1, 0), b3, voffB); PG8_STAGE(PG8_SB(1, 1), b3 + hstep, voffB); PG8_STAGE(PG8_SA(1, 0), a3, voffA);
            PG8_WAIT_V(8); PG8_WAIT_L(0); PG8_BAR; PG8_MMA(1, 0, At, B0); PG8_MMA(1, 1, At, B1); PG8_BAR; PG8_SCHED;
            } else {
            PG8_LDB(B0, 0, 0); PG8_SCHED; PG8_LDA(At, 0, 0); PG8_STAGE(PG8_SA(1, 1), a1 + hstep, voffA);
            PG8_WAIT_L(8); PG8_BAR; PG8_WAIT_L(0); PG8_MMA(0, 0, At, B0); PG8_BAR; PG8_SCHED;
            PG8_LDB(B1, 0, 1); PG8_STAGE(PG8_SB(0, 0), b2, voffB);
            PG8_BAR; PG8_WAIT_L(0); PG8_MMA(0, 1, At, B1); PG8_BAR;
            PG8_LDA(At, 0, 1); PG8_STAGE(PG8_SA(0, 0), a2, voffA);
            PG8_BAR; PG8_WAIT_L(0); PG8_MMA(1, 0, At, B0); PG8_BAR; PG8_SCHED;
            PG8_STAGE(PG8_SB(0, 1), b2 + hstep, voffB);
            PG8_WAIT_V(6); PG8_BAR; PG8_MMA(1, 1, At, B1); PG8_BAR;
            PG8_LDB(B0, 1, 0); PG8_SCHED; PG8_LDA(At, 1, 0); PG8_STAGE(PG8_SA(0, 1), a2 + hstep, voffA);
            PG8_WAIT_L(8); PG8_BAR; PG8_WAIT_L(0); PG8_MMA(0, 0, At, B0); PG8_BAR; PG8_SCHED;
            PG8_LDB(B1, 1, 1); PG8_STAGE(PG8_SB(1, 0), b3, voffB);
            PG8_BAR; PG8_WAIT_L(0); PG8_MMA(0, 1, At, B1); PG8_BAR;
            PG8_LDA(At, 1, 1); PG8_STAGE(PG8_SA(1, 0), a3, voffA);
            PG8_BAR; PG8_WAIT_L(0); PG8_MMA(1, 0, At, B0); PG8_BAR; PG8_SCHED;
            PG8_STAGE(PG8_SB(1, 1), b3 + hstep, voffB);
            PG8_WAIT_V(6); PG8_BAR; PG8_MMA(1, 1, At, B1); PG8_BAR;
            }
        }
        if constexpr (ALIGN_EPI) { if (wr == 0) PG8_BAR; }
        if constexpr (!Epi::AFTER_DRAIN) { E(acc, cur, wr, wc, fr, fq); S.done(cur); }
        if (!has_next) break;
#pragma unroll
        for (int a = 0; a < 2; ++a)
#pragma unroll
            for (int b = 0; b < 2; ++b)
#pragma unroll
                for (int m = 0; m < 4; ++m)
#pragma unroll
                    for (int n = 0; n < 2; ++n) acc[a][b][m][n] = (f32x4){0.f, 0.f, 0.f, 0.f};
        cur = nxt; cA = nA; cB = nB; ++ui;
        if constexpr (ALIGN_EPI) { if (wr == 1) PG8_BAR; }
    }
    PG8_WAIT_V(0);
    if constexpr (!ALIGN_EPI) { if (wr == 0) PG8_BAR; }
    PG8_BAR;
    if constexpr (Epi::AFTER_DRAIN) { E.fused(acc, cur, wr, wc, fr, fq, lds, wid, lane); S.done(cur); }
#undef PG8_SA
#undef PG8_SB
#undef PG8_STAGE
#undef PG8_LDA
#undef PG8_LDB
#undef PG8_MMA
#undef PG8_WAIT_V
#undef PG8_WAIT_L
#undef PG8_BAR
#undef PG8_SCHED
}
}
namespace pg8 {
struct EpiProj {
    static constexpr bool PERM = true, AFTER_DRAIN = false;
    bf16_t *QC, *KV, *QKVG, *Z;
    __device__ __forceinline__ void operator()(const f32x4 (&acc)[2][2][4][2], const Unit& u, int wr, int wc, int fr, int fq) const {
        const int pn = u.pn; bf16_t* base; int ldc, colt;
        if (pn < 2) { base = QC; ldc = 1024; colt = pn * 256; }
        else if (pn == 2) { base = KV; ldc = 256; colt = 0; }
        else if (pn < 9) { base = QKVG; ldc = 1536; colt = (pn - 3) * 256; }
        else { base = Z; ldc = 512; colt = (pn - 9) * 256; }
        const int row0 = u.pm * BM + wr * 64 + fr, col0 = colt + wc * 32 + 8 * fq;
#pragma unroll
        for (int ai = 0; ai < 2; ++ai)
#pragma unroll
            for (int m = 0; m < 4; ++m) { bf16_t* rowp = base + (size_t)(row0 + ai * HALF + m * 16) * ldc + col0;
#pragma unroll
                for (int bj = 0; bj < 2; ++bj) { const f32x4 v0 = acc[ai][bj][m][0], v1 = acc[ai][bj][m][1];
                    u32x4 w; w.x = cvt_pk_bf16(v0[0], v0[1]); w.y = cvt_pk_bf16(v0[2], v0[3]); w.z = cvt_pk_bf16(v1[0], v1[1]); w.w = cvt_pk_bf16(v1[2], v1[3]);
                    *(u32x4*)(rowp + bj * HALF) = w; } }
    }
};
struct EpiRes {
    static constexpr bool PERM = false, AFTER_DRAIN = false;
    const float* base; float* H; bf16_t* HB; float* SSQ;
    __device__ __forceinline__ void operator()(const f32x4 (&acc)[2][2][4][2], const Unit& u, int wr, int wc, int fr, int fq) const {
        typedef unsigned u32x2v __attribute__((ext_vector_type(2)));
        const int col0 = u.pn * BM + wc * 32 + 4 * fq;
#pragma unroll
        for (int ai = 0; ai < 2; ++ai)
#pragma unroll
            for (int m = 0; m < 4; ++m) { const int row = u.pm * BM + ai * HALF + wr * 64 + m * 16 + fr; const size_t off = (size_t)row * 1024 + col0; float ss = 0.f;
#pragma unroll
                for (int bj = 0; bj < 2; ++bj)
#pragma unroll
                    for (int n = 0; n < 2; ++n) { const f32x4 bs = *(const f32x4*)(base + off + bj * HALF + n * 16); const f32x4 hv = bs + acc[ai][bj][m][n];
                        *(f32x4*)(H + off + bj * HALF + n * 16) = hv; ss += (hv[0] * hv[0] + hv[1] * hv[1]) + (hv[2] * hv[2] + hv[3] * hv[3]);
                        if (HB) { u32x2v w; w.x = cvt_pk_bf16(hv[0], hv[1]); w.y = cvt_pk_bf16(hv[2], hv[3]); *(u32x2v*)(HB + off + bj * HALF + n * 16) = w; } }
                ss += __shfl_xor(ss, 16); ss += __shfl_xor(ss, 32);
                if (fq == 0) SSQ[(size_t)row * 16 + u.pn * 4 + wc] = ss; }
    }
};
struct EpiFfn1 {
    static constexpr bool PERM = true, AFTER_DRAIN = false;
    bf16_t* ACT; const float* SSQ;
    __device__ __forceinline__ void operator()(const f32x4 (&acc)[2][2][4][2], const Unit& u, int wr, int wc, int fr, int fq) const {
        const int row0 = u.pm * BM + wr * 64 + fr, col0 = u.pn * BM + wc * 32 + 8 * fq;
#pragma unroll
        for (int ai = 0; ai < 2; ++ai)
#pragma unroll
            for (int m = 0; m < 4; ++m) { const int row = row0 + ai * HALF + m * 16; const f32x4* sp = (const f32x4*)(SSQ + (size_t)row * 16);
                const f32x4 s0 = sp[0], s1 = sp[1], s2 = sp[2], s3 = sp[3]; const f32x4 st = (s0 + s1) + (s2 + s3);
                const float r = rsqrtf(((st[0] + st[1]) + (st[2] + st[3])) * (1.f / 1024.f) + 1e-6f);
                bf16_t* rowp = ACT + (size_t)row * 4096 + col0;
#pragma unroll
                for (int bj = 0; bj < 2; ++bj) { f32x4 v0 = acc[ai][bj][m][0] * r, v1 = acc[ai][bj][m][1] * r;
#pragma unroll
                    for (int e = 0; e < 4; ++e) { const float a = fmaxf(v0[e], 0.f), b = fmaxf(v1[e], 0.f); v0[e] = a * a; v1[e] = b * b; }
                    u32x4 w; w.x = cvt_pk_bf16(v0[0], v0[1]); w.y = cvt_pk_bf16(v0[2], v0[3]); w.z = cvt_pk_bf16(v1[0], v1[1]); w.w = cvt_pk_bf16(v1[2], v1[3]);
                    *(u32x4*)(rowp + bj * HALF) = w; } }
    }
};
}

constexpr int GEMM_LDS = 131072;
template <class Epi, bool ALIGN>
__global__ void __launch_bounds__(512, 2) k_gemm(pg8::Gemm g, Epi e) {
    extern __shared__ __attribute__((aligned(16))) unsigned char lds_g[];
    pg8::StaticOrder S; S.init(g.M, g.N, (int)gridDim.x, (int)blockIdx.x);
    pg8::gemm_phase<Epi, pg8::StaticOrder, ALIGN, true>((PG8_LAS unsigned char*)lds_g, g, S, e);
}
#define GAS __attribute__((address_space(1)))
typedef float f32x4 __attribute__((ext_vector_type(4)));

__global__ void k_wt(const float* __restrict__ W, int K, int ldw, int col0, int N, const float* __restrict__ kscale, bf16_t* __restrict__ WT) {
    __shared__ float tile[32][33];
    const int n0 = blockIdx.x * 32, k0 = blockIdx.y * 32, tx = threadIdx.x & 31, ty = threadIdx.x >> 5;
    for (int i = ty; i < 32; i += 8) { const int k = k0 + i; float v = W[(size_t)k * ldw + col0 + n0 + tx]; if (kscale) v *= kscale[k]; tile[i][tx] = v; }
    __syncthreads();
    for (int i = ty; i < 32; i += 8) WT[(size_t)(n0 + i) * K + k0 + tx] = (bf16_t)f2bf(tile[tx][i]);
}

__global__ void k_p0_rows(const float* __restrict__ x, const float* __restrict__ nw, const float* __restrict__ w_in, bf16_t* __restrict__ XN, float* __restrict__ GATES) {
    __shared__ float xs[DM]; __shared__ float red[256];
    const int m = blockIdx.x, t = threadIdx.x;
    float v[4], ss = 0.f;
    for (int i = 0; i < 4; ++i) { v[i] = x[(size_t)m * DM + t + 256 * i]; ss += v[i] * v[i]; }
    red[t] = ss; __syncthreads();
    for (int s = 128; s > 0; s >>= 1) { if (t < s) red[t] += red[t + s]; __syncthreads(); }
    const float r = rsqrtf(red[0] * (1.f / DM) + EPS);
    for (int i = 0; i < 4; ++i) { const int k = t + 256 * i; const float xn = v[i] * r * nw[k]; xs[k] = xn; XN[(size_t)m * DM + k] = (bf16_t)f2bf(xn); }
    __syncthreads();
    const int j = t >> 4, l = t & 15; float acc = 0.f;
    for (int k = l; k < DM; k += 16) acc += xs[k] * w_in[(size_t)k * DIN + NPROJ + j];
    for (int o = 8; o > 0; o >>= 1) acc += __shfl_xor(acc, o);
    if (l == 0) GATES[(size_t)m * 16 + j] = acc;
}

__global__ void k_p2a(const bf16_t* __restrict__ QKVG, const float* __restrict__ conv_w, bf16_t* __restrict__ QHAT, bf16_t* __restrict__ KHAT, bf16_t* __restrict__ KHT, bf16_t* __restrict__ VHT) {
    __shared__ float red[128];
    const int m = blockIdx.x, h = blockIdx.y, d = threadIdx.x, b = m / SEQ, t = m % SEQ, n = t / CHUNK, c = t % CHUNK;
    const size_t u = (size_t)((b * GH + h) * NCH + n);
    float s[3];
    for (int which = 0; which < 3; ++which) {
        const int ch = which * 512 + h * GD + d; float y = 0.f;
        for (int j = 0; j < CONVK; ++j) { const int tt = t - 2 + j; if (tt >= 0 && tt < SEQ) y += bf2f(QKVG[(size_t)(b * SEQ + tt) * 1536 + ch]) * conv_w[j * 1536 + ch]; }
        s[which] = y / (1.f + __expf(-y));
    }
    for (int which = 0; which < 2; ++which) {
        red[d] = s[which] * s[which]; __syncthreads();
        for (int st = 64; st > 0; st >>= 1) { if (d < st) red[d] += red[d + st]; __syncthreads(); }
        const float r = rsqrtf(red[0] + EPS); __syncthreads();
        s[which] *= r;
    }
    s[0] *= 0.08838834764831845f;
    QHAT[u * BLOB + offA(c, d)] = (bf16_t)f2bf(s[0]);
    KHAT[u * BLOB + offA(c, d)] = (bf16_t)f2bf(s[1]);
    KHT[u * BLOB + offT(d, c)] = (bf16_t)f2bf(s[1]);
    VHT[u * BLOB + offT(d, c)] = (bf16_t)f2bf(s[2]);
}

__global__ void k_p2b_ref(const bf16_t* __restrict__ QHAT, const bf16_t* __restrict__ KHAT, const bf16_t* __restrict__ VHT, const float* __restrict__ GATES,
                          const float* __restrict__ a_log, const float* __restrict__ dt_bias, bf16_t* __restrict__ Wb, bf16_t* __restrict__ Ub, bf16_t* __restrict__ QKb, float* __restrict__ TAB) {
    extern __shared__ float sm[];
    float* kf = sm;
    float* xf = kf + 64 * 129;
    float* A = xf + 64 * 129;
    float* T = A + 64 * 65;
    float* gc = T + 64 * 65;
    float* bet = gc + 64;
    float* gg = bet + 64;
    const int ud = blockIdx.x, u = ud >> 1, dir = ud & 1, p = threadIdx.x, c = dir ? 63 - p : p;
    const int n = u % NCH, bh = u / NCH, h = bh % GH, b = bh / GH;
    const int m = b * SEQ + n * CHUNK + c;
    {
        const float a = GATES[(size_t)m * 16 + dir * 4 + h], bb = GATES[(size_t)m * 16 + 8 + dir * 4 + h];
        const float z = a + dt_bias[dir * 4 + h];
        const float sp = (z > 20.f) ? z : log1pf(__expf(z));
        gg[p] = -__expf(a_log[dir * 4 + h]) * sp; bet[p] = 1.f / (1.f + __expf(-bb));
    }
    for (int d = 0; d < GD; ++d) kf[p * 129 + d] = bf2f(KHAT[(size_t)u * BLOB + offA(c, d)]);
    __syncthreads();
    { float s = 0.f; for (int j = 0; j <= p; ++j) s += gg[j]; gc[p] = s; }
    __syncthreads();
    for (int j = 0; j < 64; ++j) {
        float v = 0.f;
        if (j < p) { float dd = 0.f; for (int d = 0; d < GD; ++d) dd += kf[p * 129 + d] * kf[j * 129 + d]; v = bet[p] * dd * __expf(gc[p] - gc[j]); }
        A[p * 65 + j] = v;
    }
    __syncthreads();
    for (int j = 63; j >= 0; --j) {
        float acc = (j == p) ? 1.f : 0.f;
        if (j <= p) { for (int k = j + 1; k <= p; ++k) acc -= T[p * 65 + k] * A[k * 65 + j]; } else acc = 0.f;
        T[p * 65 + j] = acc;
    }
    for (int d = 0; d < GD; ++d) {
        float acc = 0.f;
        for (int j = 0; j <= p; ++j) acc += T[p * 65 + j] * bet[j] * __expf(gc[j]) * kf[j * 129 + d];
        Wb[(size_t)ud * BLOB + offA(c, d)] = (bf16_t)f2bf(-acc);
    }
    for (int d = 0; d < GD; ++d) xf[p * 129 + d] = bf2f(VHT[(size_t)u * BLOB + offT(d, c)]);
    __syncthreads();
    for (int d = 0; d < GD; ++d) {
        float acc = 0.f;
        for (int j = 0; j <= p; ++j) acc += T[p * 65 + j] * bet[j] * xf[j * 129 + d];
        Ub[(size_t)ud * BLOB + offU(c, d)] = (bf16_t)f2bf(acc);
    }
    __syncthreads();
    for (int d = 0; d < GD; ++d) xf[p * 129 + d] = bf2f(QHAT[(size_t)u * BLOB + offA(c, d)]);
    __syncthreads();
    for (int j = 0; j < 64; ++j) {
        float v = 0.f;
        if (j <= p) { float dd = 0.f; for (int d = 0; d < GD; ++d) dd += xf[p * 129 + d] * kf[j * 129 + d]; v = dd * __expf(gc[p] - gc[j]); }
        const int cj = dir ? 63 - j : j;
        QKb[(size_t)ud * QKBLOB + offT(c, cj)] = (bf16_t)f2bf(v);
    }
    TAB[(size_t)ud * TABW + c] = __expf(gc[p]);
    TAB[(size_t)ud * TABW + 64 + c] = __expf(gc[63] - gc[p]);
    if (p == 63) TAB[(size_t)ud * TABW + 128] = __expf(gc[63]);
}

__global__ void k_scan_ref(const bf16_t* __restrict__ QHAT, const bf16_t* __restrict__ KHT, const bf16_t* __restrict__ Wb, const bf16_t* __restrict__ Ub, const bf16_t* __restrict__ QKb,
                           const float* __restrict__ TAB, bf16_t* __restrict__ ODIR) {
    extern __shared__ float sm[];
    float* S = sm;
    float* vn = S + 128 * 128;
    float* Wl = vn + 64 * 128;
    float* Ql = Wl + 64 * 128;
    const int chain = blockIdx.x, dir = chain & 1, bh = chain >> 1, h = bh % GH, b = bh / GH, dv = threadIdx.x;
    for (int d = 0; d < 128; ++d) S[d * 128 + dv] = 0.f;
    for (int step = 0; step < NCH; ++step) {
        const int n = dir ? NCH - 1 - step : step; const size_t u = (size_t)bh * NCH + n, ud = u * 2 + dir;
        const float* tab = TAB + ud * TABW;
        __syncthreads();
        for (int i = dv; i < 64 * 128; i += 128) { const int c = i >> 7, d = i & 127; Wl[i] = bf2f(Wb[ud * BLOB + offA(c, d)]); }
        __syncthreads();
        for (int c = 0; c < 64; ++c) { float acc = bf2f(Ub[ud * BLOB + offU(c, dv)]); for (int d = 0; d < 128; ++d) acc += Wl[c * 128 + d] * S[d * 128 + dv]; vn[c * 128 + dv] = acc; }
        __syncthreads();
        for (int i = dv; i < 64 * 128; i += 128) { const int c = i >> 7, d = i & 127; Wl[i] = bf2f(QHAT[u * BLOB + offA(c, d)]); }
        for (int i = dv; i < 64 * 64; i += 128) { const int c = i >> 6, c2 = i & 63; Ql[i] = bf2f(QKb[ud * QKBLOB + offT(c, c2)]); }
        __syncthreads();
        for (int c = 0; c < 64; ++c) {
            float acc = 0.f; for (int d = 0; d < 128; ++d) acc += Wl[c * 128 + d] * S[d * 128 + dv];
            acc *= tab[c];
            for (int c2 = 0; c2 < 64; ++c2) acc += Ql[c * 64 + c2] * vn[c2 * 128 + dv];
            ODIR[((size_t)dir * M + (size_t)b * SEQ + n * CHUNK + c) * 512 + h * GD + dv] = (bf16_t)f2bf(acc);
        }
        __syncthreads();
        for (int i = dv; i < 64 * 128; i += 128) { const int c = i >> 7, d = i & 127; Wl[i] = bf2f(KHT[u * BLOB + offT(d, c)]); }
        __syncthreads();
        const float egl = tab[128];
        for (int d = 0; d < 128; ++d) { float acc = S[d * 128 + dv] * egl; for (int c = 0; c < 64; ++c) acc += Wl[c * 128 + d] * tab[64 + c] * vn[c * 128 + dv]; S[d * 128 + dv] = acc; }
    }
}

__host__ __device__ __forceinline__ int t5_bucket(int rel) {
    const int base = rel > 0 ? 16 : 0; const int n = rel < 0 ? -rel : rel;
    if (n < 8) return base + n;
    int k = (n >= 12) + (n >= 16) + (n >= 23) + (n >= 32) + (n >= 46) + (n >= 64) + (n >= 91) + (n >= 128);
    int large = 8 + k; if (large > 15) large = 15;
    return base + large;
}

__global__ void __launch_bounds__(64) k_attn_ref(bf16_t* QC, const bf16_t* __restrict__ KV, const float* __restrict__ rel_bias, const float* __restrict__ sink) {
    __shared__ float btab[257];
    const int h = blockIdx.y, m = blockIdx.x * 64 + threadIdx.x, b = m / SEQ, t = m % SEQ, kvh = h >> 2;
    for (int i = threadIdx.x; i < 257; i += 64) btab[i] = rel_bias[t5_bucket(i - 128) * AH + h];
    __syncthreads();
    float q[64], acc[64];
#pragma unroll
    for (int d = 0; d < 64; ++d) { q[d] = bf2f(QC[(size_t)m * 1024 + h * 64 + d]); acc[d] = 0.f; }
    float mx = -1e30f, l = 0.f;
    const int lo = t - WIN < 0 ? 0 : t - WIN, hi = t + WIN > SEQ - 1 ? SEQ - 1 : t + WIN;
    for (int kp = lo; kp <= hi; ++kp) {
        const bf16_t* kr = KV + (size_t)(b * SEQ + kp) * 256 + kvh * 64; const bf16_t* vr = kr + 128;
        float s = 0.f;
#pragma unroll
        for (int d = 0; d < 64; ++d) s += q[d] * bf2f(kr[d]);
        s = s * 0.125f + btab[kp - t + 128];
        const float mn = fmaxf(mx, s), f = __expf(mx - mn), pe = __expf(s - mn);
        l = l * f + pe; mx = mn;
#pragma unroll
        for (int d = 0; d < 64; ++d) acc[d] = acc[d] * f + pe * bf2f(vr[d]);
    }
    { const float s = sink[h]; const float mn = fmaxf(mx, s), f = __expf(mx - mn); l = l * f + __expf(s - mn);
#pragma unroll
      for (int d = 0; d < 64; ++d) acc[d] *= f; }
    const float il = 1.f / l;
#pragma unroll
    for (int d = 0; d < 64; ++d) QC[(size_t)m * 1024 + h * 64 + d] = (bf16_t)f2bf(acc[d] * il);
}

__global__ void k_p4(const bf16_t* __restrict__ ODIR, const bf16_t* __restrict__ Z, const float* __restrict__ gnw, bf16_t* __restrict__ QC) {
    __shared__ float red[128];
    const int m = blockIdx.x, h = blockIdx.y, d = threadIdx.x;
    const float o = bf2f(ODIR[(size_t)m * 512 + h * GD + d]) + bf2f(ODIR[((size_t)M + m) * 512 + h * GD + d]);
    red[d] = o * o; __syncthreads();
    for (int st = 64; st > 0; st >>= 1) { if (d < st) red[d] += red[d + st]; __syncthreads(); }
    const float r = rsqrtf(red[0] * (1.f / GD) + EPS);
    const float z = bf2f(Z[(size_t)m * 512 + h * GD + d]);
    QC[(size_t)m * 1024 + 512 + h * GD + d] = (bf16_t)f2bf(o * r * gnw[d] * (z / (1.f + __expf(-z))));
}

__global__ void k_final(float* __restrict__ out, const float* __restrict__ SSQ2, const float* __restrict__ nfw) {
    const int m = blockIdx.x, t = threadIdx.x;
    float ss = 0.f; for (int i = 0; i < 16; ++i) ss += SSQ2[(size_t)m * 16 + i];
    const float r = rsqrtf(ss * (1.f / DM) + EPS);
    for (int i = 0; i < 4; ++i) { const int k = t + 256 * i; out[(size_t)m * DM + k] = out[(size_t)m * DM + k] * r * nfw[k]; }
}
constexpr int NWAVES = 8;
constexpr int RING_BYTES = 131072;
constexpr int LDSCTL_OFF = RING_BYTES, MISC_OFF = LDSCTL_OFF + 320;
constexpr int LDS_BYTES = 147456;
constexpr int CW_TMO = 0, CW_CODE = 1, CW_BAR = 4096;
#define LAS __attribute__((address_space(3)))
typedef unsigned v4u __attribute__((ext_vector_type(4)));
typedef unsigned v2u __attribute__((ext_vector_type(2)));
typedef short bf16x8 __attribute__((ext_vector_type(8)));
typedef GAS unsigned gu32;
#define RLX_AGENT __ATOMIC_RELAXED, __HIP_MEMORY_SCOPE_AGENT
#define LDS_WAIT() asm volatile("s_waitcnt lgkmcnt(0)" ::: "memory")
#define VM_WAIT() asm volatile("s_waitcnt vmcnt(0)" ::: "memory")
typedef float f32x2_t __attribute__((ext_vector_type(2))); typedef __bf16 bf16x2_t __attribute__((ext_vector_type(2)));
__device__ __forceinline__ unsigned pk2f(float lo, float hi) { f32x2_t v = {lo, hi}; bf16x2_t b = __builtin_convertvector(v, bf16x2_t); return __builtin_bit_cast(unsigned, b); }
#define XB_TMO      128
#define XB_XCNT(j)  (256  + 64 * (j))
#define XB_XSUB(j)  (1280 + 64 * (j))
#define XB_XGEN(j)  (2304 + 64 * (j))
#define XB_TOP      3328
#define XB_TOPGEN   3392
#define XCD_BAR_WORDS 3456
#define XB_SPIN_CAP (1u << 18)

__device__ __forceinline__ unsigned xb_ld(unsigned* p)              { return __hip_atomic_load(p, __ATOMIC_RELAXED, __HIP_MEMORY_SCOPE_AGENT); }
__device__ __forceinline__ unsigned xb_add(unsigned* p, unsigned v) { return __hip_atomic_fetch_add(p, v, __ATOMIC_RELAXED, __HIP_MEMORY_SCOPE_AGENT); }
__device__ __forceinline__ unsigned xb_xcc_id() { return (unsigned)__builtin_amdgcn_s_getreg((3 << 11) | 20) & 0xFu; }
#define XB_SPIN(cond, bar) do { unsigned _sp = 0; while (cond) { __builtin_amdgcn_s_sleep(1); \
    if ((++_sp & 255u) == 0u) { if (xb_ld(&(bar)[XB_TMO])) break; if (_sp > XB_SPIN_CAP) { atomicAdd(&(bar)[XB_TMO], 1u); break; } } } } while (0)

struct XcdBarrier {
    unsigned* bar; unsigned x;
    volatile LAS unsigned* st;
};

__device__ __forceinline__ XcdBarrier xcd_barrier_post(unsigned* bar, volatile LAS unsigned* st) {
    XcdBarrier b; b.bar = bar; b.x = xb_xcc_id(); b.st = st;
    if (threadIdx.x == 0) (void)xb_add(&bar[XB_XCNT(b.x)], 1u);
    return b;
}
__device__ __forceinline__ void xcd_barrier_complete(unsigned* bar, unsigned x, unsigned& nloc, unsigned& nx) {
    const unsigned G = gridDim.x * gridDim.y * gridDim.z;
    unsigned sum, cnt, mine, sp = 0u;
    for (;;) {
        sum = 0u; cnt = 0u; mine = 0u;
#pragma unroll
        for (unsigned j = 0; j < 16; ++j) { const unsigned c = xb_ld(&bar[XB_XCNT(j)]); sum += c; cnt += (c > 0u) ? 1u : 0u; mine = (j == x) ? c : mine; }
        if (sum == G) break;
        __builtin_amdgcn_s_sleep(1);
        if ((++sp & 255u) == 0u) { if (xb_ld(&bar[XB_TMO])) break; if (sp > XB_SPIN_CAP) { atomicAdd(&bar[XB_TMO], 1u); break; } }
    }
    nloc = mine > 0u ? mine : 1u; nx = cnt > 0u ? cnt : 1u;
}

__device__ __forceinline__ void xcd_barrier(const XcdBarrier& b) {
    asm volatile("s_waitcnt vmcnt(0)" ::: "memory");
    __syncthreads();
    if (threadIdx.x == 0) {
        unsigned* bar = b.bar;
        __builtin_amdgcn_s_waitcnt(0);
        unsigned nloc = b.st[0], nx = b.st[1];
        if (nloc == 0u) { xcd_barrier_complete(bar, b.x, nloc, nx); b.st[0] = nloc; b.st[1] = nx; }
        const unsigned old = xb_add(&bar[XB_XSUB(b.x)], 1u);
        const unsigned gen = old / nloc;
        if (old + 1u == (gen + 1u) * nloc) {
            __builtin_amdgcn_fence(__ATOMIC_RELEASE, "agent");
            asm volatile("s_waitcnt vmcnt(0)" ::: "memory");
            const unsigned og = xb_add(&bar[XB_TOP], 1u);
            const unsigned tg = og / nx;
            if (og + 1u == (tg + 1u) * nx) xb_add(&bar[XB_TOPGEN], 1u);
            else XB_SPIN(xb_ld(&bar[XB_TOPGEN]) == tg, bar);
            __builtin_amdgcn_fence(__ATOMIC_ACQUIRE, "agent");
            xb_add(&bar[XB_XGEN(b.x)], 1u);
            asm volatile("s_waitcnt vmcnt(0)" ::: "memory");
        } else {
            XB_SPIN(xb_ld(&bar[XB_XGEN(b.x)]) == gen, bar);
            __builtin_amdgcn_fence(__ATOMIC_ACQUIRE, "agent");
            asm volatile("s_waitcnt vmcnt(0)" ::: "memory");
        }
    }
    __syncthreads();
}
struct Frame {
    LAS unsigned char* lds; volatile LAS unsigned* MISC; gu32* ctl;
    int tid, lane, wave, vcu, G;
};
__device__ __forceinline__ float wave_sum(float v) {
#pragma unroll
    for (int o = 1; o < 64; o <<= 1) v += __shfl_xor(v, o);
    return v;
}
__device__ __forceinline__ void p0_transpose_item(const float* W, int K, int ldw, int N, const float* ksc, bf16_t* WT, LAS float* scr, int item, int lane) {
    const int nblk = N / 32, kb = item / nblk, nb = item % nblk, k0 = 64 * kb, n0 = 32 * nb;
#pragma unroll 8
    for (int i = 0; i < 32; ++i) { const int kk = 2 * i + (lane >> 5); float v = W[(size_t)(k0 + kk) * ldw + n0 + (lane & 31)]; if (ksc) v *= ksc[k0 + kk]; scr[kk * 33 + (lane & 31)] = v; }
    LDS_WAIT(); asm volatile("" ::: "memory");
    const int c = lane & 7;
#pragma unroll
    for (int j = 0; j < 4; ++j) { const int n = (lane >> 3) + 8 * j; const LAS float* s = scr + (8 * c) * 33 + n;
        v4u o; o.x = pk2f(s[0 * 33], s[1 * 33]); o.y = pk2f(s[2 * 33], s[3 * 33]); o.z = pk2f(s[4 * 33], s[5 * 33]); o.w = pk2f(s[6 * 33], s[7 * 33]);
        *(GAS v4u*)(WT + (size_t)(n0 + n) * K + k0 + 8 * c) = o; }
    LDS_WAIT(); asm volatile("" ::: "memory");
}
struct P0Args { const float *x, *nmw, *w_in, *w_out, *nfw, *w1, *w2; bf16_t *WIN_T, *WOUT_T, *W1_T, *W2_T, *XN; float* GATES; };
__device__ __forceinline__ void phase_p0(Frame& F, const P0Args& a) {
    LAS float* scr = (LAS float*)(F.lds + F.wave * 16384);
    const int gw = F.vcu * NWAVES + F.wave, NGW = F.G * NWAVES, lane = F.lane;
    constexpr int I_IN = (DM / 64) * (NPROJ / 32), I_O = (DM / 64) * (DM / 32), I_1 = (DM / 64) * (DFF / 32), I_2 = (DFF / 64) * (DM / 32);
    constexpr int NITEMS = I_IN + I_O + I_1 + I_2;
    for (int it = gw; it < NITEMS; it += NGW) {
        int r = it;
        if (r < I_IN) { p0_transpose_item(a.w_in, DM, DIN, NPROJ, nullptr, a.WIN_T, scr, r, lane); continue; } r -= I_IN;
        if (r < I_O) { p0_transpose_item(a.w_out, DM, DM, DM, nullptr, a.WOUT_T, scr, r, lane); continue; } r -= I_O;
        if (r < I_1) { p0_transpose_item(a.w1, DM, DFF, DFF, a.nfw, a.W1_T, scr, r, lane); continue; } r -= I_1;
        p0_transpose_item(a.w2, DFF, DM, DM, nullptr, a.W2_T, scr, r, lane);
    }
    __syncthreads();
    LAS float* GW = (LAS float*)F.lds;
    for (int k = F.tid; k < DM; k += NWAVES * 64) {
        const f32x4* src = (const f32x4*)(a.w_in + (size_t)k * DIN + NPROJ); const int kg = k >> 2, e = k & 3;
#pragma unroll
        for (int q = 0; q < 4; ++q) { const f32x4 w = src[q];
#pragma unroll
            for (int t = 0; t < 4; ++t) { const int i = q * 4 + t; GW[kg * 64 + ((i ^ (kg & 15)) << 2) + e] = w[t]; } }
    }
    __syncthreads();
    f32x4 nwv[4];
#pragma unroll
    for (int j = 0; j < 4; ++j) nwv[j] = *(const f32x4*)(a.nmw + 256 * j + 4 * lane);
    for (int m = gw; m < M; m += NGW) {
        const GAS f32x4* xr = (const GAS f32x4*)(a.x + (size_t)m * DM) + lane;
        f32x4 v[4]; float s = 0.f;
#pragma unroll
        for (int j = 0; j < 4; ++j) { v[j] = xr[64 * j]; s += (v[j].x * v[j].x + v[j].y * v[j].y) + (v[j].z * v[j].z + v[j].w * v[j].w); }
        const float r = rsqrtf(wave_sum(s) * (1.f / DM) + EPS);
        GAS unsigned long long* o8 = (GAS unsigned long long*)(a.XN + (size_t)m * DM) + lane;
        float acc[16];
#pragma unroll
        for (int i = 0; i < 16; ++i) acc[i] = 0.f;
#pragma unroll
        for (int j = 0; j < 4; ++j) {
            v[j] = v[j] * r * nwv[j];
            o8[64 * j] = (unsigned long long)pk2f(v[j].x, v[j].y) | ((unsigned long long)pk2f(v[j].z, v[j].w) << 32);
            const LAS float* base = GW + (64 * j + lane) * 64;
#pragma unroll
            for (int i = 0; i < 16; ++i) { const f32x4 w = *(const LAS f32x4*)(base + ((i ^ (lane & 15)) << 2)); acc[i] += (v[j].x * w.x + v[j].y * w.y) + (v[j].z * w.z + v[j].w * w.w);
                if ((i & 7) == 7) asm volatile("" ::: "memory"); }
        }
        float a8[8], a4[4], a2[2], a1;
        { const bool hb = (lane >> 5) & 1;
#pragma unroll
          for (int i = 0; i < 8; ++i) { const float send = hb ? acc[i] : acc[i + 8]; const float recv = __shfl_xor(send, 32); a8[i] = (hb ? acc[i + 8] : acc[i]) + recv; } }
        { const bool hb = (lane >> 4) & 1;
#pragma unroll
          for (int i = 0; i < 4; ++i) { const float send = hb ? a8[i] : a8[i + 4]; const float recv = __shfl_xor(send, 16); a4[i] = (hb ? a8[i + 4] : a8[i]) + recv; } }
        { const bool hb = (lane >> 3) & 1;
#pragma unroll
          for (int i = 0; i < 2; ++i) { const float send = hb ? a4[i] : a4[i + 2]; const float recv = __shfl_xor(send, 8); a2[i] = (hb ? a4[i + 2] : a4[i]) + recv; } }
        { const bool hb = (lane >> 2) & 1; const float send = hb ? a2[0] : a2[1]; const float recv = __shfl_xor(send, 4); a1 = (hb ? a2[1] : a2[0]) + recv; }
        a1 += __shfl_xor(a1, 2); a1 += __shfl_xor(a1, 1);
        if ((lane & 3) == 0) a.GATES[(size_t)m * 16 + (lane >> 2)] = a1;
    }
}
__device__ __forceinline__ void phase_p4(Frame& F, const bf16_t* ODIR, const bf16_t* Z, const float* gnw, bf16_t* QC) {
    const int gw = F.vcu * NWAVES + F.wave, NGW = F.G * NWAVES, lane = F.lane;
    const float g0 = gnw[2 * lane], g1 = gnw[2 * lane + 1];
    for (int idx = gw; idx < M * GH; idx += NGW) {
        const int m = idx >> 2, h = idx & 3;
        const unsigned of = *(const GAS unsigned*)(ODIR + (size_t)m * 512 + h * GD + 2 * lane), ob = *(const GAS unsigned*)(ODIR + ((size_t)M + m) * 512 + h * GD + 2 * lane);
        const unsigned zz = *(const GAS unsigned*)(Z + (size_t)m * 512 + h * GD + 2 * lane);
        const float o0 = bf2f(of) + bf2f(ob), o1 = bf2f(of >> 16) + bf2f(ob >> 16);
        const float r = rsqrtf(wave_sum(o0 * o0 + o1 * o1) * (1.f / GD) + EPS);
        const float z0 = bf2f(zz), z1 = bf2f(zz >> 16);
        *(GAS unsigned*)(QC + (size_t)m * 1024 + 512 + h * GD + 2 * lane) = pk2f(o0 * r * g0 * (z0 / (1.f + __expf(-z0))), o1 * r * g1 * (z1 / (1.f + __expf(-z1))));
    }
}
__device__ __forceinline__ void phase_p8(Frame& F, float* out, const float* SSQ2, const float* nfw) {
    const int gw = F.vcu * NWAVES + F.wave, NGW = F.G * NWAVES, lane = F.lane;
    f32x4 wv[4];
#pragma unroll
    for (int j = 0; j < 4; ++j) wv[j] = *(const f32x4*)(nfw + 256 * j + 4 * lane);
    for (int m = gw; m < M; m += NGW) {
        const GAS f32x4* sp = (const GAS f32x4*)(SSQ2 + (size_t)m * 16);
        const f32x4 st = (sp[0] + sp[1]) + (sp[2] + sp[3]);
        const float r = rsqrtf(((st[0] + st[1]) + (st[2] + st[3])) * (1.f / DM) + EPS);
        GAS f32x4* xr = (GAS f32x4*)(out + (size_t)m * DM) + lane;
#pragma unroll
        for (int j = 0; j < 4; ++j) xr[64 * j] = xr[64 * j] * r * wv[j];
    }
}
constexpr size_t WS_VTP = 232 * MiB;
__host__ __device__ __forceinline__ int perm16(int a) { return (a & ~12) | ((a & 4) << 1) | ((a & 8) >> 1); }
__device__ __forceinline__ float silu_f(float y) { return y / (1.f + __expf(-y)); }
__device__ __forceinline__ void phase_p2a(Frame& F, const bf16_t* QKVG, const bf16_t* KV, const float* conv_w, bf16_t* QHAT, bf16_t* KHAT, bf16_t* KHT, bf16_t* VHT, bf16_t* VTP) {
    const int lane = F.lane, w = F.wave;
    const int upw = (NUNIT + F.G - 1) / F.G;
    const int cbase = 32 * (w >> 2) + 8 * ((w >> 1) & 1) + 4 * (w & 1);
    const int P0 = (cbase & 32) | ((cbase & 12) << 1);
    for (int ui = 0; ui < upw; ++ui) {
        const int u = F.vcu * upw + ui; if (u >= NUNIT) break;
        const int n = u % NCH, bh = u / NCH, h = bh % GH, b = bh / GH;
        float cw[CONVK][3][2];
#pragma unroll
        for (int j = 0; j < CONVK; ++j)
#pragma unroll
            for (int wh = 0; wh < 3; ++wh) { const float* p = conv_w + j * 1536 + wh * 512 + h * GD + 2 * lane; cw[j][wh][0] = p[0]; cw[j][wh][1] = p[1]; }
        unsigned kt[2][4], vt[2][4];
#pragma unroll
        for (int run = 0; run < 2; ++run) {
            const int c0 = cbase + 16 * run, t0 = n * CHUNK + c0;
            unsigned xw[8][3];
#pragma unroll
            for (int rr = 0; rr < 8; ++rr) { const int t = t0 - 2 + rr; const bool ok = (t >= 0) && (t < SEQ);
                const GAS unsigned* rp = (const GAS unsigned*)(QKVG + (size_t)(b * SEQ + (ok ? t : 0)) * 1536 + h * GD + 2 * lane);
#pragma unroll
                for (int wh = 0; wh < 3; ++wh) { const unsigned v = rp[wh * 256]; xw[rr][wh] = ok ? v : 0u; } }
            float kv0[4], kv1[4], vv0[4], vv1[4];
#pragma unroll
            for (int i = 0; i < 4; ++i) {
                float y[3][2];
#pragma unroll
                for (int wh = 0; wh < 3; ++wh) { float a0 = 0.f, a1 = 0.f;
#pragma unroll
                    for (int j = 0; j < CONVK; ++j) { a0 += bf2f(xw[i + j][wh]) * cw[j][wh][0]; a1 += bf2f(xw[i + j][wh] >> 16) * cw[j][wh][1]; }
                    y[wh][0] = silu_f(a0); y[wh][1] = silu_f(a1); }
                const float sq = wave_sum(y[0][0] * y[0][0] + y[0][1] * y[0][1]), sk = wave_sum(y[1][0] * y[1][0] + y[1][1] * y[1][1]);
                const float rq = rsqrtf(sq + EPS) * 0.08838834764831845f, rk = rsqrtf(sk + EPS);
                const int c = c0 + i;
                const float k0 = y[1][0] * rk, k1 = y[1][1] * rk;
                *(GAS unsigned*)(QHAT + (size_t)u * BLOB + offA(c, 2 * lane)) = pk2f(y[0][0] * rq, y[0][1] * rq);
                *(GAS unsigned*)(KHAT + (size_t)u * BLOB + offA(c, 2 * lane)) = pk2f(k0, k1);
                kv0[i] = k0; kv1[i] = k1; vv0[i] = y[2][0]; vv1[i] = y[2][1];
            }
            kt[0][2 * run] = pk2f(kv0[0], kv0[1]); kt[0][2 * run + 1] = pk2f(kv0[2], kv0[3]);
            kt[1][2 * run] = pk2f(kv1[0], kv1[1]); kt[1][2 * run + 1] = pk2f(kv1[2], kv1[3]);
            vt[0][2 * run] = pk2f(vv0[0], vv0[1]); vt[0][2 * run + 1] = pk2f(vv0[2], vv0[3]);
            vt[1][2 * run] = pk2f(vv1[0], vv1[1]); vt[1][2 * run + 1] = pk2f(vv1[2], vv1[3]);
        }
        const int chunk = (P0 >> 3) ^ (lane & 7);
#pragma unroll
        for (int e = 0; e < 2; ++e) { const size_t off = (size_t)u * BLOB + (size_t)(2 * lane + e) * 64 + chunk * 8;
            *(GAS v4u*)(KHT + off) = (v4u){kt[e][0], kt[e][1], kt[e][2], kt[e][3]};
            *(GAS v4u*)(VHT + off) = (v4u){vt[e][0], vt[e][1], vt[e][2], vt[e][3]}; }
    }
    const int gw = F.vcu * NWAVES + F.wave, NGW = F.G * NWAVES;
    for (int it = gw; it < BATCH * AKVH * (SEQ / 64); it += NGW) {
        const int tb = it % (SEQ / 64), bk = it / (SEQ / 64), kvh = bk % AKVH, b = bk / AKVH;
        const GAS bf16_t* src = (const GAS bf16_t*)(KV + (size_t)(b * SEQ + tb * 64) * 256 + 128 + kvh * 64 + lane);
        unsigned pkd[32];
#pragma unroll
        for (int i = 0; i < 32; ++i) pkd[i] = 0u;
#pragma unroll
        for (int tt = 0; tt < 64; ++tt) { const unsigned v = src[(size_t)tt * 256]; const int pos = perm16(tt); pkd[pos >> 1] |= (pos & 1) ? (v << 16) : v; }
        GAS v4u* dst = (GAS v4u*)(VTP + ((size_t)(b * AKVH + kvh) * 64 + lane) * SEQ + tb * 64);
#pragma unroll
        for (int q = 0; q < 8; ++q) dst[q] = (v4u){pkd[4 * q], pkd[4 * q + 1], pkd[4 * q + 2], pkd[4 * q + 3]};
    }
}
__host__ __device__ constexpr int kpinv(int p) { return (p & ~31) | ((p & 4) << 2) | ((p & 24) >> 1) | (p & 3); }
__device__ __forceinline__ bf16x8 fragA_g(const bf16_t* blob, int rt, int s, int fr, int g) { const int row = 16 * rt + fr; return *(const GAS bf16x8*)(blob + row * 128 + (((4 * s + g) ^ fr) << 3)); }
__device__ __forceinline__ bf16x8 fragT_g(const bf16_t* blob, int rt, int s, int fr, int g) { const int row = 16 * rt + fr; return *(const GAS bf16x8*)(blob + row * 64 + (((4 * s + g) ^ ((row >> 1) & 7)) << 3)); }
__device__ __forceinline__ bf16x8 fragT_l(const LAS unsigned char* img, int rt, int s, int fr, int g) { const int row = 16 * rt + fr; return *(const LAS bf16x8*)(img + row * 128 + (((4 * s + g) ^ ((row >> 1) & 7)) << 4)); }

template <int DIR>
__device__ __forceinline__ void p2b_write_ts(LAS unsigned char* img, const float (&T)[64], const LAS float* sct, int c, float sign) {
#pragma unroll
    for (int q = 0; q < 8; ++q) {
        const f32x4 s0 = *(const LAS f32x4*)(sct + 8 * q), s1 = *(const LAS f32x4*)(sct + 8 * q + 4);
        float v[8];
#pragma unroll
        for (int i = 0; i < 8; ++i) { const int cp = kpinv(8 * q + i); const int j = DIR ? 63 - cp : cp; v[i] = T[j] * (i < 4 ? s0[i] : s1[i - 4]) * sign; }
        v4u pw; pw.x = pk2f(v[0], v[1]); pw.y = pk2f(v[2], v[3]); pw.z = pk2f(v[4], v[5]); pw.w = pk2f(v[6], v[7]);
        *(LAS v4u*)(img + c * 128 + ((q ^ ((c >> 1) & 7)) << 4)) = pw;
        asm volatile("" ::: "memory");
    }
}

__device__ __forceinline__ void p2b_task(LAS unsigned char* R, LAS float* sct, int ud, int lane, const bf16_t* QHAT, const bf16_t* KHAT, const bf16_t* KHT, const bf16_t* VHT, const float* GATES,
                                         const float* a_log, const float* dt_bias, bf16_t* Wb, bf16_t* Ub, bf16_t* QKb, float* TAB) {
    const int fr = lane & 15, g = lane >> 4;
    const int u = ud >> 1, dir = ud & 1, n = u % NCH, bh = u / NCH, h = bh % GH, b = bh / GH;
    const int c = dir ? 63 - lane : lane;
    float beta, gc, glast;
    {
        const size_t m = (size_t)b * SEQ + n * CHUNK + c;
        const float a = GATES[m * 16 + dir * 4 + h], bb = GATES[m * 16 + 8 + dir * 4 + h];
        const float z = a + dt_bias[dir * 4 + h];
        const float sp = (z > 20.f) ? z : log1pf(__expf(z));
        float s = -__expf(a_log[dir * 4 + h]) * sp; beta = 1.f / (1.f + __expf(-bb));
#pragma unroll
        for (int o = 1; o < 64; o <<= 1) { const float t = __shfl_up(s, o); if (lane >= o) s += t; }
        gc = s; glast = __shfl(gc, 63);
        TAB[(size_t)ud * TABW + c] = __expf(gc); TAB[(size_t)ud * TABW + 64 + c] = __expf(glast - gc);
        if (lane == 63) TAB[(size_t)ud * TABW + 128] = __expf(glast);
    }
    sct[kperm(c)] = beta * __expf(gc); sct[64 + kperm(c)] = beta;
    float gcr[4][4], ber[4][4], gcc[4];
#pragma unroll
    for (int t = 0; t < 4; ++t) {
        { const int cc = 16 * t + fr; const int pl = dir ? 63 - cc : cc; gcc[t] = __shfl(gc, pl); }
#pragma unroll
        for (int r = 0; r < 4; ++r) { const int cr = 16 * t + 4 * g + r; const int pl = dir ? 63 - cr : cr; gcr[t][r] = __shfl(gc, pl); ber[t][r] = __shfl(beta, pl); }
    }
    const bf16_t* kb = KHAT + (size_t)u * BLOB; const bf16_t* qb = QHAT + (size_t)u * BLOB;
    LAS float* AT = (LAS float*)R;
    {
        bf16x8 kf[4][4], qfa[2][4];
#pragma unroll
        for (int t = 0; t < 4; ++t)
#pragma unroll
            for (int s = 0; s < 4; ++s) kf[t][s] = fragA_g(kb, t, s, fr, g);
#pragma unroll
        for (int s = 0; s < 4; ++s) qfa[0][s] = fragA_g(qb, 0, s, fr, g);
#pragma unroll
        for (int ta = 0; ta < 4; ++ta)
#pragma unroll
            for (int tb = 0; tb < 4; ++tb) {
                f32x4 acc = (f32x4){0.f, 0.f, 0.f, 0.f};
#pragma unroll
                for (int s = 0; s < 4; ++s) acc = __builtin_amdgcn_mfma_f32_16x16x32_bf16(kf[ta][s], kf[tb][s], acc, 0, 0, 0);
                const int ccol = 16 * tb + fr; int pc = dir ? 63 - ccol : ccol; asm volatile("" : "+v"(pc));
                f32x4 v;
#pragma unroll
                for (int r = 0; r < 4; ++r) { const int crow = 16 * ta + 4 * g + r, pr = dir ? 63 - crow : crow;
                    const float e = __expf(fminf(gcr[ta][r] - gcc[tb], 0.f)); v[r] = (pc < pr) ? ber[ta][r] * acc[r] * e : 0.f; }
                const int pr0 = dir ? 63 - (16 * ta + 4 * g + 3) : 16 * ta + 4 * g;
                if (dir) v = (f32x4){v[3], v[2], v[1], v[0]};
                *(LAS f32x4*)(AT + pc * 64 + (pr0 ^ (4 * (pc & 15)))) = v;
            }
#pragma unroll
        for (int tb = 0; tb < 4; ++tb) {
            const int cq = 16 * tb + fr; int pq = dir ? 63 - cq : cq; asm volatile("" : "+v"(pq));
            const bf16x8 (&qf)[4] = qfa[tb & 1];
            if (tb < 3) {
#pragma unroll
                for (int s = 0; s < 4; ++s) qfa[(tb + 1) & 1][s] = fragA_g(qb, tb + 1, s, fr, g); }
#pragma unroll
            for (int sg = 0; sg < 2; ++sg) {
                f32x4 a0 = (f32x4){0.f, 0.f, 0.f, 0.f}, a1 = a0;
#pragma unroll
                for (int s = 0; s < 4; ++s) { a0 = __builtin_amdgcn_mfma_f32_16x16x32_bf16(kf[2 * sg][s], qf[s], a0, 0, 0, 0); a1 = __builtin_amdgcn_mfma_f32_16x16x32_bf16(kf[2 * sg + 1][s], qf[s], a1, 0, 0, 0); }
                float v[8];
#pragma unroll
                for (int r = 0; r < 4; ++r) {
                    { const int ck = 16 * (2 * sg) + 4 * g + r, pk = dir ? 63 - ck : ck; v[r] = (pk <= pq) ? a0[r] * __expf(fminf(gcc[tb] - gcr[2 * sg][r], 0.f)) : 0.f; }
                    { const int ck = 16 * (2 * sg + 1) + 4 * g + r, pk = dir ? 63 - ck : ck; v[4 + r] = (pk <= pq) ? a1[r] * __expf(fminf(gcc[tb] - gcr[2 * sg + 1][r], 0.f)) : 0.f; }
                }
                v4u pw; pw.x = pk2f(v[0], v[1]); pw.y = pk2f(v[2], v[3]); pw.z = pk2f(v[4], v[5]); pw.w = pk2f(v[6], v[7]);
                *(GAS v4u*)(QKb + (size_t)ud * QKBLOB + cq * 64 + (((4 * sg + g) ^ ((cq >> 1) & 7)) << 3)) = pw;
            }
        }
    }
    const bf16_t* ktb = KHT + (size_t)u * BLOB; const bf16_t* vtb = VHT + (size_t)u * BLOB;
    bf16x8 kta[8][2], vta[8][2];
    { int lane1 = lane; asm volatile("" : "+v"(lane1));
      const int fr1 = lane1 & 15, g1 = lane1 >> 4;
#pragma unroll
      for (int t = 0; t < 8; ++t)
#pragma unroll
          for (int s2 = 0; s2 < 2; ++s2) kta[t][s2] = fragT_g(ktb, t, s2, fr1, g1); }
    LDS_WAIT(); asm volatile("" ::: "memory");
    float T[64];
#pragma unroll
    for (int j = 63; j >= 0; --j) {
        int lj = lane; asm volatile("" : "+v"(lj));
        float acc = (lj == j) ? 1.f : 0.f;
#pragma unroll
        for (int k4 = ((j + 1) & ~3); k4 < 64; k4 += 4) {
            const f32x4 a = *(const LAS f32x4*)(AT + j * 64 + (k4 ^ (4 * (j & 15))));
#pragma unroll
            for (int e = 0; e < 4; ++e) if (k4 + e > j) acc -= T[k4 + e] * a[e];
            if ((k4 & 28) == 28) asm volatile("" ::: "memory");
        }
        T[j] = acc;
        asm volatile("" ::: "memory");
    }
    asm volatile("" ::: "memory");
    LAS unsigned char* Tw = R; LAS unsigned char* Tu = R + 8192;
    if (dir) { p2b_write_ts<1>(Tw, T, sct, c, -1.f); p2b_write_ts<1>(Tu, T, sct + 64, c, 1.f); }
    else { p2b_write_ts<0>(Tw, T, sct, c, -1.f); p2b_write_ts<0>(Tu, T, sct + 64, c, 1.f); }
    { int lane1 = lane; asm volatile("" : "+v"(lane1)); const int fr1 = lane1 & 15, g1 = lane1 >> 4;
#pragma unroll
      for (int t = 0; t < 8; ++t)
#pragma unroll
          for (int s2 = 0; s2 < 2; ++s2) vta[t][s2] = fragT_g(vtb, t, s2, fr1, g1); }
    LDS_WAIT(); asm volatile("" ::: "memory");
    int lane2 = lane; asm volatile("" : "+v"(lane2));
    const int fr_ = fr, g_ = g; (void)fr_; (void)g_;
    #define fr (lane2 & 15)
    #define g (lane2 >> 4)
    #define lane lane2
#pragma unroll
    for (int sg = 0; sg < 4; ++sg) {
        const bf16x8 (&ka)[2][2] = *(const bf16x8 (*)[2][2])&kta[2 * sg];
#pragma unroll
        for (int ct = 0; ct < 4; ++ct) {
            f32x4 a0 = (f32x4){0.f, 0.f, 0.f, 0.f}, a1 = a0;
#pragma unroll
            for (int s2 = 0; s2 < 2; ++s2) { const bf16x8 tb_ = fragT_l(Tw, ct, s2, fr, g);
                a0 = __builtin_amdgcn_mfma_f32_16x16x32_bf16(ka[0][s2], tb_, a0, 0, 0, 0); a1 = __builtin_amdgcn_mfma_f32_16x16x32_bf16(ka[1][s2], tb_, a1, 0, 0, 0); }
            const int cc = 16 * ct + fr;
            v4u pw; pw.x = pk2f(a0[0], a0[1]); pw.y = pk2f(a0[2], a0[3]); pw.z = pk2f(a1[0], a1[1]); pw.w = pk2f(a1[2], a1[3]);
            *(GAS v4u*)(Wb + (size_t)ud * BLOB + cc * 128 + (((4 * sg + g) ^ fr) << 3)) = pw;
        }
    }
#pragma unroll
    for (int ct = 0; ct < 4; ++ct) {
        bf16x8 ta_[2];
#pragma unroll
        for (int s2 = 0; s2 < 2; ++s2) ta_[s2] = fragT_l(Tu, ct, s2, fr, g);
#pragma unroll
        for (int vt = 0; vt < 8; ++vt) {
            f32x4 a0 = (f32x4){0.f, 0.f, 0.f, 0.f};
#pragma unroll
            for (int s2 = 0; s2 < 2; ++s2) a0 = __builtin_amdgcn_mfma_f32_16x16x32_bf16(ta_[s2], vta[vt][s2], a0, 0, 0, 0);
            v2u pw; pw.x = pk2f(a0[0], a0[1]); pw.y = pk2f(a0[2], a0[3]);
            *(GAS v2u*)(Ub + (size_t)ud * BLOB + (size_t)((vt * 4 + ct) * 64 + lane) * 4) = pw;
        }
    }
    LDS_WAIT(); asm volatile("" ::: "memory");
    #undef fr
    #undef g
    #undef lane
}
__device__ __forceinline__ void phase_p2b(Frame& F, const bf16_t* QHAT, const bf16_t* KHAT, const bf16_t* KHT, const bf16_t* VHT, const float* GATES,
                                          const float* a_log, const float* dt_bias, bf16_t* Wb, bf16_t* Ub, bf16_t* QKb, float* TAB) {
    const int gw = F.vcu * NWAVES + F.wave, NGW = F.G * NWAVES;
    LAS unsigned char* R = F.lds + F.wave * 16384; LAS float* sct = (LAS float*)(F.lds + RING_BYTES + 1024 + F.wave * 512);
    for (int ud = gw; ud < NUNIT * 2; ud += NGW) { int ln = F.lane; asm volatile("" : "+v"(ln));
        p2b_task(R, sct, ud, ln, QHAT, KHAT, KHT, VHT, GATES, a_log, dt_bias, Wb, Ub, QKb, TAB); }
}
#ifndef SCAN_SPLIT
#define SCAN_SPLIT 2
#endif
constexpr int SCAN_NCW = 8 / SCAN_SPLIT;
constexpr int SCAN_SEG = NCH / 2;
constexpr int SCAN_WGS = 16 * SCAN_SPLIT * 3;
constexpr size_t WS_GBUF = 236 * MiB;
constexpr size_t WS_SMID = 252 * MiB;
__device__ __forceinline__ bf16x8 pack8(f32x4 a, f32x4 b) {
    v4u r; r.x = pk2f(a[0], a[1]); r.y = pk2f(a[2], a[3]); r.z = pk2f(b[0], b[1]); r.w = pk2f(b[2], b[3]); return __builtin_bit_cast(bf16x8, r);
}
constexpr int SC_W = 0, SC_Q = 16384, SC_K = 32768, SC_QK = 49152, SC_TAB = 57344, SC_BUF = 58368;
struct ScanRegs { v2u ub[4]; };
__device__ __forceinline__ void glds16(const void* gsrc, unsigned lds_dst) {
    unsigned keep;
    asm volatile("s_mov_b32 %0, m0\n\ts_mov_b32 m0, %2\n\ts_nop 0\n\tglobal_load_lds_dwordx4 %1, off\n\ts_mov_b32 m0, %0" : "=&s"(keep) : "v"(gsrc), "s"(lds_dst) : "memory");
}
__device__ __forceinline__ void glds4(const void* gsrc, unsigned lds_dst) {
    unsigned keep;
    asm volatile("s_mov_b32 %0, m0\n\ts_mov_b32 m0, %2\n\ts_nop 0\n\tglobal_load_lds_dword %1, off\n\ts_mov_b32 m0, %0" : "=&s"(keep) : "v"(gsrc), "s"(lds_dst) : "memory");
}
struct ScanSrc { const char *pw, *pq, *pk, *pqk, *pt, *pu; };
template <int LW, int NLW>
__device__ __forceinline__ void scan_stage_t(unsigned ldsb, const ScanSrc& c, int lane) {
#pragma unroll
    for (int pc = LW; pc < 57; pc += NLW) {
        const char* src = (pc < 16) ? c.pw + pc * 1024 : (pc < 32) ? c.pq + (pc - 16) * 1024 : (pc < 48) ? c.pk + (pc - 32) * 1024 : (pc < 56) ? c.pqk + (pc - 48) * 1024 : c.pt;
        glds16(src + lane * 16, (unsigned)__builtin_amdgcn_readfirstlane(ldsb + pc * 1024));
    }
}
constexpr int SCAN_NPF = 3;
template <int LW>
__device__ __forceinline__ void scan_prefetch_t(unsigned dummy, const ScanSrc& c, int lane) {
    const char* b0 = (LW == 0) ? c.pw : (LW == 1) ? c.pq : (LW == 2) ? c.pk : c.pqk;
    glds4(b0 + lane * 128, dummy);
    if (LW < 3) { glds4(b0 + 8192 + lane * 128, dummy); glds4(b0 + (lane & 1) * 8192 + (lane >> 1) * 128 + 64, dummy); }
    else { glds4(c.pu + lane * 128, dummy); glds4(c.pt + (lane & 7) * 96, dummy); }
}
__device__ __forceinline__ void scan_loader(LAS unsigned char* buf, unsigned dummy, const ScanSrc& now, const ScanSrc& later, bool pf, int lw, int lane) {
    const unsigned ldsb = (unsigned)(uintptr_t)buf;
    switch (lw) { case 0: scan_stage_t<0, 4>(ldsb, now, lane); if (pf) scan_prefetch_t<0>(dummy, later, lane); break;
                  case 1: scan_stage_t<1, 4>(ldsb, now, lane); if (pf) scan_prefetch_t<1>(dummy, later, lane); break;
                  case 2: scan_stage_t<2, 4>(ldsb, now, lane); if (pf) scan_prefetch_t<2>(dummy, later, lane); break;
                  default: scan_stage_t<3, 4>(ldsb, now, lane); if (pf) scan_prefetch_t<3>(dummy, later, lane); break; }
    if (pf) asm volatile("s_waitcnt vmcnt(3)" ::: "memory"); else asm volatile("s_waitcnt vmcnt(0)" ::: "memory");
}
__device__ __forceinline__ void scan_load_regs(ScanRegs& R, const bf16_t* Ub, size_t ud, int sl, int lane) {
#pragma unroll
    for (int ct = 0; ct < 4; ++ct) R.ub[ct] = *(const GAS v2u*)(Ub + ud * BLOB + (size_t)((sl * 4 + ct) * 64 + lane) * 4);
}
#define SCAN_SB() __builtin_amdgcn_sched_barrier(0)
__device__ __forceinline__ void scan_compute(f32x4 (&S)[8], const LAS unsigned char* cur, const ScanRegs& R, v2u (&ow)[4], int lane) {
    const int fr = lane & 15, g = lane >> 4;
    const LAS float* tab = (const LAS float*)(cur + SC_TAB);
    const LAS unsigned char* pA = cur + fr * 256;
    const LAS unsigned char* pT = cur + fr * 128;
    const int sw = (fr >> 1) & 7;
    bf16x8 fa[8], fb[8];
#define LD_A(dst, base, c0) _Pragma("unroll") for (int i_ = 0; i_ < 8; ++i_) dst[i_] = *(const LAS bf16x8*)(pA + (base) + ((c0) + (i_ >> 2)) * 4096 + (((4 * (i_ & 3) + g) ^ fr) << 4))
#define LD_T(dst, base, t0) _Pragma("unroll") for (int i_ = 0; i_ < 8; ++i_) dst[i_] = *(const LAS bf16x8*)(pT + (base) + ((t0) + (i_ >> 1)) * 2048 + (((4 * (i_ & 1) + g) ^ sw) << 4))
    LD_A(fa, SC_W, 0); LD_A(fb, SC_W, 2);
    SCAN_SB();
    bf16x8 bS[4];
#pragma unroll
    for (int s = 0; s < 4; ++s) bS[s] = pack8(S[2 * s], S[2 * s + 1]);
    f32x4 vn[4], oa[4];
#pragma unroll
    for (int ct = 0; ct < 4; ++ct) vn[ct] = (f32x4){bf2f(R.ub[ct].x), bf2f(R.ub[ct].x >> 16), bf2f(R.ub[ct].y), bf2f(R.ub[ct].y >> 16)};
#pragma unroll
    for (int i = 0; i < 8; ++i) vn[i >> 2] = __builtin_amdgcn_mfma_f32_16x16x32_bf16(fa[i], bS[i & 3], vn[i >> 2], 0, 0, 0);
    SCAN_SB(); LD_A(fa, SC_Q, 0); SCAN_SB();
#pragma unroll
    for (int i = 0; i < 8; ++i) vn[2 + (i >> 2)] = __builtin_amdgcn_mfma_f32_16x16x32_bf16(fb[i], bS[i & 3], vn[2 + (i >> 2)], 0, 0, 0);
    SCAN_SB(); LD_A(fb, SC_Q, 2); SCAN_SB();
#pragma unroll
    for (int ct = 0; ct < 4; ++ct) oa[ct] = (f32x4){0.f, 0.f, 0.f, 0.f};
#pragma unroll
    for (int i = 0; i < 8; ++i) oa[i >> 2] = __builtin_amdgcn_mfma_f32_16x16x32_bf16(fa[i], bS[i & 3], oa[i >> 2], 0, 0, 0);
    bf16x8 bV[2], bK[2];
    { const f32x4 ek0 = *(const LAS f32x4*)(tab + 64 + 4 * g), ek1 = *(const LAS f32x4*)(tab + 80 + 4 * g), ek2 = *(const LAS f32x4*)(tab + 96 + 4 * g), ek3 = *(const LAS f32x4*)(tab + 112 + 4 * g);
      bV[0] = pack8(vn[0], vn[1]); bV[1] = pack8(vn[2], vn[3]);
      bK[0] = pack8(vn[0] * ek0, vn[1] * ek1); bK[1] = pack8(vn[2] * ek2, vn[3] * ek3); }
    SCAN_SB(); LD_T(fa, SC_K, 0); SCAN_SB();
#pragma unroll
    for (int i = 0; i < 8; ++i) oa[2 + (i >> 2)] = __builtin_amdgcn_mfma_f32_16x16x32_bf16(fb[i], bS[i & 3], oa[2 + (i >> 2)], 0, 0, 0);
    const float egl = tab[128];
    SCAN_SB(); LD_T(fb, SC_K, 4); SCAN_SB();
#pragma unroll
    for (int i = 0; i < 8; ++i) { if ((i & 1) == 0) S[i >> 1] = S[i >> 1] * egl; S[i >> 1] = __builtin_amdgcn_mfma_f32_16x16x32_bf16(fa[i], bK[i & 1], S[i >> 1], 0, 0, 0); }
    SCAN_SB(); LD_T(fa, SC_QK, 0); SCAN_SB();
#pragma unroll
    for (int i = 0; i < 8; ++i) { if ((i & 1) == 0) S[4 + (i >> 1)] = S[4 + (i >> 1)] * egl; S[4 + (i >> 1)] = __builtin_amdgcn_mfma_f32_16x16x32_bf16(fb[i], bK[i & 1], S[4 + (i >> 1)], 0, 0, 0); }
    { const f32x4 eg0 = *(const LAS f32x4*)(tab + 4 * g), eg1 = *(const LAS f32x4*)(tab + 16 + 4 * g), eg2 = *(const LAS f32x4*)(tab + 32 + 4 * g), eg3 = *(const LAS f32x4*)(tab + 48 + 4 * g);
      oa[0] = oa[0] * eg0; oa[1] = oa[1] * eg1; oa[2] = oa[2] * eg2; oa[3] = oa[3] * eg3; }
    SCAN_SB();
#pragma unroll
    for (int i = 0; i < 8; ++i) oa[i >> 1] = __builtin_amdgcn_mfma_f32_16x16x32_bf16(fa[i], bV[i & 1], oa[i >> 1], 0, 0, 0);
#pragma unroll
    for (int ct = 0; ct < 4; ++ct) { ow[ct].x = pk2f(oa[ct][0], oa[ct][1]); ow[ct].y = pk2f(oa[ct][2], oa[ct][3]); }
#undef LD_A
#undef LD_T
}
__device__ __forceinline__ void scan_store_o(const v2u (&ow)[4], bf16_t* oblob, int sl, int lane) {
#pragma unroll
    for (int ct = 0; ct < 4; ++ct) *(GAS v2u*)(oblob + (size_t)((sl * 4 + ct) * 64 + lane) * 4) = ow[ct];
}
__device__ __forceinline__ void scan_store_g(const v2u (&ow)[4], bf16_t* gblob, int sl, int lane) {
    int ln = lane; asm volatile("" : "+v"(ln));
    const int fr = ln & 15, g = ln >> 4, j = 16 * sl + fr;
#pragma unroll
    for (int ct = 0; ct < 4; ++ct) { const int c0 = 16 * ct + 4 * g;
        gblob[offA(c0, j)] = (bf16_t)(ow[ct].x & 0xffffu); gblob[offA(c0 + 1, j)] = (bf16_t)(ow[ct].x >> 16); gblob[offA(c0 + 2, j)] = (bf16_t)(ow[ct].y & 0xffffu); gblob[offA(c0 + 3, j)] = (bf16_t)(ow[ct].y >> 16); }
}
__device__ __forceinline__ void phase_scan(Frame& F, int chain, int role, int half, const bf16_t* QHAT, const bf16_t* KHT, const bf16_t* Wb, const bf16_t* Ub, const bf16_t* QKb, const float* TAB,
                                           bf16_t* ODIRB, bf16_t* GBUF, bf16_t* SMIDT) {
    static_assert(SCAN_SPLIT == 2, "scan: 4 compute waves + 4 loader waves per workgroup, two workgroups per chain and role");
    const int lane = F.lane, w = F.wave;
    const int dir = chain & 1, bh = chain >> 1;
    const bool compute = (w < 4);
    const int sl = half * 4 + (w & 3);
    const int lw = w - 4;
    const unsigned dummy = (unsigned)(uintptr_t)(F.lds + RING_BYTES + 1024);
    const int pi0 = role ? SCAN_SEG : 0;
    f32x4 S[8];
#pragma unroll
    for (int t = 0; t < 8; ++t)
#pragma unroll
        for (int r = 0; r < 4; ++r) S[t][r] = (role == 2 && (16 * t + 4 * (lane >> 4) + r) == (16 * sl + (lane & 15))) ? 1.f : 0.f;
    ScanRegs RA, RB; v2u ow[4];
#pragma unroll
    for (int ct = 0; ct < 4; ++ct) { RA.ub[ct] = (v2u){0u, 0u}; RB.ub[ct] = (v2u){0u, 0u}; }
    constexpr int PFD = 3;
#define SCAN_N(step_) (dir ? NCH - 1 - (pi0 + (step_)) : (pi0 + (step_)))
#define SCAN_SRC(n_) [&]() { const size_t u_ = (size_t)bh * NCH + (n_), ud_ = u_ * 2 + dir; ScanSrc c_; c_.pw = (const char*)(Wb + ud_ * BLOB); c_.pq = (const char*)(QHAT + u_ * BLOB); c_.pk = (const char*)(KHT + u_ * BLOB); \
        c_.pqk = (const char*)(QKb + ud_ * QKBLOB); c_.pt = (const char*)(TAB + ud_ * TABW); c_.pu = (const char*)(Ub + ud_ * BLOB) + half * 8192; return c_; }()
    if (!compute) { scan_loader(F.lds, dummy, SCAN_SRC(SCAN_N(0)), SCAN_SRC(SCAN_N(1)), true, lw, lane); }
    else if (role != 2) scan_load_regs(RA, Ub, ((size_t)bh * NCH + SCAN_N(0)) * 2 + dir, sl, lane);
    VM_WAIT(); __syncthreads();
#define SCAN_OUT(step_) do { if (role == 2) scan_store_g(ow, GBUF + ((size_t)chain * SCAN_SEG + (step_)) * BLOB, sl, lane); \
                             else scan_store_o(ow, ODIRB + ((size_t)dir * NUNIT + (size_t)bh * NCH + SCAN_N(step_)) * BLOB, sl, lane); } while (0)
#define SCAN_STEP(step, RC, RN) do { \
        LAS unsigned char* cur = F.lds + ((step) & 1) * SC_BUF; LAS unsigned char* nxt = F.lds + (((step) + 1) & 1) * SC_BUF; \
        if (compute) { \
            if ((step) > 0) SCAN_OUT((step) - 1); \
            if ((step) + 1 < SCAN_SEG && role != 2) scan_load_regs(RN, Ub, ((size_t)bh * NCH + SCAN_N((step) + 1)) * 2 + dir, sl, lane); \
            scan_compute(S, cur, RC, ow, lane); VM_WAIT(); \
        } else if ((step) + 1 < SCAN_SEG) { const bool pf = ((step) + PFD < SCAN_SEG); scan_loader(nxt, dummy, SCAN_SRC(SCAN_N((step) + 1)), SCAN_SRC(SCAN_N(pf ? (step) + PFD : (step) + 1)), pf, lw, lane); } \
        __syncthreads(); } while (0)
    for (int step = 0; step < SCAN_SEG; step += 2) { SCAN_STEP(step, RA, RB); SCAN_STEP(step + 1, RB, RA); }
#undef SCAN_STEP
#undef SCAN_SRC
    if (compute) {
        SCAN_OUT(SCAN_SEG - 1);
        if (role == 0) {
            const int fr = lane & 15, g = lane >> 4, row = 16 * sl + fr;
#pragma unroll
            for (int s = 0; s < 4; ++s) *(GAS bf16x8*)(SMIDT + (size_t)chain * (128 * 128) + row * 128 + (((4 * s + g) ^ fr) << 3)) = pack8(S[2 * s], S[2 * s + 1]);
        }
    }
#undef SCAN_OUT
#undef SCAN_N
}
typedef float f32x16 __attribute__((ext_vector_type(16)));
constexpr int AT_BTAB = 0;
constexpr int AT_WS = 8 * 320 * 4;
constexpr float AT_L2E = 1.4426950408889634f, AT_NEG = -1e30f;
__device__ __forceinline__ void attn_tables(Frame& F, const float* rel_bias) {
    LAS float* bt = (LAS float*)(F.lds + AT_BTAB);
    for (int i = F.tid; i < 8 * 320; i += NWAVES * 64) { const int h = i / 320, rel = i % 320 - 160;
        bt[i] = (rel >= -WIN && rel <= WIN) ? rel_bias[t5_bucket(rel) * AH + h] * AT_L2E : AT_NEG; }
    __syncthreads();
}
__device__ __forceinline__ void attn_task(Frame& F, int task, bf16_t* QC, const bf16_t* KV, const bf16_t* VTP, const float* sink) {
    const int lane = F.lane, q = lane & 31, hh = lane >> 5;
    const int gq = task & 3, qblk = (task >> 2) & 255, bk = task >> 10, kvh = bk & 1, b = bk >> 1, h = kvh * 4 + gq, q0 = qblk * 32;
    const LAS float* btl = (const LAS float*)(F.lds + AT_BTAB) + h * 320 + (4 * hh - q + 32);
    LAS float* wsf = (LAS float*)(F.lds + AT_WS) + F.wave * 64;
    bf16x8 qf[4];
    { const bf16_t* qp = QC + (size_t)(b * SEQ + q0 + q) * 1024 + h * 64 + 8 * hh;
#pragma unroll
      for (int s = 0; s < 4; ++s) qf[s] = *(const GAS bf16x8*)(qp + 16 * s); }
    const bf16_t* kbase = KV + (size_t)(b * SEQ) * 256 + kvh * 64 + 8 * hh;
    const bf16_t* vbase = VTP + ((size_t)(b * AKVH + kvh) * 64 + q) * SEQ + 8 * hh;
#define AT_TILE(j_) ((qblk - 4 + (j_)) < 0 ? 0 : ((qblk - 4 + (j_)) > SEQ / 32 - 1 ? SEQ / 32 - 1 : (qblk - 4 + (j_))))
#define AT_OK(j_) ((qblk - 4 + (j_)) >= 0 && (qblk - 4 + (j_)) <= SEQ / 32 - 1)
    const float sc = 0.125f * AT_L2E;
    float mx = sink[h] * AT_L2E;
    f32x16 sv[9];
    bf16x8 kc[4], kn[4];
    { const bf16_t* kp = kbase + (size_t)(32 * AT_TILE(0) + q) * 256;
#pragma unroll
      for (int s = 0; s < 4; ++s) kc[s] = *(const GAS bf16x8*)(kp + 16 * s); }
#pragma unroll
    for (int j = 0; j < 9; ++j) {
        if (j < 8) { const bf16_t* kp = kbase + (size_t)(32 * AT_TILE(j + 1) + q) * 256;
#pragma unroll
            for (int s = 0; s < 4; ++s) kn[s] = *(const GAS bf16x8*)(kp + 16 * s); }
        f32x16 acc;
#pragma unroll
        for (int r = 0; r < 16; ++r) acc[r] = 0.f;
#pragma unroll
        for (int s = 0; s < 4; ++s) acc = __builtin_amdgcn_mfma_f32_32x32x16_bf16(kc[s], qf[s], acc, 0, 0, 0);
        const float tb = AT_OK(j) ? 0.f : AT_NEG;
#pragma unroll
        for (int r = 0; r < 16; ++r) { const float v = __builtin_fmaf(acc[r], sc, btl[32 * j + (r & 3) + 8 * (r >> 2)]) + tb; sv[j][r] = v; mx = fmaxf(mx, v); }
#pragma unroll
        for (int s = 0; s < 4; ++s) kc[s] = kn[s];
    }
    mx = fmaxf(mx, __shfl_xor(mx, 32));
    f32x16 o0, o1;
#pragma unroll
    for (int r = 0; r < 16; ++r) { o0[r] = 0.f; o1[r] = 0.f; }
    float l = 0.f;
    bf16x8 vc[4];
#pragma unroll
    for (int j = 0; j < 9; ++j) {
#pragma unroll
        for (int s2 = 0; s2 < 2; ++s2) { vc[2 * s2] = *(const GAS bf16x8*)(vbase + 32 * AT_TILE(j) + 16 * s2); vc[2 * s2 + 1] = *(const GAS bf16x8*)(vbase + (size_t)32 * SEQ + 32 * AT_TILE(j) + 16 * s2); }
        float p[16];
#pragma unroll
        for (int r = 0; r < 16; ++r) { p[r] = __builtin_amdgcn_exp2f(sv[j][r] - mx); l += p[r]; }
#pragma unroll
        for (int s2 = 0; s2 < 2; ++s2) {
            v4u pw; pw.x = pk2f(p[8 * s2], p[8 * s2 + 1]); pw.y = pk2f(p[8 * s2 + 2], p[8 * s2 + 3]); pw.z = pk2f(p[8 * s2 + 4], p[8 * s2 + 5]); pw.w = pk2f(p[8 * s2 + 6], p[8 * s2 + 7]);
            const bf16x8 pa = __builtin_bit_cast(bf16x8, pw);
            o0 = __builtin_amdgcn_mfma_f32_32x32x16_bf16(pa, vc[2 * s2], o0, 0, 0, 0);
            o1 = __builtin_amdgcn_mfma_f32_32x32x16_bf16(pa, vc[2 * s2 + 1], o1, 0, 0, 0);
        }
    }
#undef AT_TILE
#undef AT_OK
    l += __shfl_xor(l, 32);
    l += __builtin_amdgcn_exp2f(sink[h] * AT_L2E - mx);
    if (hh == 0) wsf[q] = 1.f / l;
    LDS_WAIT(); asm volatile("" ::: "memory");
    bf16_t* op = QC + (size_t)(b * SEQ + q0) * 1024 + h * 64 + q;
#pragma unroll
    for (int r = 0; r < 16; ++r) { const int qr = (r & 3) + 8 * (r >> 2) + 4 * hh; const float il = wsf[qr]; const unsigned w2 = pk2f(o0[r] * il, o1[r] * il);
        op[(size_t)qr * 1024] = (bf16_t)(w2 & 0xffffu); op[(size_t)qr * 1024 + 32] = (bf16_t)(w2 >> 16); }
    LDS_WAIT(); asm volatile("" ::: "memory");
}
__device__ __forceinline__ void phase_attn(Frame& F, int aw, int naw, bf16_t* QC, const bf16_t* KV, const bf16_t* VTP, const float* rel_bias, const float* sink) {
    attn_tables(F, rel_bias);
    for (int task = aw; task < BATCH * AKVH * 256 * 4; task += naw) { attn_task(F, task, QC, KV, VTP, sink); }
}
__device__ __forceinline__ void phase_p4c(Frame& F, const bf16_t* ODIRB, const bf16_t* GBUF, const bf16_t* SMIDT, const bf16_t* Z, const float* gnw, bf16_t* QC) {
    const int gw = F.vcu * NWAVES + F.wave, NGW = F.G * NWAVES;
    for (int task = gw; task < NUNIT * 4; task += NGW) {
        int lane = F.lane; asm volatile("" : "+v"(lane));
        const int fr = lane & 15, g = lane >> 4;
        const int u = task >> 2, ct = task & 3, n = u % NCH, bh = u / NCH, h = bh % GH, b = bh / GH;
        const int dirc = (n >= SCAN_SEG) ? 0 : 1, st = dirc ? (SCAN_SEG - 1 - n) : (n - SCAN_SEG), chain = bh * 2 + dirc;
        const bf16_t* gb = GBUF + ((size_t)chain * SCAN_SEG + st) * BLOB; const bf16_t* sm = SMIDT + (size_t)chain * (128 * 128);
        bf16x8 ga[4];
#pragma unroll
        for (int s = 0; s < 4; ++s) ga[s] = fragA_g(gb, ct, s, fr, g);
        f32x4 acc[8];
#pragma unroll
        for (int vt = 0; vt < 8; ++vt) {
            bf16x8 sb[4];
#pragma unroll
            for (int s = 0; s < 4; ++s) sb[s] = fragA_g(sm, vt, s, fr, g);
            const size_t oo = (size_t)((vt * 4 + ct) * 64 + lane) * 4;
            const v2u of = *(const GAS v2u*)(ODIRB + (size_t)u * BLOB + oo), ob = *(const GAS v2u*)(ODIRB + ((size_t)NUNIT + u) * BLOB + oo);
            f32x4 a = (f32x4){bf2f(of.x) + bf2f(ob.x), bf2f(of.x >> 16) + bf2f(ob.x >> 16), bf2f(of.y) + bf2f(ob.y), bf2f(of.y >> 16) + bf2f(ob.y >> 16)};
#pragma unroll
            for (int s = 0; s < 4; ++s) a = __builtin_amdgcn_mfma_f32_16x16x32_bf16(ga[s], sb[s], a, 0, 0, 0);
            acc[vt] = a;
        }
        float gv[8];
#pragma unroll
        for (int vt = 0; vt < 8; ++vt) gv[vt] = gnw[16 * vt + fr];
#pragma unroll
        for (int r = 0; r < 4; ++r) {
            float ss = 0.f;
#pragma unroll
            for (int vt = 0; vt < 8; ++vt) ss += acc[vt][r] * acc[vt][r];
            ss += __shfl_xor(ss, 1); ss += __shfl_xor(ss, 2); ss += __shfl_xor(ss, 4); ss += __shfl_xor(ss, 8);
            const float rs = rsqrtf(ss * (1.f / GD) + EPS);
            const size_t m = (size_t)b * SEQ + n * CHUNK + 16 * ct + 4 * g + r;
            const bf16_t* zp = Z + m * 512 + h * GD + fr; bf16_t* qp = QC + m * 1024 + 512 + h * GD + fr;
#pragma unroll
            for (int vt = 0; vt < 8; vt += 2) { const float z0 = bf2f(zp[16 * vt]), z1 = bf2f(zp[16 * vt + 16]);
                const unsigned w2 = pk2f(acc[vt][r] * rs * gv[vt] * (z0 / (1.f + __expf(-z0))), acc[vt + 1][r] * rs * gv[vt + 1] * (z1 / (1.f + __expf(-z1))));
                qp[16 * vt] = (bf16_t)(w2 & 0xffffu); qp[16 * vt + 16] = (bf16_t)(w2 >> 16); }
            asm volatile("" ::: "memory");
        }
    }
}
#define MIXER_PHASES \
    bf16_t* VTP = (bf16_t*)(ws + WS_VTP); (void)VTP; \
    if (IN(2)) { phase_p2a(F, QKVG, KV, conv_w, QHAT, KHAT, KHT, VHT, VTP); if (BOTH(2)) { VM_WAIT(); __syncthreads(); } }     \
    if (IN(3)) { phase_p2b(F, QHAT, KHAT, KHT, VHT, GATES, a_log, dt_bias, Wb, Ub, QKb, TAB); if (BOTH(3)) GRID_BAR(); } \
    if (IN(4)) { if (blockIdx.x < SCAN_WGS) { const int bx_ = (int)blockIdx.x, slot_ = bx_ >> 3, sub_ = slot_ % 6; \
                     phase_scan(F, (bx_ & 7) + 8 * (slot_ / 6), sub_ >> 1, sub_ & 1, QHAT, KHT, Wb, Ub, QKb, TAB, ODIR, (bf16_t*)(ws + WS_GBUF), (bf16_t*)(ws + WS_SMID)); } \
                 else phase_attn(F, ((int)blockIdx.x - SCAN_WGS) * NWAVES + F.wave, (F.G - SCAN_WGS) * NWAVES, QC, KV, VTP, rel_bias, attn_sink); \
                 if (BOTH(4)) GRID_BAR(); }
#define HAVE_REF_MIXERS 1
#define REF_P2A k_p2a<<<dim3(M, GH), 128, 0, stream>>>((bf16_t*)(ws + WS_QKVG), (const float*)d_in[5], (bf16_t*)(ws + WS_QHAT), (bf16_t*)(ws + WS_KHAT), (bf16_t*)(ws + WS_KHT), (bf16_t*)(ws + WS_VHT));
#define REF_P2B k_p2b_ref<<<NUNIT * 2, 64, P2B_SMEM, stream>>>((bf16_t*)(ws + WS_QHAT), (bf16_t*)(ws + WS_KHAT), (bf16_t*)(ws + WS_VHT), (float*)(ws + WS_GATES), (const float*)d_in[6], (const float*)d_in[7], (bf16_t*)(ws + WS_W), (bf16_t*)(ws + WS_U), (bf16_t*)(ws + WS_QK), (float*)(ws + WS_TAB));
#define REF_SCAN k_scan_ref<<<16, 128, SCAN_SMEM, stream>>>((bf16_t*)(ws + WS_QHAT), (bf16_t*)(ws + WS_KHT), (bf16_t*)(ws + WS_W), (bf16_t*)(ws + WS_U), (bf16_t*)(ws + WS_QK), (float*)(ws + WS_TAB), (bf16_t*)(ws + WS_ODIR));
#define REF_ATTN k_attn_ref<<<dim3(M / 64, AH), 64, 0, stream>>>((bf16_t*)(ws + WS_QC), (bf16_t*)(ws + WS_KV), (const float*)d_in[3], (const float*)d_in[4]);
#define MEGA(lo, hi, idx) a.ph_lo = lo; a.ph_hi = hi; a.li = idx; hipLaunchKernelGGL(mega, dim3(grid), dim3(NWAVES * 64), LDS_BYTES, stream, a);
#define LAUNCH_PROGRAM { MEGA(0, 10, 0) }
struct Args { const float* in[14]; float* out; unsigned char* ws; int ph_lo, ph_hi, li, pad; };
__global__ void __launch_bounds__(NWAVES * 64, 2) mega(Args args) {
    extern __shared__ __attribute__((aligned(16))) unsigned char lds[];
    Frame F;
    F.lds = (LAS unsigned char*)lds; F.MISC = (volatile LAS unsigned*)(F.lds + MISC_OFF);
    F.tid = threadIdx.x; F.lane = F.tid & 63; F.wave = __builtin_amdgcn_readfirstlane(F.tid >> 6);
    F.G = gridDim.x; { const int bx = blockIdx.x; F.vcu = (F.G % 8 == 0) ? (bx % 8) * (F.G / 8) + bx / 8 : bx; }
    unsigned char* ws = args.ws; F.ctl = (gu32*)(ws + WS_CTL);
    const float* x = args.in[0]; const float* norm_mix_w = args.in[1]; const float* w_in = args.in[2];
    const float* rel_bias = args.in[3]; const float* attn_sink = args.in[4]; const float* conv_w = args.in[5];
    const float* a_log = args.in[6]; const float* dt_bias = args.in[7]; const float* gdn_norm_w = args.in[8];
    const float* w_out = args.in[9]; const float* norm_ffn_w = args.in[10]; const float* w_ffn_in = args.in[11];
    const float* w_ffn_out = args.in[12]; const float* norm_final_w = args.in[13]; float* out = args.out;
    bf16_t* WIN_T = (bf16_t*)(ws + WS_WIN); bf16_t* WOUT_T = (bf16_t*)(ws + WS_WOUT); bf16_t* W1_T = (bf16_t*)(ws + WS_W1); bf16_t* W2_T = (bf16_t*)(ws + WS_W2);
    float* GATES = (float*)(ws + WS_GATES); bf16_t* XN = (bf16_t*)(ws + WS_XN); bf16_t* QHAT = (bf16_t*)(ws + WS_QHAT); bf16_t* KHT = (bf16_t*)(ws + WS_KHT); bf16_t* HB = (bf16_t*)(ws + WS_HB);
    bf16_t* QC = (bf16_t*)(ws + WS_QC); bf16_t* KV = (bf16_t*)(ws + WS_KV); bf16_t* Z = (bf16_t*)(ws + WS_Z); bf16_t* QKVG = (bf16_t*)(ws + WS_QKVG);
    bf16_t* Wb = (bf16_t*)(ws + WS_W); bf16_t* QKb = (bf16_t*)(ws + WS_QK); bf16_t* KHAT = (bf16_t*)(ws + WS_KHAT); bf16_t* VHT = (bf16_t*)(ws + WS_VHT); bf16_t* ODIR = (bf16_t*)(ws + WS_ODIR);
    bf16_t* Ub = (bf16_t*)(ws + WS_U); float* TAB = (float*)(ws + WS_TAB); float* SSQ1 = (float*)(ws + WS_SSQ1); float* SSQ2 = (float*)(ws + WS_SSQ2); bf16_t* ACT = (bf16_t*)(ws + WS_ACT);
    (void)rel_bias; (void)attn_sink; (void)conv_w; (void)a_log; (void)dt_bias; (void)QHAT; (void)KHT; (void)QKVG; (void)Wb; (void)QKb; (void)KHAT; (void)VHT; (void)Ub; (void)TAB; (void)KV;
    for (int u = F.tid; u < (LDS_BYTES - LDSCTL_OFF) / 4; u += NWAVES * 64) ((LAS unsigned*)(F.lds + LDSCTL_OFF))[u] = 0u;
    __syncthreads();
    XcdBarrier bar = xcd_barrier_post((unsigned*)(F.ctl + CW_BAR) + args.li * XCD_BAR_WORDS, F.MISC + 8);
    const int lo = args.ph_lo, hi = args.ph_hi;
#define IN(k) (lo <= (k) && (k) < hi)
#define BOTH(k) (IN(k) && IN((k) + 1))
#define GRID_BAR() xcd_barrier(bar)
    if (IN(0)) { P0Args a{x, norm_mix_w, w_in, w_out, norm_ffn_w, w_ffn_in, w_ffn_out, WIN_T, WOUT_T, W1_T, W2_T, XN, GATES}; phase_p0(F, a); if (BOTH(0)) GRID_BAR(); }
    if (IN(1)) { pg8::Gemm g{XN, WIN_T, M, NPROJ, DM, 0}; pg8::StaticOrder S; S.init(M, NPROJ, F.G, (int)blockIdx.x); pg8::EpiProj E{QC, KV, QKVG, Z};
        pg8::gemm_phase<pg8::EpiProj, pg8::StaticOrder, true, true>(F.lds, g, S, E); if (BOTH(1)) GRID_BAR(); }
    MIXER_PHASES
    if (IN(5)) { phase_p4c(F, ODIR, (const bf16_t*)(ws + WS_GBUF), (const bf16_t*)(ws + WS_SMID), Z, gdn_norm_w, QC); if (BOTH(5)) GRID_BAR(); }
    if (IN(6)) { pg8::Gemm g{QC, WOUT_T, M, DM, DM, 0}; pg8::StaticOrder S; S.init(M, DM, F.G, (int)blockIdx.x); pg8::EpiRes E{x, out, HB, SSQ1};
        pg8::gemm_phase<pg8::EpiRes, pg8::StaticOrder, false, true>(F.lds, g, S, E); if (BOTH(6)) GRID_BAR(); }
    if (IN(7)) { pg8::Gemm g{HB, W1_T, M, DFF, DM, 0}; pg8::StaticOrder S; S.init(M, DFF, F.G, (int)blockIdx.x); pg8::EpiFfn1 E{ACT, SSQ1};
        pg8::gemm_phase<pg8::EpiFfn1, pg8::StaticOrder, true, true>(F.lds, g, S, E); if (BOTH(7)) GRID_BAR(); }
    if (IN(8)) { pg8::Gemm g{ACT, W2_T, M, DM, DFF, 0}; pg8::StaticOrder S; S.init(M, DM, F.G, (int)blockIdx.x); pg8::EpiRes E{out, out, nullptr, SSQ2};
        pg8::gemm_phase<pg8::EpiRes, pg8::StaticOrder, false, true>(F.lds, g, S, E); if (BOTH(8)) GRID_BAR(); }
    if (IN(9)) { phase_p8(F, out, SSQ2, norm_final_w); }
#undef IN
#undef BOTH
}
extern "C" void kernel_launch(void* const* d_in, const int* in_sizes, int n_in, void* d_out, int out_size, void* d_ws, size_t ws_size, hipStream_t stream) {
    static int grid = 0;
    constexpr int P2B_SMEM = (64 * 129 * 2 + 64 * 65 * 2 + 192) * 4, SCAN_SMEM = (128 * 128 + 64 * 128 * 2 + 64 * 64) * 4;
    if (grid == 0) {
        if (n_in != 14 || ws_size < WS_END) { fprintf(stderr, "kernel_launch: unexpected inputs (n_in %d, ws %zu)\n", n_in, ws_size); grid = -1; return; }
        int dev = 0, cus = 0, per_cu = 0;
        if (hipGetDevice(&dev) != hipSuccess || hipDeviceGetAttribute(&cus, hipDeviceAttributeMultiprocessorCount, dev) != hipSuccess) { grid = -1; return; }
        if (hipFuncSetAttribute((const void*)mega, hipFuncAttributeMaxDynamicSharedMemorySize, LDS_BYTES) != hipSuccess) { fprintf(stderr, "kernel_launch: hipFuncSetAttribute failed\n"); grid = -1; return; }
        if (hipOccupancyMaxActiveBlocksPerMultiprocessor(&per_cu, (const void*)mega, NWAVES * 64, LDS_BYTES) != hipSuccess || per_cu < 1) { fprintf(stderr, "kernel_launch: occupancy query says %d\n", per_cu); per_cu = 1; }
        (void)hipGetLastError();
        grid = cus * 1;
#ifdef HAVE_REF_MIXERS
        (void)hipFuncSetAttribute((const void*)k_p2b_ref, hipFuncAttributeMaxDynamicSharedMemorySize, P2B_SMEM);
        (void)hipFuncSetAttribute((const void*)k_scan_ref, hipFuncAttributeMaxDynamicSharedMemorySize, SCAN_SMEM);
#endif
    }
    if (grid < 0) return;
    if (hipMemsetAsync((char*)d_ws + WS_CTL, 0, CTL_ZERO_BYTES, stream) != hipSuccess) return;
    Args a{};
    for (int i = 0; i < 14; ++i) a.in[i] = (const float*)d_in[i];
    a.out = (float*)d_out; a.ws = (unsigned char*)d_ws;
    LAUNCH_PROGRAM
}
```
